# Optimizing an MI355X kernel written in HIP

```python
import jax, jax.numpy as jnp
from jax import lax
import numpy as np

D_MODEL = 1024
BATCH = 32
SEQ = 2048
DEPTH = 4

GRID_W = 64
CTX_LEN = 256
N_MIXERS = 2
N_ATTN_LAYERS = (DEPTH + N_MIXERS - 1) // N_MIXERS
N_GLA_LAYERS = DEPTH // N_MIXERS
RMS_EPS = 1e-6
ATTN_HEAD_DIM = 64
ATTN_HEADS = D_MODEL // ATTN_HEAD_DIM
ATTN_KV_HEADS = 4
ATTN_GROUP = ATTN_HEADS // ATTN_KV_HEADS
WINDOW = 128
ATTN_BLOCK = 128
ATTN_HALO = -(-WINDOW // ATTN_BLOCK) * ATTN_BLOCK
ROPE_THETA = 10000.0
ROPE_AXIS_DIM = ATTN_HEAD_DIM // 2
GLA_HEADS = 4
GLA_KEY_DIM = D_MODEL // 2 // GLA_HEADS
GLA_VAL_DIM = D_MODEL // GLA_HEADS
GLA_GATE_RANK = 16
GLA_GATE_NORM = 16.0
GLA_CHUNK = 64
N_EXPERTS = 16
N_GROUPS = 4
EXPERTS_PER_GROUP = N_EXPERTS // N_GROUPS
TOP_K = 2
D_EXPERT = D_MODEL // 2
MOE_BLOCK = 256

kernel_name = 'hybrid_swa_gla_grouped_moe_dit'

F32 = jnp.float32


def rmsnorm(x, gain):
    xf = x.astype(F32)
    y = xf * lax.rsqrt(jnp.mean(xf * xf, axis=-1, keepdims=True) + RMS_EPS) * gain.astype(F32)
    return y.astype(x.dtype)


def modulate(h, shift, scale):
    return h * (1 + scale) + shift


def axial_rope_tables(rows):
    row = jnp.repeat(jnp.arange(rows, dtype=F32), GRID_W)
    col = jnp.tile(jnp.arange(GRID_W, dtype=F32), rows)
    half = ROPE_AXIS_DIM // 2
    inv_freq = ROPE_THETA ** (-jnp.arange(half, dtype=F32) / half)
    ang_r = row[:, None] * inv_freq[None, :]
    ang_c = col[:, None] * inv_freq[None, :]
    return (jnp.cos(ang_r), jnp.sin(ang_r), jnp.cos(ang_c), jnp.sin(ang_c))


def rope_2d(x, rope):
    cos_r, sin_r, cos_c, sin_c = rope
    shp = (x.shape[1],) + (1,) * (x.ndim - 3) + (ROPE_AXIS_DIM // 2,)
    xf = x.astype(F32)

    def rot(y, cos, sin):
        y1, y2 = jnp.split(y, 2, axis=-1)
        cos, sin = cos.reshape(shp), sin.reshape(shp)
        return jnp.concatenate([y1 * cos - y2 * sin, y2 * cos + y1 * sin], axis=-1)

    x_row, x_col = jnp.split(xf, 2, axis=-1)
    return jnp.concatenate([rot(x_row, cos_r, sin_r), rot(x_col, cos_c, sin_c)], axis=-1).astype(x.dtype)


def sink_attend(scores, values, sink):
    B, KH, G, Q, _ = scores.shape
    sink_col = jnp.broadcast_to(sink.astype(F32)[None, :, :, None, None], (B, KH, G, Q, 1))
    p = jax.nn.softmax(jnp.concatenate([scores, sink_col], axis=-1), axis=-1)[..., :-1]
    return jnp.einsum('bkgqs,bskd->bqkgd', p.astype(values.dtype), values)


def window_gqa_mixer(h_lat, h_ctx, w_qkv, w_o, sinks, rope, need_ctx_out):
    B, S, _ = h_lat.shape
    q_dim = ATTN_HEADS * ATTN_HEAD_DIM
    kv_dim = ATTN_KV_HEADS * ATTN_HEAD_DIM
    scale = ATTN_HEAD_DIM ** -0.5
    sinks_g = sinks.reshape(ATTN_KV_HEADS, ATTN_GROUP)

    def project(h):
        b, t, _ = h.shape
        z = h @ w_qkv
        q = z[..., :q_dim].reshape(b, t, ATTN_KV_HEADS, ATTN_GROUP, ATTN_HEAD_DIM)
        k = z[..., q_dim:q_dim + kv_dim].reshape(b, t, ATTN_KV_HEADS, ATTN_HEAD_DIM)
        v = z[..., q_dim + kv_dim:].reshape(b, t, ATTN_KV_HEADS, ATTN_HEAD_DIM)
        return q, k, v

    q_l, k_l, v_l = project(h_lat)
    q_l, k_l = rope_2d(q_l, rope), rope_2d(k_l, rope)
    q_c, k_c, v_c = project(h_ctx)

    pad = ((0, 0), (ATTN_HALO, ATTN_HALO), (0, 0), (0, 0))
    k_pad, v_pad = jnp.pad(k_l, pad), jnp.pad(v_l, pad)
    span = ATTN_BLOCK + 2 * ATTN_HALO
    q_off = jnp.arange(ATTN_BLOCK)
    k_off = jnp.arange(span) - ATTN_HALO

    def block(start):
        qb = lax.dynamic_slice_in_dim(q_l, start, ATTN_BLOCK, axis=1)
        kb = lax.dynamic_slice_in_dim(k_pad, start, span, axis=1)
        vb = lax.dynamic_slice_in_dim(v_pad, start, span, axis=1)
        qpos, kpos = start + q_off, start + k_off
        valid = (jnp.abs(qpos[:, None] - kpos[None, :]) <= WINDOW) & (kpos[None, :] >= 0) & (kpos[None, :] < S)
        s_win = jnp.einsum('bqkgd,bskd->bkgqs', qb, kb).astype(F32) * scale
        s_win = jnp.where(valid, s_win, -jnp.inf)
        s_cx = jnp.einsum('bqkgd,bckd->bkgqc', qb, k_c).astype(F32) * scale
        return sink_attend(jnp.concatenate([s_win, s_cx], axis=-1),
                           jnp.concatenate([vb, v_c], axis=1), sinks_g)

    o = lax.map(block, jnp.arange(S // ATTN_BLOCK) * ATTN_BLOCK)
    y_lat = o.transpose(1, 0, 2, 3, 4, 5).reshape(B, S, q_dim) @ w_o
    y_ctx = None
    if need_ctx_out:
        s_cc = jnp.einsum('bqkgd,bckd->bkgqc', q_c, k_c).astype(F32) * scale
        o_c = sink_attend(s_cc, v_c, sinks_g)
        y_ctx = o_c.reshape(B, h_ctx.shape[1], q_dim) @ w_o
    return y_lat, y_ctx


def gla_chunked(q, k, v, log_a, s0):
    B, T, H, DK = q.shape
    DV = v.shape[-1]
    nc = T // GLA_CHUNK

    def chunks(a):
        return a.astype(F32).reshape(B, nc, GLA_CHUNK, H, a.shape[-1]).transpose(1, 0, 3, 2, 4)

    lower_tri = jnp.tril(jnp.ones((GLA_CHUNK, GLA_CHUNK), dtype=bool))[:, :, None]

    def step(state, inp):
        qi, ki, vi, gi = inp
        b = jnp.cumsum(gi, axis=2)
        b_end = b[:, :, -1:, :]
        o_inter = jnp.einsum('bhtk,bhkv->bhtv', qi * jnp.exp(b), state)
        diff = jnp.where(lower_tri, b[:, :, :, None, :] - b[:, :, None, :, :], -jnp.inf)
        scores = jnp.einsum('bhtk,bhsk,bhtsk->bhts', qi, ki, jnp.exp(diff))
        o_intra = jnp.einsum('bhts,bhsv->bhtv', scores, vi)
        new_state = state * jnp.exp(b_end[:, :, 0, :, None]) + jnp.einsum(
            'bhsk,bhsv->bhkv', ki * jnp.exp(b_end - b), vi)
        return new_state, o_inter + o_intra

    s_final, o = lax.scan(step, s0, (chunks(q), chunks(k), chunks(v), chunks(log_a)))
    o = o.transpose(1, 0, 3, 2, 4).reshape(B, T, H, DV).astype(v.dtype)
    return o, s_final


def gla_mixer(h_lat, h_ctx, w_in, w_a1, w_a2, b_a, norm_g, w_o, need_ctx_out):
    kd = GLA_HEADS * GLA_KEY_DIM
    vd = GLA_HEADS * GLA_VAL_DIM

    def project(h):
        b, t, _ = h.shape
        z = h @ w_in
        q = z[..., :kd].reshape(b, t, GLA_HEADS, GLA_KEY_DIM) * (GLA_KEY_DIM ** -0.5)
        k = z[..., kd:2 * kd].reshape(b, t, GLA_HEADS, GLA_KEY_DIM)
        v = z[..., 2 * kd:2 * kd + vd].reshape(b, t, GLA_HEADS, GLA_VAL_DIM)
        g = z[..., 2 * kd + vd:]
        log_a = [(jax.nn.log_sigmoid((h @ w_a1[d] @ w_a2[d] + b_a[d]).astype(F32)) / GLA_GATE_NORM)
                 .reshape(b, t, GLA_HEADS, GLA_KEY_DIM) for d in range(2)]
        return q, k, v, g, log_a

    def output(o, g):
        b, t = o.shape[:2]
        o = rmsnorm(o, norm_g).reshape(b, t, vd)
        return (o * jax.nn.silu(g)) @ w_o

    flip = lambda a: jnp.flip(a, axis=1)
    q_l, k_l, v_l, g_l, la_l = project(h_lat)
    q_c, k_c, v_c, g_c, la_c = project(h_ctx)
    B = h_lat.shape[0]
    s0 = jnp.zeros((B, GLA_HEADS, GLA_KEY_DIM, GLA_VAL_DIM), F32)
    o_cf, s_cf = gla_chunked(q_c, k_c, v_c, la_c[0], s0)
    o_lf, _ = gla_chunked(q_l, k_l, v_l, la_l[0], s_cf)
    o_cb, s_cb = gla_chunked(flip(q_c), flip(k_c), flip(v_c), flip(la_c[1]), s0)
    o_lb, _ = gla_chunked(flip(q_l), flip(k_l), flip(v_l), flip(la_l[1]), s_cb)
    y_lat = output(o_lf + flip(o_lb), g_l)
    y_ctx = output(o_cf + flip(o_cb), g_c) if need_ctx_out else None
    return y_lat, y_ctx


def grouped_moe(h, router_w, router_b, w_gate, w_up, w_down):
    N, D = h.shape
    scores = jax.nn.sigmoid(h.astype(F32) @ router_w.astype(F32))
    sel = (scores + router_b.astype(F32)).reshape(N, N_GROUPS, EXPERTS_PER_GROUP)
    group_score = lax.top_k(sel, TOP_K)[0].sum(-1)
    grp = jnp.argmax(group_score, axis=-1)
    sel_in = jnp.take_along_axis(sel, grp[:, None, None], axis=1)[:, 0]
    _, local = lax.top_k(sel_in, TOP_K)
    eidx = grp[:, None] * EXPERTS_PER_GROUP + local
    gate = jnp.take_along_axis(scores, eidx, axis=1)
    gate = gate / jnp.sum(gate, axis=-1, keepdims=True)
    A = N * TOP_K
    e_flat = eidx.reshape(A)
    order = jnp.argsort(e_flat)
    e_sorted = e_flat[order]
    tok_sorted = order // TOP_K
    gate_sorted = gate.reshape(A)[order].astype(h.dtype)
    counts = jnp.bincount(e_flat, length=N_EXPERTS)
    starts = jnp.cumsum(counts) - counts
    padded = (counts + MOE_BLOCK - 1) // MOE_BLOCK * MOE_BLOCK
    pends = jnp.cumsum(padded)
    pstarts = pends - padded
    slot = pstarts[e_sorted] + (jnp.arange(A) - starts[e_sorted])
    n_blocks = -(-A // MOE_BLOCK) + N_EXPERTS
    buf = jnp.zeros((n_blocks * MOE_BLOCK, D), h.dtype).at[slot].set(h[tok_sorted])
    block_expert = jnp.minimum(jnp.searchsorted(pends, jnp.arange(n_blocks) * MOE_BLOCK, side='right'),
                               N_EXPERTS - 1)

    def expert_block(args):
        xb, e = args
        hid = jax.nn.silu(xb @ w_gate[e]) * (xb @ w_up[e])
        return hid @ w_down[e]

    y_buf = lax.map(expert_block, (buf.reshape(n_blocks, MOE_BLOCK, D), block_expert)).reshape(-1, D)
    y = y_buf[slot] * gate_sorted[:, None]
    return jnp.zeros((N, D), h.dtype).at[tok_sorted].add(y)


def setup_inputs(seed: int = 0) -> dict:
    key = jax.random.key(seed)
    ks = jax.random.split(key, 23)

    def nrm(k, shape, scale):
        return jax.random.normal(k, shape, F32) * scale

    D = D_MODEL
    qkv_w = ATTN_HEADS * ATTN_HEAD_DIM + 2 * ATTN_KV_HEADS * ATTN_HEAD_DIM
    kd = GLA_HEADS * GLA_KEY_DIM
    vd = GLA_HEADS * GLA_VAL_DIM
    return {
        'x': nrm(ks[0], (BATCH, SEQ, D), 1.0),
        'c': nrm(ks[1], (BATCH, D), 1.0),
        'ctx': nrm(ks[2], (BATCH, CTX_LEN, D), 1.0),
        'c_ctx': nrm(ks[3], (D,), 1.0),
        'ada_w': nrm(ks[4], (DEPTH, D, 6 * D), 0.5 * D ** -0.5),
        'ada_b': nrm(ks[5], (DEPTH, 6 * D), 0.02),
        'norm_mix_g': 1.0 + nrm(ks[6], (DEPTH, D), 0.05),
        'norm_ffn_g': 1.0 + nrm(ks[7], (DEPTH, D), 0.05),
        'final_g': 1.0 + nrm(ks[8], (D,), 0.05),
        'attn_w_qkv': nrm(ks[9], (N_ATTN_LAYERS, D, qkv_w), D ** -0.5),
        'attn_w_o': nrm(ks[10], (N_ATTN_LAYERS, ATTN_HEADS * ATTN_HEAD_DIM, D), (ATTN_HEADS * ATTN_HEAD_DIM) ** -0.5),
        'attn_sinks': nrm(ks[11], (N_ATTN_LAYERS, ATTN_HEADS), 0.5),
        'gla_w_in': nrm(ks[12], (N_GLA_LAYERS, D, 2 * kd + 2 * vd), D ** -0.5),
        'gla_w_a1': nrm(ks[13], (N_GLA_LAYERS, 2, D, GLA_GATE_RANK), D ** -0.5),
        'gla_w_a2': nrm(ks[14], (N_GLA_LAYERS, 2, GLA_GATE_RANK, kd), GLA_GATE_RANK ** -0.5),
        'gla_b_a': nrm(ks[15], (N_GLA_LAYERS, 2, kd), 0.1),
        'gla_norm_g': 1.0 + nrm(ks[16], (N_GLA_LAYERS, GLA_VAL_DIM), 0.05),
        'gla_w_o': nrm(ks[17], (N_GLA_LAYERS, vd, D), vd ** -0.5),
        'router_w': nrm(ks[18], (D, N_EXPERTS), D ** -0.5),
        'router_b': nrm(ks[19], (N_EXPERTS,), 0.01),
        'moe_w_gate': nrm(ks[20], (DEPTH, N_EXPERTS, D, D_EXPERT), D ** -0.5),
        'moe_w_up': nrm(ks[21], (DEPTH, N_EXPERTS, D, D_EXPERT), D ** -0.5),
        'moe_w_down': nrm(ks[22], (DEPTH, N_EXPERTS, D_EXPERT, D), D_EXPERT ** -0.5),
    }


def reference(x, c, ctx, c_ctx, ada_w, ada_b, norm_mix_g, norm_ffn_g, final_g, attn_w_qkv, attn_w_o, attn_sinks,
              gla_w_in, gla_w_a1, gla_w_a2, gla_b_a, gla_norm_g, gla_w_o, router_w, router_b,
              moe_w_gate, moe_w_up, moe_w_down):
    B, S, D = x.shape
    C = ctx.shape[1]
    ROWS = S // GRID_W
    rope = axial_rope_tables(ROWS)
    silu_c = jax.nn.silu(c)
    silu_cc = jax.nn.silu(c_ctx)
    h_ctx_stream = ctx
    for i in range(DEPTH):
        last = i == DEPTH - 1
        mod_l = silu_c @ ada_w[i] + ada_b[i]
        mod_c = silu_cc @ ada_w[i] + ada_b[i]
        sh_m, sc_m, g_m, sh_f, sc_f, g_f = [m[:, None, :] for m in jnp.split(mod_l, 6, axis=-1)]
        csh_m, csc_m, cg_m, csh_f, csc_f, cg_f = jnp.split(mod_c, 6, axis=-1)
        h_l = modulate(rmsnorm(x, norm_mix_g[i]), sh_m, sc_m)
        h_c = modulate(rmsnorm(h_ctx_stream, norm_mix_g[i]), csh_m, csc_m)
        j = i // N_MIXERS
        if i % N_MIXERS == 0:
            y_l, y_c = window_gqa_mixer(h_l, h_c, attn_w_qkv[j], attn_w_o[j], attn_sinks[j], rope, not last)
        else:
            y_l, y_c = gla_mixer(h_l, h_c, gla_w_in[j], gla_w_a1[j], gla_w_a2[j], gla_b_a[j],
                                 gla_norm_g[j], gla_w_o[j], not last)
        x = x + g_m * y_l
        f_l = modulate(rmsnorm(x, norm_ffn_g[i]), sh_f, sc_f).reshape(B * S, D)
        if last:
            x = x + g_f * grouped_moe(f_l, router_w, router_b, moe_w_gate[i], moe_w_up[i],
                                      moe_w_down[i]).reshape(B, S, D)
        else:
            h_ctx_stream = h_ctx_stream + cg_m * y_c
            f_c = modulate(rmsnorm(h_ctx_stream, norm_ffn_g[i]), csh_f, csc_f).reshape(B * C, D)
            y_f = grouped_moe(jnp.concatenate([f_l, f_c], axis=0), router_w, router_b,
                              moe_w_gate[i], moe_w_up[i], moe_w_down[i])
            x = x + g_f * y_f[:B * S].reshape(B, S, D)
            h_ctx_stream = h_ctx_stream + cg_f * y_f[B * S:].reshape(B, C, D)
    return rmsnorm(x, final_g)
```

```cpp
#include <hip/hip_runtime.h>
#include <cstdio>
#include <cstdint>

#ifndef MK_N_LAUNCHES
#define MK_N_LAUNCHES 1
#endif

#ifndef PH_SEL
#define PH_SEL -1
#endif
#define PHE(k) (PH_SEL < 0 || PH_SEL == (k))
#define LAS __attribute__((address_space(3)))
#define GAS __attribute__((address_space(1)))
typedef unsigned short bf16_t;
typedef short bf16x8 __attribute__((ext_vector_type(8)));
typedef short s16x4 __attribute__((ext_vector_type(4)));
typedef float f32x4 __attribute__((ext_vector_type(4)));
typedef float f32x2 __attribute__((ext_vector_type(2)));
typedef float f32x16 __attribute__((ext_vector_type(16)));
typedef unsigned u32x4 __attribute__((ext_vector_type(4)));
typedef unsigned u32x2 __attribute__((ext_vector_type(2)));
#define DI __device__ __forceinline__

constexpr int D = 1024, NB = 32, SEQ = 2048, CTX = 256, DEPTH = 4;
constexpr int NL = NB * SEQ, NC = NB * CTX, MT = NL + NC;
constexpr int NQKV = 1536, NGIN = 3328;
constexpr int NCLS = 24;
constexpr float RMS_EPS = 1e-6f;
constexpr float QSCALE = 0.125f * 1.4426950408889634f;
constexpr float LOG2E = 1.4426950408889634f;

constexpr size_t MiB = (size_t)1 << 20;
constexpr size_t WS_CTL = 0, CTL_ZERO_BYTES = 1 * MiB;
constexpr size_t WS_MOD = 1 * MiB;
constexpr size_t WS_ROPE = 5 * MiB;
constexpr size_t WS_LIST = 6 * MiB;
constexpr size_t WS_GLIST = 13 * MiB;
constexpr size_t WS_R = 27 * MiB;
constexpr size_t WS_WQKV = 36 * MiB, WS_WO = 42 * MiB, WS_WIN = 46 * MiB, WS_WGO = 59 * MiB, WS_WGU = 63 * MiB, WS_WD = 191 * MiB;
constexpr size_t WS_XR = 256 * MiB;
constexpr size_t WS_H = 400 * MiB;
constexpr size_t WS_R2 = 544 * MiB;
static_assert(544 * MiB + 2 * ((size_t)73728 * 1024 * 2) == 832 * MiB, "R3 = R2 + 2 activations");
constexpr size_t WS_R3 = 832 * MiB;
constexpr size_t WS_END = 976 * MiB;
constexpr size_t ACT_BYTES = (size_t)MT * 1024 * 2;
constexpr int CW_BAR = 4096;
constexpr int CW_MOE = 16384;

constexpr int RING_BYTES = 131072;
constexpr int MISC_OFF = RING_BYTES;
constexpr int MOE_TAB_OFF = RING_BYTES + 256;
constexpr int LDS_BYTES = 147456;
constexpr int NWAVES = 8;

typedef __bf16 bf16x2_t __attribute__((ext_vector_type(2)));
DI unsigned cvt_pk_bf16(float lo, float hi) { f32x2 v = {lo, hi}; bf16x2_t b = __builtin_convertvector(v, bf16x2_t); return __builtin_bit_cast(unsigned, b); }
DI float bf_lo(unsigned w) { return __uint_as_float(w << 16); }
DI float bf_hi(unsigned w) { return __uint_as_float(w & 0xffff0000u); }
DI float wave_sum(float v) {
#pragma unroll
    for (int o = 1; o < 64; o <<= 1) v += __shfl_xor(v, o);
    return v;
}
DI float sigmoidf_(float x) { return 1.0f / (1.0f + __expf(-x)); }
DI float siluf_(float x) { return x / (1.0f + __expf(-x)); }
#define MFMA32(a, b, c) __builtin_amdgcn_mfma_f32_32x32x16_bf16((a), (b), (c), 0, 0, 0)
#define MFMA16(a, b, c) __builtin_amdgcn_mfma_f32_16x16x32_bf16((a), (b), (c), 0, 0, 0)
DI int crow(int r, int hi) { return (r & 3) + 8 * (r >> 2) + 4 * hi; }
DI bf16x8 pack8(const f32x16& x, int s) {
    u32x4 p; p[0] = cvt_pk_bf16(x[8 * s + 0], x[8 * s + 1]); p[1] = cvt_pk_bf16(x[8 * s + 2], x[8 * s + 3]); p[2] = cvt_pk_bf16(x[8 * s + 4], x[8 * s + 5]); p[3] = cvt_pk_bf16(x[8 * s + 6], x[8 * s + 7]);
    return __builtin_bit_cast(bf16x8, p);
}
DI s16x4 tr_read(const LAS unsigned char* p) { return __builtin_bit_cast(s16x4, __builtin_amdgcn_ds_read_tr16_b64_v4i16((LAS s16x4*)p)); }
DI bf16x8 cat4(s16x4 lo, s16x4 hi) { return __builtin_shufflevector(lo, hi, 0, 1, 2, 3, 4, 5, 6, 7); }

#define XB_TMO      128
#define XB_XCNT(j)  (256  + 64 * (j))
#define XB_XSUB(j)  (1280 + 64 * (j))
#define XB_XGEN(j)  (2304 + 64 * (j))
#define XB_TOP      3328
#define XB_TOPGEN   3392
#define XCD_BAR_WORDS 3456
#define XB_SPIN_CAP (1u << 18)
__device__ __forceinline__ unsigned xb_ld(unsigned* p)              { return __hip_atomic_load(p, __ATOMIC_RELAXED, __HIP_MEMORY_SCOPE_AGENT); }
__device__ __forceinline__ unsigned xb_add(unsigned* p, unsigned v) { return __hip_atomic_fetch_add(p, v, __ATOMIC_RELAXED, __HIP_MEMORY_SCOPE_AGENT); }
__device__ __forceinline__ unsigned xb_xcc_id() { return (unsigned)__builtin_amdgcn_s_getreg((3 << 11) | 20) & 0xFu; }
#define XB_SPIN(cond, bar) do { unsigned _sp = 0; while (cond) { __builtin_amdgcn_s_sleep(1); \
    if ((++_sp & 255u) == 0u) { if (xb_ld(&(bar)[XB_TMO])) break; if (_sp > XB_SPIN_CAP) { atomicAdd(&(bar)[XB_TMO], 1u); break; } } } } while (0)
struct XcdBarrier { unsigned* bar; unsigned x; volatile LAS unsigned* st; };
__device__ __forceinline__ XcdBarrier xcd_barrier_post(unsigned* bar, volatile LAS unsigned* st) {
    XcdBarrier b; b.bar = bar; b.x = xb_xcc_id(); b.st = st;
    if (threadIdx.x == 0) (void)xb_add(&bar[XB_XCNT(b.x)], 1u);
    return b;
}
__device__ __forceinline__ void xcd_barrier_complete(unsigned* bar, unsigned x, unsigned& nloc, unsigned& nx) {
    const unsigned G = gridDim.x * gridDim.y * gridDim.z;
    unsigned sum, cnt, mine, sp = 0u;
    for (;;) {
        sum = 0u; cnt = 0u; mine = 0u;
#pragma unroll
        for (unsigned j = 0; j < 16; ++j) { const unsigned c = xb_ld(&bar[XB_XCNT(j)]); sum += c; cnt += (c > 0u) ? 1u : 0u; mine = (j == x) ? c : mine; }
        if (sum == G) break;
        __builtin_amdgcn_s_sleep(1);
        if ((++sp & 255u) == 0u) { if (xb_ld(&bar[XB_TMO])) break; if (sp > XB_SPIN_CAP) { atomicAdd(&bar[XB_TMO], 1u); break; } }
    }
    nloc = mine > 0u ? mine : 1u; nx = cnt > 0u ? cnt : 1u;
}
__device__ __forceinline__ void xcd_barrier(const XcdBarrier& b) {
    asm volatile("s_waitcnt vmcnt(0)" ::: "memory");
    __syncthreads();
    if (threadIdx.x == 0) {
        unsigned* bar = b.bar;
        __builtin_amdgcn_s_waitcnt(0);
        unsigned nloc = b.st[0], nx = b.st[1];
        if (nloc == 0u) { xcd_barrier_complete(bar, b.x, nloc, nx); b.st[0] = nloc; b.st[1] = nx; }
        const unsigned old = xb_add(&bar[XB_XSUB(b.x)], 1u);
        const unsigned gen = old / nloc;
        if (old + 1u == (gen + 1u) * nloc) {
            __builtin_amdgcn_fence(__ATOMIC_RELEASE, "agent");
            asm volatile("s_waitcnt vmcnt(0)" ::: "memory");
            const unsigned og = xb_add(&bar[XB_TOP], 1u);
            const unsigned tg = og / nx;
            if (og + 1u == (tg + 1u) * nx) xb_add(&bar[XB_TOPGEN], 1u);
            else XB_SPIN(xb_ld(&bar[XB_TOPGEN]) == tg, bar);
            __builtin_amdgcn_fence(__ATOMIC_ACQUIRE, "agent");
            xb_add(&bar[XB_XGEN(b.x)], 1u);
            asm volatile("s_waitcnt vmcnt(0)" ::: "memory");
        } else {
            XB_SPIN(xb_ld(&bar[XB_XGEN(b.x)]) == gen, bar);
            __builtin_amdgcn_fence(__ATOMIC_ACQUIRE, "agent");
            asm volatile("s_waitcnt vmcnt(0)" ::: "memory");
        }
    }
    __syncthreads();
}

struct Frame {
    LAS unsigned char* lds;
    int tid, lane, wave, G;
};
DI Frame mkframe(LAS unsigned char* lds) { Frame F; int t = threadIdx.x; asm volatile("" : "+v"(t)); F.tid = t; F.lane = t & 63; F.wave = __builtin_amdgcn_readfirstlane(t >> 6); F.G = gridDim.x; F.lds = lds; return F; }
DI const void* karg(int slot) {
    const volatile __attribute__((address_space(4))) unsigned long long* ka = (const volatile __attribute__((address_space(4))) unsigned long long*)__builtin_amdgcn_kernarg_segment_ptr();
    return (const void*)ka[slot];
}
#define KIN(i) ((const float*)karg(i))
#define KOUT ((float*)karg(23))
#define KWS ((unsigned char*)karg(24))
enum { I_X = 0, I_C, I_CTX, I_CCTX, I_ADAW, I_ADAB, I_NMIX, I_NFFN, I_FINALG, I_WQKV, I_WO, I_SINKS, I_GWIN, I_GWA1, I_GWA2, I_GBA, I_GNORM, I_GWO, I_RW, I_RB, I_MG, I_MU, I_MD };

namespace pg8 {
constexpr int BM = 256, BK = 64, HALF = 128, HTB = HALF * BK * 2, STAGE_BYTES = 8 * HTB, NXCD = 8, WGM = 8;
__host__ __device__ __forceinline__ int lds_byte(int r, int c) { const int st = (r >> 4) * 2 + (c >> 5), rr = r & 15, cc = c & 31, ob = rr * 64 + cc * 2; return st * 1024 + (ob ^ (((ob >> 9) & 1) << 5)); }
__host__ __device__ __forceinline__ void stage_rc(int b, int& R, int& C) { const int st = b / 1024, sb = b % 1024, swz = sb ^ (((sb >> 9) & 1) << 5); R = (st >> 1) * 16 + swz / 64; C = (st & 1) * 32 + (swz % 64) / 2; }
__host__ __device__ __forceinline__ int perm32(int rho) { const int n = rho >> 4, i = rho & 15; return 8 * (i >> 2) + 4 * n + (i & 3); }
struct Unit { int pm, pn; };
DI bool static_next(int i, int G, int c, int nM, int nN, Unit& u) {
    const int nwg = nM * nN; const long L = (long)i * G + c; if (L >= nwg) return false;
    int wgid = (int)L; { const int q = nwg / NXCD, r = nwg % NXCD, xcd = wgid % NXCD, off = wgid / NXCD; wgid = (xcd < r ? xcd * (q + 1) : r * (q + 1) + (xcd - r) * q) + off; }
    const int nig = WGM * nN, gid = wgid / nig, fm = gid * WGM, gsz = (nM - fm) < WGM ? (nM - fm) : WGM;
    u.pm = fm + ((wgid % nig) % gsz); u.pn = (wgid % nig) / gsz; return true;
}
template <class Epi, class Sched>
__device__ __forceinline__ void gemm_phase(LAS unsigned char* lds, const char* Abase, const int K, const unsigned ldb, const Sched& S, const Epi& E) {
    int tid_ = threadIdx.x; asm volatile("" : "+v"(tid_));
    const int tid = tid_, wid = __builtin_amdgcn_readfirstlane(tid >> 6), lane = tid & 63, wr = wid >> 2, wc = wid & 3, fr = lane & 15, fq = lane >> 4;
    const int nt = K / BK;
    int Rr[2], Cc[2]; unsigned voffB[2];
#pragma unroll
    for (int i = 0; i < 2; ++i) { int R, C; stage_rc(tid * 16 + i * 8192, R, C); Rr[i] = R; Cc[i] = C; const int Rb = Epi::PERM ? ((R & ~31) + perm32(R & 31)) : R; voffB[i] = (unsigned)Rb * ldb + (unsigned)C * 2u; }
    const size_t kstep = (size_t)(BK * 2);
    const size_t hstepB = (size_t)HALF * ldb;
    const unsigned ldsw = (unsigned)wid * 1024u;
    const int aoff = lds_byte(wr * 64 + fr, fq * 8), boff = lds_byte(wc * 32 + fr, fq * 8);
#define PG8_SA(b, h) (((b) * 2 + (h)) * HTB)
#define PG8_SB(b, h) ((4 + (b) * 2 + (h)) * HTB)
#define PG8_STAGE_B(bufoff, gbase) do { _Pragma("unroll") for (int _i = 0; _i < 2; ++_i) \
        __builtin_amdgcn_global_load_lds((const unsigned*)((const char*)(gbase) + voffB[_i]), (LAS unsigned*)(lds + (bufoff) + ldsw + _i * 8192), 16, 0, 0); } while (0)
#define PG8_STAGE_A(bufoff, koff, offs) do { _Pragma("unroll") for (int _i = 0; _i < 2; ++_i) \
        __builtin_amdgcn_global_load_lds((const unsigned*)(Abase + (koff) + (offs)[_i]), (LAS unsigned*)(lds + (bufoff) + ldsw + _i * 8192), 16, 0, 0); } while (0)
#define PG8_LDA(dst, b, h) do { _Pragma("unroll") for (int m = 0; m < 4; ++m) _Pragma("unroll") for (int k = 0; k < 2; ++k) dst[m][k] = *(const LAS bf16x8*)(lds + PG8_SA(b, h) + aoff + m * 2048 + k * 1024); } while (0)
#define PG8_LDB(dst, b, h) do { _Pragma("unroll") for (int n = 0; n < 2; ++n) _Pragma("unroll") for (int k = 0; k < 2; ++k) dst[n][k] = *(const LAS bf16x8*)(lds + PG8_SB(b, h) + boff + n * 2048 + k * 1024); } while (0)
#define PG8_MMA(ai, bj, At, Bt) do { __builtin_amdgcn_s_setprio(1); _Pragma("unroll") for (int m = 0; m < 4; ++m) _Pragma("unroll") for (int n = 0; n < 2; ++n) _Pragma("unroll") for (int k = 0; k < 2; ++k) \
        acc[ai][bj][m][n] = __builtin_amdgcn_mfma_f32_16x16x32_bf16(Bt[n][k], At[m][k], acc[ai][bj][m][n], 0, 0, 0); __builtin_amdgcn_s_setprio(0); } while (0)
#define PG8_WAIT_V(n) asm volatile("s_waitcnt vmcnt(" #n ")" ::: "memory")
#define PG8_WAIT_L(n) asm volatile("s_waitcnt lgkmcnt(" #n ")" ::: "memory")
#define PG8_BAR __builtin_amdgcn_s_barrier()
#define PG8_SCHED __builtin_amdgcn_sched_barrier(0)
    Unit cur, nxt; int ui = 0;
    if (!S.next(0, cur)) return;
    f32x4 acc[2][2][4][2];
#pragma unroll
    for (int a = 0; a < 2; ++a)
#pragma unroll
        for (int b = 0; b < 2; ++b)
#pragma unroll
            for (int m = 0; m < 4; ++m)
#pragma unroll
                for (int n = 0; n < 2; ++n) acc[a][b][m][n] = (f32x4){0.f, 0.f, 0.f, 0.f};
    bf16x8 At[4][2], B0[2][2], B1[2][2];
    unsigned oC[2][2], oN[2][2], dN[2][2];
#pragma unroll
    for (int h = 0; h < 2; ++h)
#pragma unroll
        for (int i = 0; i < 2; ++i) { oC[h][i] = S.a_off(cur, h * HALF + Rr[i]) + (unsigned)Cc[i] * 2u; asm volatile("" : "+v"(oC[h][i])); }
    const char* cB = S.b_ptr(cur, 0);
    PG8_STAGE_B(PG8_SB(0, 0), cB); PG8_STAGE_B(PG8_SB(0, 1), cB + hstepB); PG8_STAGE_A(PG8_SA(0, 0), 0, oC[0]); PG8_STAGE_A(PG8_SA(0, 1), 0, oC[1]);
    if (wr == 1) PG8_BAR;
    PG8_WAIT_V(2); PG8_BAR;
    { const char* cB1 = S.b_ptr(cur, 1); PG8_STAGE_B(PG8_SB(1, 0), cB1); PG8_STAGE_A(PG8_SA(1, 0), kstep, oC[0]); PG8_STAGE_B(PG8_SB(1, 1), cB1 + hstepB); }
    PG8_WAIT_V(6); PG8_BAR;
    for (;;) {
        const bool has_next = S.next(ui + 1, nxt);
        if (!has_next) nxt = cur;
#pragma unroll
        for (int h = 0; h < 2; ++h)
#pragma unroll
            for (int i = 0; i < 2; ++i) { oN[h][i] = S.a_off(nxt, h * HALF + Rr[i]) + (unsigned)Cc[i] * 2u; asm volatile("" : "+v"(oN[h][i])); dN[h][i] = oN[h][i] - oC[h][i]; }
        for (int t = 0; t < nt; t += 2) {
            const bool last = (t == nt - 2);
            const size_t a1k = (size_t)(t + 1) * kstep;
            const size_t a2k = last ? 0 : (size_t)(t + 2) * kstep, a3k = a2k + kstep;
            const char* b2 = last ? S.b_ptr(nxt, 0) : S.b_ptr(cur, t + 2);
            const char* b3 = last ? S.b_ptr(nxt, 1) : S.b_ptr(cur, t + 3);
            const unsigned lm = last ? 0xffffffffu : 0u;
            unsigned o2[2][2];
            o2[0][0] = oC[0][0] + (dN[0][0] & lm); o2[0][1] = oC[0][1] + (dN[0][1] & lm); o2[1][0] = oC[1][0] + (dN[1][0] & lm); o2[1][1] = oC[1][1] + (dN[1][1] & lm);
            PG8_LDB(B0, 0, 0); PG8_LDB(B1, 0, 1); PG8_SCHED; PG8_LDA(At, 0, 0); PG8_STAGE_A(PG8_SA(1, 1), a1k, oC[1]);
            PG8_WAIT_V(8); PG8_WAIT_L(0); PG8_BAR; PG8_MMA(0, 0, At, B0); PG8_MMA(0, 1, At, B1); PG8_BAR; PG8_SCHED;
            PG8_LDA(At, 0, 1); PG8_STAGE_B(PG8_SB(0, 0), b2); PG8_STAGE_B(PG8_SB(0, 1), b2 + hstepB); PG8_STAGE_A(PG8_SA(0, 0), a2k, o2[0]);
            PG8_WAIT_V(8); PG8_WAIT_L(0); PG8_BAR; PG8_MMA(1, 0, At, B0); PG8_MMA(1, 1, At, B1); PG8_BAR; PG8_SCHED;
            PG8_LDB(B0, 1, 0); PG8_LDB(B1, 1, 1); PG8_SCHED; PG8_LDA(At, 1, 0); PG8_STAGE_A(PG8_SA(0, 1), a2k, o2[1]);
            PG8_WAIT_V(8); PG8_WAIT_L(0); PG8_BAR; PG8_MMA(0, 0, At, B0); PG8_MMA(0, 1, At, B1); PG8_BAR; PG8_SCHED;
            PG8_LDA(At, 1, 1); PG8_STAGE_B(PG8_SB(1, 0), b3); PG8_STAGE_B(PG8_SB(1, 1), b3 + hstepB); PG8_STAGE_A(PG8_SA(1, 0), a3k, o2[0]);
            PG8_WAIT_V(8); PG8_WAIT_L(0); PG8_BAR; PG8_MMA(1, 0, At, B0); PG8_MMA(1, 1, At, B1); PG8_BAR; PG8_SCHED;
        }
        if (wr == 0) PG8_BAR;
        E(acc, cur, wr, wc, fr, fq);
        if (!has_next) break;
#pragma unroll
        for (int a = 0; a < 2; ++a)
#pragma unroll
            for (int b = 0; b < 2; ++b)
#pragma unroll
                for (int m = 0; m < 4; ++m)
#pragma unroll
                    for (int n = 0; n < 2; ++n) acc[a][b][m][n] = (f32x4){0.f, 0.f, 0.f, 0.f};
        cur = nxt; ++ui;
#pragma unroll
        for (int h = 0; h < 2; ++h)
#pragma unroll
            for (int i = 0; i < 2; ++i) oC[h][i] = oN[h][i];
        if (wr == 1) PG8_BAR;
    }
    PG8_WAIT_V(0);
    PG8_BAR;
#undef PG8_SA
#undef PG8_SB
#undef PG8_STAGE_A
#undef PG8_STAGE_B
#undef PG8_LDA
#undef PG8_LDB
#undef PG8_MMA
#undef PG8_WAIT_V
#undef PG8_WAIT_L
#undef PG8_BAR
#undef PG8_SCHED
}
}
using pg8::Unit;

struct DenseOrder {
    int nM, nN, G, c; unsigned lda; const char* Bt; unsigned ldb;
    DI bool next(int i, Unit& u) const { return pg8::static_next(i, G, c, nM, nN, u); }
    DI unsigned a_off(const Unit& u, int row) const { return (unsigned)(u.pm * 256 + row) * lda; }
    DI const char* b_ptr(const Unit& u, int t) const { return Bt + (size_t)u.pn * 256 * ldb + (size_t)t * 128; }
};
DI int moe_class(const LAS int* bs, int pm) { int c = 0;
#pragma unroll
    for (int k = 1; k < NCLS; ++k) c += (bs[k] <= pm) ? 1 : 0;
    return c; }
DI void moe_experts(int c, int& elo, int& ehi) { const int g = c / 6, p = c - 6 * g; const int lo = p < 3 ? 0 : (p < 5 ? 1 : 2), hi = p < 3 ? p + 1 : (p < 5 ? p - 1 : 3); elo = 4 * g + lo; ehi = 4 * g + hi; }
struct MoeUpOrder {
    int nM, G, c; const LAS int* bs; const LAS int* cnt; const int* list; const char* Wgu;
    DI bool next(int i, Unit& u) const { return pg8::static_next(i, G, c, nM, 8, u); }
    DI unsigned a_off(const Unit& u, int row) const {
        const int cl = moe_class(bs, u.pm); const int slot = (u.pm - bs[cl]) * 256 + row;
        int tok = 0; if (slot < cnt[cl]) tok = list[(size_t)cl * MT + slot];
        return (unsigned)tok * 2048u; }
    DI const char* b_ptr(const Unit& u, int t) const {
        const int cl = moe_class(bs, u.pm); int elo, ehi; moe_experts(cl, elo, ehi); const int e = u.pn < 4 ? elo : ehi;
        return Wgu + (size_t)e * (1024 * 1024 * 2) + (size_t)(u.pn & 3) * 256 * 2048 + (size_t)t * 128; }
};
struct MoeDownOrder {
    int nM, G, c; const LAS int* bs; const char* Wd;
    DI bool next(int i, Unit& u) const { return pg8::static_next(i, G, c, nM, 4, u); }
    DI unsigned a_off(const Unit& u, int row) const { return (unsigned)(u.pm * 256 + row) * 2048u; }
    DI const char* b_ptr(const Unit& u, int t) const {
        const int cl = moe_class(bs, u.pm); int elo, ehi; moe_experts(cl, elo, ehi); const int e = t < 8 ? elo : ehi;
        return Wd + (size_t)e * (1024 * 512 * 2) + (size_t)u.pn * 256 * 1024 + (size_t)(t & 7) * 128; }
};

struct EpiQKV {
    static constexpr bool PERM = false;
    bf16_t* P; const float* rope;
    DI void operator()(const f32x4 (&acc)[2][2][4][2], const Unit& u, int wr, int wc, int fr, int fq) const {
        const int row0 = u.pm * 256 + wr * 64 + fr; const bool lat = u.pm < 256; const bool dorope = lat && u.pn < 5; const float sc = u.pn < 4 ? QSCALE : 1.0f;
#pragma unroll
        for (int ai = 0; ai < 2; ++ai)
#pragma unroll
            for (int m = 0; m < 4; ++m) { const int row = row0 + ai * 128 + m * 16; const int t = row & 2047; const int pos = (wc & 1) ? (t & 63) : (t >> 6);
                f32x4 cs = (f32x4){1.f, 1.f, 1.f, 1.f}, sn = (f32x4){0.f, 0.f, 0.f, 0.f};
                if (dorope) { cs = *(const f32x4*)(rope + pos * 32 + 4 * fq); sn = *(const f32x4*)(rope + pos * 32 + 16 + 4 * fq); }
                bf16_t* rowp = P + (size_t)row * NQKV + u.pn * 256 + wc * 32 + 4 * fq;
#pragma unroll
                for (int bj = 0; bj < 2; ++bj) { const f32x4 y1 = acc[ai][bj][m][0], y2 = acc[ai][bj][m][1];
                    const f32x4 o1 = (y1 * cs - y2 * sn) * sc, o2 = (y2 * cs + y1 * sn) * sc;
                    u32x2 w1, w2; w1.x = cvt_pk_bf16(o1[0], o1[1]); w1.y = cvt_pk_bf16(o1[2], o1[3]); w2.x = cvt_pk_bf16(o2[0], o2[1]); w2.y = cvt_pk_bf16(o2[2], o2[3]);
                    *(u32x2*)(rowp + bj * 128) = w1; *(u32x2*)(rowp + bj * 128 + 16) = w2; } }
    }
};
struct EpiGLA {
    static constexpr bool PERM = true;
    bf16_t* R2b; float* R;
    DI void operator()(const f32x4 (&acc)[2][2][4][2], const Unit& u, int wr, int wc, int fr, int fq) const {
        const int row0 = u.pm * 256 + wr * 64 + fr;
        if (u.pn == 12) { if (wc == 0) {
#pragma unroll
            for (int ai = 0; ai < 2; ++ai)
#pragma unroll
                for (int m = 0; m < 4; ++m) { float* rp = R + (size_t)(row0 + ai * 128 + m * 16) * 32 + 8 * fq; *(f32x4*)rp = acc[ai][0][m][0]; *(f32x4*)(rp + 4) = acc[ai][0][m][1]; } }
            return; }
        const int tsel = u.pn < 4 ? 0 : (u.pn < 8 ? 2 : 1);
        bf16_t* base = R2b + (size_t)tsel * ((size_t)MT * 1024); const int colt = (u.pn & 3) * 256; const float sc = u.pn < 2 ? 0.08838834764831845f : 1.0f;
#pragma unroll
        for (int ai = 0; ai < 2; ++ai)
#pragma unroll
            for (int m = 0; m < 4; ++m) { bf16_t* rowp = base + (size_t)(row0 + ai * 128 + m * 16) * 1024 + colt + wc * 32 + 8 * fq;
#pragma unroll
                for (int bj = 0; bj < 2; ++bj) { const f32x4 v0 = acc[ai][bj][m][0] * sc, v1 = acc[ai][bj][m][1] * sc;
                    u32x4 w; w.x = cvt_pk_bf16(v0[0], v0[1]); w.y = cvt_pk_bf16(v0[2], v0[3]); w.z = cvt_pk_bf16(v1[0], v1[1]); w.w = cvt_pk_bf16(v1[2], v1[3]);
                    *(u32x4*)(rowp + bj * 128) = w; } }
    }
};
struct EpiRes {
    static constexpr bool PERM = true;
    bf16_t* XR; const float* gate;
    DI void operator()(const f32x4 (&acc)[2][2][4][2], const Unit& u, int wr, int wc, int fr, int fq) const {
        const int row0 = u.pm * 256 + wr * 64 + fr; const int mb = u.pm < 256 ? (u.pm >> 3) : 32; const int col0 = u.pn * 256 + wc * 32 + 8 * fq;
        f32x4 gv[2][2];
#pragma unroll
        for (int bj = 0; bj < 2; ++bj)
#pragma unroll
            for (int n = 0; n < 2; ++n) gv[bj][n] = *(const f32x4*)(gate + (size_t)mb * 6144 + col0 + bj * 128 + 4 * n);
#pragma unroll
        for (int ai = 0; ai < 2; ++ai)
#pragma unroll
            for (int m = 0; m < 4; ++m) { bf16_t* rowp = XR + (size_t)(row0 + ai * 128 + m * 16) * 1024 + col0;
#pragma unroll
                for (int bj = 0; bj < 2; ++bj) { const u32x4 xo = *(const u32x4*)(rowp + bj * 128);
                    const f32x4 a0 = acc[ai][bj][m][0] * gv[bj][0], a1 = acc[ai][bj][m][1] * gv[bj][1];
                    u32x4 w; w.x = cvt_pk_bf16(bf_lo(xo.x) + a0[0], bf_hi(xo.x) + a0[1]); w.y = cvt_pk_bf16(bf_lo(xo.y) + a0[2], bf_hi(xo.y) + a0[3]);
                    w.z = cvt_pk_bf16(bf_lo(xo.z) + a1[0], bf_hi(xo.z) + a1[1]); w.w = cvt_pk_bf16(bf_lo(xo.w) + a1[2], bf_hi(xo.w) + a1[3]);
                    *(u32x4*)(rowp + bj * 128) = w; } }
    }
};
struct EpiSwiGLU {
    static constexpr bool PERM = true;
    bf16_t* HID; const LAS int* bs; const LAS int* cnt; const f32x2* glist;
    DI void operator()(const f32x4 (&acc)[2][2][4][2], const Unit& u, int wr, int wc, int fr, int fq) const {
        const int cl = moe_class(bs, u.pm); const int slot0 = (u.pm - bs[cl]) * 256, n = cnt[cl]; const int sel = u.pn >> 2, hb = u.pn & 3;
        const int r0 = wr * 64 + fr;
#pragma unroll
        for (int ai = 0; ai < 2; ++ai)
#pragma unroll
            for (int m = 0; m < 4; ++m) { const int r = r0 + ai * 128 + m * 16; const int slot = slot0 + r; float gw = 0.f;
                if (slot < n) { const f32x2 gg = glist[(size_t)cl * MT + slot]; gw = sel ? gg.y : gg.x; }
                const f32x4 a0 = acc[ai][0][m][0], a1 = acc[ai][0][m][1], b0 = acc[ai][1][m][0], b1 = acc[ai][1][m][1];
                float h[8];
#pragma unroll
                for (int e = 0; e < 4; ++e) { h[e] = siluf_(a0[e]) * b0[e] * gw; h[4 + e] = siluf_(a1[e]) * b1[e] * gw; }
                u32x4 w; w.x = cvt_pk_bf16(h[0], h[1]); w.y = cvt_pk_bf16(h[2], h[3]); w.z = cvt_pk_bf16(h[4], h[5]); w.w = cvt_pk_bf16(h[6], h[7]);
                *(u32x4*)(HID + (size_t)(u.pm * 256 + r) * 1024 + sel * 512 + hb * 128 + wc * 32 + 8 * fq) = w; }
    }
};
struct EpiDown {
    static constexpr bool PERM = true;
    bf16_t* XR; const float* gate; const LAS int* bs; const LAS int* cnt; const int* list;
    DI void operator()(const f32x4 (&acc)[2][2][4][2], const Unit& u, int wr, int wc, int fr, int fq) const {
        const int cl = moe_class(bs, u.pm); const int slot0 = (u.pm - bs[cl]) * 256, n = cnt[cl]; const int col0 = u.pn * 256 + wc * 32 + 8 * fq; const int r0 = wr * 64 + fr;
#pragma unroll
        for (int ai = 0; ai < 2; ++ai)
#pragma unroll
            for (int m = 0; m < 4; ++m) { const int slot = slot0 + r0 + ai * 128 + m * 16;
                if (slot < n) { const int tok = list[(size_t)cl * MT + slot]; const int mb = tok < NL ? (tok >> 11) : 32; const float* gp = gate + (size_t)mb * 6144 + col0; bf16_t* rowp = XR + (size_t)tok * 1024 + col0;
#pragma unroll
                    for (int bj = 0; bj < 2; ++bj) { const u32x4 xo = *(const u32x4*)(rowp + bj * 128); const f32x4 g0 = *(const f32x4*)(gp + bj * 128), g1 = *(const f32x4*)(gp + bj * 128 + 4);
                        const f32x4 a0 = acc[ai][bj][m][0] * g0, a1 = acc[ai][bj][m][1] * g1;
                        u32x4 w; w.x = cvt_pk_bf16(bf_lo(xo.x) + a0[0], bf_hi(xo.x) + a0[1]); w.y = cvt_pk_bf16(bf_lo(xo.y) + a0[2], bf_hi(xo.y) + a0[3]);
                        w.z = cvt_pk_bf16(bf_lo(xo.z) + a1[0], bf_hi(xo.z) + a1[1]); w.w = cvt_pk_bf16(bf_lo(xo.w) + a1[2], bf_hi(xo.w) + a1[3]);
                        *(u32x4*)(rowp + bj * 128) = w; } } }
    }
};

DI void transpose_item(const float* W, int ldw, bf16_t* WT, int Kd, int k0, int n0, int drow0, LAS float* scr, int lane) {
#pragma unroll 8
    for (int i = 0; i < 32; ++i) { const int kk = 2 * i + (lane >> 5); scr[kk * 33 + (lane & 31)] = W[(size_t)(k0 + kk) * ldw + n0 + (lane & 31)]; }
    asm volatile("s_waitcnt lgkmcnt(0)" ::: "memory");
    const int c = lane & 7;
#pragma unroll
    for (int j = 0; j < 4; ++j) { const int n = (lane >> 3) + 8 * j; const LAS float* s = scr + (8 * c) * 33 + n;
        u32x4 o; o.x = cvt_pk_bf16(s[0 * 33], s[1 * 33]); o.y = cvt_pk_bf16(s[2 * 33], s[3 * 33]); o.z = cvt_pk_bf16(s[4 * 33], s[5 * 33]); o.w = cvt_pk_bf16(s[6 * 33], s[7 * 33]);
        *(u32x4*)(WT + (size_t)(drow0 + n) * Kd + k0 + 8 * c) = o; }
    asm volatile("s_waitcnt lgkmcnt(0)" ::: "memory");
}
DI void p0_prologue(Frame& F) {
    unsigned char* const ws = KWS;
    const int gw = blockIdx.x * NWAVES + F.wave, NGW = F.G * NWAVES;
    const int gtid = blockIdx.x * 512 + F.tid, NT = F.G * 512;
    {
        LAS float* scr = (LAS float*)(F.lds + F.wave * 16384);
        constexpr int I_QKV = 16 * 48, I_O = 16 * 32, I_IN = 16 * 96, I_E = 16 * 16, I_D = 8 * 32;
        constexpr int N_DENSE = 2 * (I_QKV + I_O + I_IN + I_O);
        constexpr int N_ITEMS = N_DENSE + 64 * (2 * I_E + I_D);
        for (int it = gw; it < N_ITEMS; it += NGW) {
            int r = it;
            if (r < N_DENSE) {
                const int j = r & 1; r >>= 1;
                if (r < I_QKV) { const int kb = r / 48, nb = r % 48; transpose_item(KIN(I_WQKV) + (size_t)j * 1024 * NQKV, NQKV, ((bf16_t*)(ws + WS_WQKV)) + (size_t)j * NQKV * 1024, 1024, 64 * kb, 32 * nb, 32 * nb, scr, F.lane); continue; } r -= I_QKV;
                if (r < I_O) { const int kb = r / 32, nb = r % 32; transpose_item(KIN(I_WO) + (size_t)j * 1024 * 1024, 1024, ((bf16_t*)(ws + WS_WO)) + (size_t)j * 1024 * 1024, 1024, 64 * kb, 32 * nb, 32 * nb, scr, F.lane); continue; } r -= I_O;
                if (r < I_IN) { const int kb = r / 96, nb = r % 96; transpose_item(KIN(I_GWIN) + (size_t)j * 1024 * 3072, 3072, ((bf16_t*)(ws + WS_WIN)) + (size_t)j * NGIN * 1024, 1024, 64 * kb, 32 * nb, 32 * nb, scr, F.lane); continue; } r -= I_IN;
                { const int kb = r / 32, nb = r % 32; transpose_item(KIN(I_GWO) + (size_t)j * 1024 * 1024, 1024, ((bf16_t*)(ws + WS_WGO)) + (size_t)j * 1024 * 1024, 1024, 64 * kb, 32 * nb, 32 * nb, scr, F.lane); continue; }
            }
            r -= N_DENSE;
            const int le = r / (2 * I_E + I_D); r -= le * (2 * I_E + I_D);
            if (r < 2 * I_E) { const int up = r >= I_E; if (up) r -= I_E; const int kb = r / 16, nb = r % 16; const int n0 = 32 * nb;
                transpose_item((up ? KIN(I_MU) : KIN(I_MG)) + (size_t)le * 1024 * 512, 512, ((bf16_t*)(ws + WS_WGU)) + (size_t)le * 1024 * 1024, 1024, 64 * kb, n0, (n0 >> 7) * 256 + up * 128 + (n0 & 127), scr, F.lane); continue; }
            r -= 2 * I_E;
            { const int kb = r / 32, nb = r % 32; transpose_item(KIN(I_MD) + (size_t)le * 512 * 1024, 1024, ((bf16_t*)(ws + WS_WD)) + (size_t)le * 1024 * 512, 512, 64 * kb, 32 * nb, 32 * nb, scr, F.lane); }
        }
        { const float* wa1 = KIN(I_GWA1); bf16_t* Winp = ((bf16_t*)(ws + WS_WIN));
        for (int idx = gtid; idx < 2 * 256 * 1024; idx += NT) { const int j = idx >> 18, rr = (idx >> 10) & 255, k = idx & 1023;
            float v = 0.f; if (rr < 32) v = wa1[(((size_t)j * 2 + (rr >> 4)) * 1024 + k) * 16 + (rr & 15)];
            Winp[((size_t)j * NGIN + 3072 + rr) * 1024 + k] = (bf16_t)(cvt_pk_bf16(v, 0.f) & 0xffffu); } }
    }
    __syncthreads();
    {
        LAS float* sl = (LAS float*)F.lds;
        LAS float* red = (LAS float*)(F.lds + 40960);
        float* modp = ((float*)(ws + WS_MOD));
        for (int it = blockIdx.x; it < 4 * 96; it += F.G) {
            const int l = it / 96, n0 = (it % 96) * 64;
            const float* W = KIN(I_ADAW) + (size_t)l * 1024 * 6144 + n0 + F.lane; const float* cin = KIN(I_C); const float* ccin = KIN(I_CCTX); const float* adab = KIN(I_ADAB);
            float acc[33];
#pragma unroll
            for (int i = 0; i < 33; ++i) acc[i] = 0.f;
            for (int kc = 0; kc < 4; ++kc) {
                __syncthreads();
                for (int idx = F.tid; idx < 33 * 256; idx += 512) { const int mb = idx >> 8, k = idx & 255; const float cv = mb < 32 ? cin[mb * 1024 + kc * 256 + k] : ccin[kc * 256 + k]; sl[k * 36 + mb] = siluf_(cv); }
                __syncthreads();
                for (int kk = 0; kk < 32; ++kk) { const int k = F.wave * 32 + kk; const float wv = W[(size_t)(kc * 256 + k) * 6144];
                    const LAS f32x4* sp = (const LAS f32x4*)(sl + k * 36);
#pragma unroll
                    for (int q = 0; q < 8; ++q) { const f32x4 s4 = sp[q]; acc[4 * q] += s4[0] * wv; acc[4 * q + 1] += s4[1] * wv; acc[4 * q + 2] += s4[2] * wv; acc[4 * q + 3] += s4[3] * wv; }
                    acc[32] += sl[k * 36 + 32] * wv; }
            }
#pragma unroll
            for (int i = 0; i < 33; ++i) red[(F.wave * 33 + i) * 64 + F.lane] = acc[i];
            __syncthreads();
            for (int idx = F.tid; idx < 33 * 64; idx += 512) { const int mb = idx >> 6, nn = idx & 63; float s = 0.f;
#pragma unroll
                for (int w = 0; w < 8; ++w) s += red[(w * 33 + mb) * 64 + nn];
                modp[((size_t)l * 33 + mb) * 6144 + n0 + nn] = s + adab[l * 6144 + n0 + nn]; }
            __syncthreads();
        }
    }
    { const float* xin = KIN(I_X); const float* cxin = KIN(I_CTX); bf16_t* XRp = ((bf16_t*)(ws + WS_XR));
    for (size_t ch = gtid; ch < (size_t)MT * 128; ch += NT) { const size_t row = ch >> 7; const int c8 = (int)(ch & 127) * 8;
        const float* src = row < NL ? xin + row * 1024 + c8 : cxin + (row - NL) * 1024 + c8;
        const f32x4 a = *(const f32x4*)src, b = *(const f32x4*)(src + 4);
        u32x4 w; w.x = cvt_pk_bf16(a[0], a[1]); w.y = cvt_pk_bf16(a[2], a[3]); w.z = cvt_pk_bf16(b[0], b[1]); w.w = cvt_pk_bf16(b[2], b[3]);
        *(u32x4*)(XRp + row * 1024 + c8) = w; } }
    if (blockIdx.x == 0) { float* ropep = ((float*)(ws + WS_ROPE)); for (int idx = F.tid; idx < 64 * 16; idx += 512) { const int pos = idx >> 4, j = idx & 15;
        const float inv = __builtin_amdgcn_exp2f(-(float)j * 0.8304820237218406f); const float ang = (float)pos * inv;
        const float kq = rintf(ang * 0.15915494309189535f); float r = fmaf(-kq, 6.28318548202514648f, ang); r = fmaf(-kq, -1.7484556000744883e-7f, r);
        ropep[pos * 32 + j] = cosf(r); ropep[pos * 32 + 16 + j] = sinf(r); } }
}

template <bool ROUTER>
DI void norm_phase(Frame& F, int layer) {
    unsigned char* const ws = KWS;
    const float* gain = (ROUTER ? KIN(I_NFFN) : KIN(I_NMIX)) + layer * 1024;
    const float* modl = (const float*)(ws + WS_MOD) + (size_t)layer * 33 * 6144 + (ROUTER ? 3 * 1024 : 0);
    const bf16_t* XRp = (const bf16_t*)(ws + WS_XR); bf16_t* Hp = (bf16_t*)(ws + WS_H);
    const int RPB = (MT + F.G - 1) / F.G, RPW = (RPB + 7) / 8;
    const int brow0 = blockIdx.x * RPB; int bend = brow0 + RPB; if (bend > MT) bend = MT;
    const int row0 = brow0 + F.wave * RPW; int rend = row0 + RPW; if (rend > bend) rend = bend;
    LAS float* RW = (LAS float*)F.lds;
    LAS float* WL = (LAS float*)(F.lds + 67584) + F.wave * 16;
    LAS int* lcnt = (LAS int*)(F.lds + 68096); LAS int* lbase = (LAS int*)(F.lds + 68224);
    LAS int* rec = (LAS int*)(F.lds + 68352); LAS f32x2* recg = (LAS f32x2*)(F.lds + 72448);
    float rb[16];
    if (ROUTER) {
        const float* rwp = KIN(I_RW); const float* rbp = KIN(I_RB);
        for (int idx = F.tid; idx < 1024 * 16; idx += 512) { const int col = idx >> 4, e = idx & 15; RW[(col >> 3) * 132 + (col & 7) * 16 + e] = rwp[idx]; }
        if (F.tid < 32) lcnt[F.tid] = 0;
#pragma unroll
        for (int e = 0; e < 16; ++e) rb[e] = rbp[e];
        __syncthreads();
    }
    float gs[16], sh[16]; int mb = -1;
    const int c0 = 8 * F.lane;
    for (int row = row0; row < rend; ++row) {
        const int mbn = row < NL ? (row >> 11) : 32;
        if (mbn != mb) { mb = mbn; const float* mp = modl + (size_t)mb * 6144;
#pragma unroll
            for (int hh = 0; hh < 2; ++hh)
#pragma unroll
                for (int q = 0; q < 2; ++q) { const int cc = hh * 512 + c0 + 4 * q; const f32x4 g4 = *(const f32x4*)(gain + cc), s4 = *(const f32x4*)(mp + 1024 + cc), h4 = *(const f32x4*)(mp + cc);
#pragma unroll
                    for (int e = 0; e < 4; ++e) { gs[hh * 8 + q * 4 + e] = g4[e] * (1.0f + s4[e]); sh[hh * 8 + q * 4 + e] = h4[e]; } } }
        const bf16_t* xr = XRp + (size_t)row * 1024;
        const u32x4 xa = *(const u32x4*)(xr + c0), xb = *(const u32x4*)(xr + 512 + c0);
        float v[16];
        v[0] = bf_lo(xa.x); v[1] = bf_hi(xa.x); v[2] = bf_lo(xa.y); v[3] = bf_hi(xa.y); v[4] = bf_lo(xa.z); v[5] = bf_hi(xa.z); v[6] = bf_lo(xa.w); v[7] = bf_hi(xa.w);
        v[8] = bf_lo(xb.x); v[9] = bf_hi(xb.x); v[10] = bf_lo(xb.y); v[11] = bf_hi(xb.y); v[12] = bf_lo(xb.z); v[13] = bf_hi(xb.z); v[14] = bf_lo(xb.w); v[15] = bf_hi(xb.w);
        float ss = 0.f;
#pragma unroll
        for (int e = 0; e < 16; ++e) ss += v[e] * v[e];
        ss = wave_sum(ss);
        const float rstd = 1.0f / sqrtf(ss * (1.0f / 1024.0f) + RMS_EPS);
#pragma unroll
        for (int e = 0; e < 16; ++e) v[e] = v[e] * rstd * gs[e] + sh[e];
        u32x4 oa, ob; oa.x = cvt_pk_bf16(v[0], v[1]); oa.y = cvt_pk_bf16(v[2], v[3]); oa.z = cvt_pk_bf16(v[4], v[5]); oa.w = cvt_pk_bf16(v[6], v[7]);
        ob.x = cvt_pk_bf16(v[8], v[9]); ob.y = cvt_pk_bf16(v[10], v[11]); ob.z = cvt_pk_bf16(v[12], v[13]); ob.w = cvt_pk_bf16(v[14], v[15]);
        bf16_t* hr = Hp + (size_t)row * 1024; *(u32x4*)(hr + c0) = oa; *(u32x4*)(hr + 512 + c0) = ob;
        if (ROUTER) {
            float pl[16];
#pragma unroll
            for (int e = 0; e < 16; ++e) pl[e] = 0.f;
#pragma unroll
            for (int jj = 0; jj < 16; ++jj) { const LAS f32x4* wp = (const LAS f32x4*)(RW + ((jj >> 3) * 64 + F.lane) * 132 + (jj & 7) * 16);
#pragma unroll
                for (int q = 0; q < 4; ++q) { const f32x4 w4 = wp[q]; pl[4 * q] += v[jj] * w4[0]; pl[4 * q + 1] += v[jj] * w4[1]; pl[4 * q + 2] += v[jj] * w4[2]; pl[4 * q + 3] += v[jj] * w4[3]; } }
            float v8[8], v4[4], v2[2], v1;
            { const bool bt = (F.lane >> 5) & 1;
#pragma unroll
              for (int i = 0; i < 8; ++i) { const float mine = bt ? pl[8 + i] : pl[i], theirs = bt ? pl[i] : pl[8 + i]; v8[i] = mine + __shfl_xor(theirs, 32); } }
            { const bool bt = (F.lane >> 4) & 1;
#pragma unroll
              for (int i = 0; i < 4; ++i) { const float mine = bt ? v8[4 + i] : v8[i], theirs = bt ? v8[i] : v8[4 + i]; v4[i] = mine + __shfl_xor(theirs, 16); } }
            { const bool bt = (F.lane >> 3) & 1;
#pragma unroll
              for (int i = 0; i < 2; ++i) { const float mine = bt ? v4[2 + i] : v4[i], theirs = bt ? v4[i] : v4[2 + i]; v2[i] = mine + __shfl_xor(theirs, 8); } }
            { const bool bt = (F.lane >> 2) & 1; const float mine = bt ? v2[1] : v2[0], theirs = bt ? v2[0] : v2[1]; v1 = mine + __shfl_xor(theirs, 4); }
            v1 += __shfl_xor(v1, 2); v1 += __shfl_xor(v1, 1);
            if ((F.lane & 3) == 0) WL[((F.lane >> 5) & 1) * 8 + ((F.lane >> 4) & 1) * 4 + ((F.lane >> 3) & 1) * 2 + ((F.lane >> 2) & 1)] = v1;
            asm volatile("s_waitcnt lgkmcnt(0)" ::: "memory");
            float sc[16], sel[16];
#pragma unroll
            for (int q = 0; q < 4; ++q) { const f32x4 l4 = ((const LAS f32x4*)WL)[q];
#pragma unroll
                for (int e = 0; e < 4; ++e) { sc[4 * q + e] = sigmoidf_(l4[e]); sel[4 * q + e] = sc[4 * q + e] + rb[4 * q + e]; } }
            asm volatile("s_waitcnt lgkmcnt(0)" ::: "memory");
            int grp = 0; float best = -1e30f;
#pragma unroll
            for (int g = 0; g < 4; ++g) { const float a = sel[4 * g], b = sel[4 * g + 1], c = sel[4 * g + 2], d = sel[4 * g + 3];
                const float m1 = fmaxf(fmaxf(a, b), fmaxf(c, d)); const float lo1 = fminf(a, b), hi1 = fmaxf(a, b), lo2 = fminf(c, d), hi2 = fmaxf(c, d);
                const float m2 = fmaxf(fminf(hi1, hi2), fmaxf(lo1, lo2)); const float gsum = m1 + m2;
                if (gsum > best) { best = gsum; grp = g; } }
            float s4[4], c4[4];
#pragma unroll
            for (int e = 0; e < 4; ++e) { s4[e] = grp == 0 ? sel[e] : (grp == 1 ? sel[4 + e] : (grp == 2 ? sel[8 + e] : sel[12 + e])); c4[e] = grp == 0 ? sc[e] : (grp == 1 ? sc[4 + e] : (grp == 2 ? sc[8 + e] : sc[12 + e])); }
            int i1 = 0; float b1 = s4[0];
#pragma unroll
            for (int e = 1; e < 4; ++e) if (s4[e] > b1) { b1 = s4[e]; i1 = e; }
            int i2 = -1; float b2 = -1e30f;
#pragma unroll
            for (int e = 0; e < 4; ++e) if (e != i1 && s4[e] > b2) { b2 = s4[e]; i2 = e; }
            const float g1 = i1 == 0 ? c4[0] : (i1 == 1 ? c4[1] : (i1 == 2 ? c4[2] : c4[3])), g2 = i2 == 0 ? c4[0] : (i2 == 1 ? c4[1] : (i2 == 2 ? c4[2] : c4[3]));
            const float inv = 1.0f / (g1 + g2);
            const int lo = i1 < i2 ? i1 : i2, hi = i1 < i2 ? i2 : i1;
            const int pidx = lo == 0 ? hi - 1 : (lo == 1 ? hi + 1 : 5);
            const int cls = grp * 6 + pidx;
            const float glo = (i1 < i2 ? g1 : g2) * inv, ghi = (i1 < i2 ? g2 : g1) * inv;
            if (F.lane == 0) { const int sl_ = __hip_atomic_fetch_add(lcnt + cls, 1, __ATOMIC_RELAXED, __HIP_MEMORY_SCOPE_WORKGROUP); const int rbi = row - brow0; rec[rbi] = cls | (sl_ << 8); recg[rbi] = (f32x2){glo, ghi}; }
        }
    }
    if (ROUTER) {
        __syncthreads();
        if (F.tid < NCLS) { const int n = lcnt[F.tid]; int base = 0; if (n > 0) base = (int)__hip_atomic_fetch_add((unsigned*)ws + CW_MOE + 32 * layer + F.tid, (unsigned)n, __ATOMIC_RELAXED, __HIP_MEMORY_SCOPE_AGENT); lbase[F.tid] = base; }
        __syncthreads();
        int* listp = (int*)(ws + WS_LIST); f32x2* glistp = (f32x2*)(ws + WS_GLIST);
        for (int rbi = F.tid; rbi < bend - brow0; rbi += 512) { const int rc = rec[rbi]; const int cls = rc & 0xff; const int slot = lbase[cls] + (rc >> 8);
            listp[(size_t)cls * MT + slot] = brow0 + rbi; glistp[(size_t)cls * MT + slot] = recg[rbi]; }
        __syncthreads();
    }
}

DI void attn_phase(Frame& F, int j) {
    unsigned char* const ws = KWS; const bf16_t* P = (const bf16_t*)(ws + WS_R2); bf16_t* O = (bf16_t*)(ws + WS_R3); const float* sinks = KIN(I_SINKS);
    const int lane = F.lane, wave = F.wave, tid = F.tid, r32 = lane & 31, hi = lane >> 5;
    const int g = wave & 3, qh = wave >> 2;
    LAS unsigned char* KB = F.lds; LAS unsigned char* VB = F.lds + 2 * 18432;
    const int i16 = lane & 15, tq = i16 >> 2, tp = i16 & 3, blk = (lane >> 4) & 1;
    const int nunits = 2048 + 256;
    for (int u = blockIdx.x; u < nunits; u += F.G) {
        int b, kvh, qb; bool isctx;
        if (u < 2048) { isctx = false; b = u >> 6; kvh = (u >> 4) & 3; qb = u & 15; } else { const int v = u - 2048; isctx = true; b = v >> 3; kvh = (v >> 1) & 3; qb = v & 1; }
        const int s = qb * 128;
        const int qrow0 = isctx ? (NL + b * CTX + s) : (b * SEQ + s);
        int klo = 0, nwin = 0;
        if (!isctx) { klo = s - 128 < 0 ? 0 : s - 128; int khi = s + 256 > SEQ ? SEQ : s + 256; nwin = (khi - klo) >> 7; }
        const int nch = nwin + 2;
        const int hq = kvh * 4 + g;
        bf16x8 qf[2][4];
#pragma unroll
        for (int gr = 0; gr < 2; ++gr) { const bf16_t* qp = P + (size_t)(qrow0 + 64 * qh + 32 * gr + r32) * NQKV + hq * 64 + 8 * hi;
#pragma unroll
            for (int ks = 0; ks < 4; ++ks) qf[gr][ks] = *(const bf16x8*)(qp + 16 * ks); }
        const float sink2 = sinks[j * 16 + hq] * LOG2E;
        float mrun[2], lrun[2]; f32x16 o[2][2];
#pragma unroll
        for (int gr = 0; gr < 2; ++gr) { mrun[gr] = sink2; lrun[gr] = hi == 0 ? 1.0f : 0.0f;
#pragma unroll
            for (int d0 = 0; d0 < 2; ++d0)
#pragma unroll
                for (int i = 0; i < 16; ++i) o[gr][d0][i] = 0.f; }
        u32x4 kst[2], vst[2];
#define ATT_CHROW(ch) ((ch) < nwin ? (b * SEQ + klo + 128 * (ch)) : (NL + b * CTX + 128 * ((ch) - nwin)))
#define ATT_LOAD(ch) do { const int cr_ = ATT_CHROW(ch); _Pragma("unroll") for (int i_ = 0; i_ < 2; ++i_) { const int p_ = tid + 512 * i_; const bf16_t* src_ = P + (size_t)(cr_ + (p_ >> 3)) * NQKV + 1024 + kvh * 64 + (p_ & 7) * 8; \
            kst[i_] = *(const u32x4*)src_; vst[i_] = *(const u32x4*)(src_ + 256); } } while (0)
#define ATT_STORE(bufi) do { _Pragma("unroll") for (int i_ = 0; i_ < 2; ++i_) { const int p_ = tid + 512 * i_; const int off_ = (bufi) * 18432 + (p_ >> 3) * 144 + (p_ & 7) * 16; \
            *(LAS u32x4*)(KB + off_) = kst[i_]; *(LAS u32x4*)(VB + off_) = vst[i_]; } } while (0)
        __syncthreads();
        ATT_LOAD(0); ATT_STORE(0);
        __syncthreads();
        for (int ch = 0; ch < nch; ++ch) {
            const int buf = ch & 1;
            if (ch + 1 < nch) ATT_LOAD(ch + 1);
            const bool masked = ch < nwin; const int kpos0 = klo + 128 * ch;
            const LAS unsigned char* kb = KB + buf * 18432; const LAS unsigned char* vb = VB + buf * 18432;
#pragma unroll 1
            for (int kt = 0; kt < 4; ++kt) {
                bf16x8 kf[4];
#pragma unroll
                for (int ks = 0; ks < 4; ++ks) kf[ks] = *(const LAS bf16x8*)(kb + (32 * kt + r32) * 144 + (16 * ks + 8 * hi) * 2);
                bf16x8 vf[2][2];
#pragma unroll
                for (int d0 = 0; d0 < 2; ++d0)
#pragma unroll
                    for (int s2 = 0; s2 < 2; ++s2) { const LAS unsigned char* vp = vb + (32 * kt + 16 * s2 + 4 * hi + tq) * 144 + (32 * d0 + 16 * blk + 4 * tp) * 2;
                        vf[d0][s2] = cat4(tr_read(vp), tr_read(vp + 8 * 144)); }
#pragma unroll
                for (int gr = 0; gr < 2; ++gr) {
                    f32x16 st;
#pragma unroll
                    for (int i = 0; i < 16; ++i) st[i] = 0.f;
#pragma unroll
                    for (int ks = 0; ks < 4; ++ks) st = MFMA32(kf[ks], qf[gr][ks], st);
                    if (masked) { const int qpos = s + 64 * qh + 32 * gr + r32; const int kb0 = kpos0 + 32 * kt + 4 * hi;
#pragma unroll
                        for (int i = 0; i < 16; ++i) { const int dlt = qpos - (kb0 + (i & 3) + 8 * (i >> 2)); if (dlt > 128 || dlt < -128) st[i] = -1e30f; } }
                    float tmax = st[0];
#pragma unroll
                    for (int i = 1; i < 16; ++i) tmax = fmaxf(tmax, st[i]);
                    tmax = fmaxf(tmax, __shfl_xor(tmax, 32));
                    const float mnew = fmaxf(mrun[gr], tmax); const float alpha = __builtin_amdgcn_exp2f(mrun[gr] - mnew); mrun[gr] = mnew;
                    float psum = 0.f;
#pragma unroll
                    for (int i = 0; i < 16; ++i) { st[i] = __builtin_amdgcn_exp2f(st[i] - mnew); psum += st[i]; }
                    lrun[gr] = lrun[gr] * alpha + psum;
#pragma unroll
                    for (int d0 = 0; d0 < 2; ++d0)
#pragma unroll
                        for (int i = 0; i < 16; ++i) o[gr][d0][i] *= alpha;
                    const bf16x8 p0 = pack8(st, 0), p1 = pack8(st, 1);
#pragma unroll
                    for (int d0 = 0; d0 < 2; ++d0) { o[gr][d0] = MFMA32(vf[d0][0], p0, o[gr][d0]); o[gr][d0] = MFMA32(vf[d0][1], p1, o[gr][d0]); }
                }
            }
            if (ch + 1 < nch) ATT_STORE(buf ^ 1);
            __syncthreads();
        }
#pragma unroll
        for (int gr = 0; gr < 2; ++gr) { const float lt = lrun[gr] + __shfl_xor(lrun[gr], 32); const float inv = 1.0f / lt;
            bf16_t* op = O + (size_t)(qrow0 + 64 * qh + 32 * gr + r32) * 1024 + hq * 64 + 4 * hi;
#pragma unroll
            for (int d0 = 0; d0 < 2; ++d0)
#pragma unroll
                for (int i4 = 0; i4 < 4; ++i4) { u32x2 w; w.x = cvt_pk_bf16(o[gr][d0][4 * i4] * inv, o[gr][d0][4 * i4 + 1] * inv); w.y = cvt_pk_bf16(o[gr][d0][4 * i4 + 2] * inv, o[gr][d0][4 * i4 + 3] * inv);
                    *(u32x2*)(op + 32 * d0 + 8 * i4) = w; } }
    }
#undef ATT_CHROW
#undef ATT_LOAD
#undef ATT_STORE
}

DI void gla_phase(Frame& F, int j) {
    unsigned char* const ws = KWS; const bf16_t* QK = (const bf16_t*)(ws + WS_R2); const bf16_t* GV = (const bf16_t*)(ws + WS_R3); bf16_t* const OBp = (bf16_t*)KOUT;
    const float* wa2g = KIN(I_GWA2); const float* bag = KIN(I_GBA); const float* rbuf = (const float*)(ws + WS_R);
    const int lane = F.lane, wave = F.wave, tid = F.tid, r32 = lane & 31, hi = lane >> 5;
    const int i16 = lane & 15, tq = i16 >> 2, tp = i16 & 3, blk = (lane >> 4) & 1;
    LAS unsigned char* QD = F.lds; LAS unsigned char* KD = F.lds + 17408; LAS unsigned char* KZ = F.lds + 34816; LAS unsigned char* VT = F.lds + 52224; LAS unsigned char* PT = F.lds + 86016;
    LAS float* RR = (LAS float*)(F.lds + 95232); LAS float* SEG = (LAS float*)(F.lds + 99328); LAS float* DEC = (LAS float*)(F.lds + 103424);
    LAS float* WA2 = (LAS float*)(F.lds + 103936); LAS float* BA = (LAS float*)(F.lds + 112128);
    const int kp = tid & 63, seg = tid >> 6;
    for (int u = blockIdx.x; u < 256; u += F.G) {
        const int b = u >> 3, hd = (u >> 1) & 3, dir = u & 1;
        bf16_t* OUT = dir ? OBp : (bf16_t*)(ws + WS_H);
        __syncthreads();
        for (int idx = tid; idx < 16 * 128; idx += 512) WA2[idx] = wa2g[(((size_t)j * 2 + dir) * 16 + (idx >> 7)) * 512 + hd * 128 + (idx & 127)];
        if (tid < 128) BA[tid] = bag[((size_t)j * 2 + dir) * 512 + hd * 128 + tid];
        f32x16 S[4];
#pragma unroll
        for (int kb = 0; kb < 4; ++kb)
#pragma unroll
            for (int i = 0; i < 16; ++i) S[kb][i] = 0.f;
        for (int cj = 0; cj < 36; ++cj) {
            int tbase, sgn;
            if (cj < 4) { tbase = NL + b * CTX + (dir ? 255 - 64 * cj : 64 * cj); } else { tbase = b * SEQ + (dir ? 2047 - 64 * (cj - 4) : 64 * (cj - 4)); }
            sgn = dir ? -1 : 1;
            __syncthreads();
#pragma unroll
            for (int i = 0; i < 4; ++i) { const int p = tid + 512 * i; const int tau = p >> 5, c16 = p & 31; const int tok = tbase + sgn * tau;
                *(LAS u32x4*)(VT + tau * 528 + c16 * 16) = *(const u32x4*)(GV + (size_t)tok * 1024 + hd * 256 + c16 * 8); }
            if (tid < 256) { const int tau = tid >> 2, c4 = tid & 3; const int tok = tbase + sgn * tau; *(LAS f32x4*)(RR + tau * 16 + c4 * 4) = *(const f32x4*)(rbuf + (size_t)tok * 32 + dir * 16 + c4 * 4); }
            unsigned q2[8], k2[8];
#pragma unroll
            for (int e = 0; e < 8; ++e) { const int tok = tbase + sgn * (8 * seg + e); const bf16_t* qp = QK + (size_t)tok * 1024 + hd * 128 + 2 * kp; q2[e] = *(const unsigned*)qp; k2[e] = *(const unsigned*)(qp + 512); }
            __syncthreads();
            float bl[8][2];
            { float wa[16][2];
#pragma unroll
              for (int r = 0; r < 16; ++r) { const f32x2 w2 = *(const LAS f32x2*)(WA2 + r * 128 + 2 * kp); wa[r][0] = w2[0]; wa[r][1] = w2[1]; }
              const f32x2 ba2 = *(const LAS f32x2*)(BA + 2 * kp);
              float run0 = 0.f, run1 = 0.f;
#pragma unroll
              for (int e = 0; e < 8; ++e) { const LAS f32x4* rp = (const LAS f32x4*)(RR + (8 * seg + e) * 16); float x0 = ba2[0], x1 = ba2[1];
#pragma unroll
                  for (int q = 0; q < 4; ++q) { const f32x4 r4 = rp[q];
#pragma unroll
                      for (int c = 0; c < 4; ++c) { x0 += r4[c] * wa[4 * q + c][0]; x1 += r4[c] * wa[4 * q + c][1]; } }
                  const float g0 = (fminf(x0, 0.f) - __logf(1.0f + __expf(-fabsf(x0)))) * 0.0625f, g1 = (fminf(x1, 0.f) - __logf(1.0f + __expf(-fabsf(x1)))) * 0.0625f;
                  run0 += g0; run1 += g1; bl[e][0] = run0; bl[e][1] = run1; }
              *(LAS f32x2*)(SEG + seg * 128 + 2 * kp) = (f32x2){run0, run1}; }
            __syncthreads();
            { float off0 = 0.f, off1 = 0.f, tot0 = 0.f, tot1 = 0.f;
#pragma unroll
              for (int s2 = 0; s2 < 8; ++s2) { const f32x2 t2 = *(const LAS f32x2*)(SEG + s2 * 128 + 2 * kp); if (s2 < seg) { off0 += t2[0]; off1 += t2[1]; } tot0 += t2[0]; tot1 += t2[1]; }
              if (seg == 0) *(LAS f32x2*)(DEC + 2 * kp) = (f32x2){__expf(tot0), __expf(tot1)};
#pragma unroll
              for (int e = 0; e < 8; ++e) { const float b0 = bl[e][0] + off0, b1 = bl[e][1] + off1; const float q0 = bf_lo(q2[e]), q1 = bf_hi(q2[e]), k0 = bf_lo(k2[e]), k1 = bf_hi(k2[e]);
                  const float e0 = __expf(b0), e1 = __expf(b1), n0 = __expf(fminf(-b0, 60.f)), n1 = __expf(fminf(-b1, 60.f)), z0 = __expf(tot0 - b0), z1 = __expf(tot1 - b1);
                  const int ro = (8 * seg + e) * 272 + 4 * kp;
                  *(LAS unsigned*)(QD + ro) = cvt_pk_bf16(q0 * e0, q1 * e1); *(LAS unsigned*)(KD + ro) = cvt_pk_bf16(k0 * n0, k1 * n1); *(LAS unsigned*)(KZ + ro) = cvt_pk_bf16(k0 * z0, k1 * z1); } }
            __syncthreads();
            { const int ti = wave >> 1;
#pragma unroll
              for (int uu = 0; uu < 2; ++uu) { const int sj = 2 * (wave & 1) + uu; f32x4 a4 = (f32x4){0.f, 0.f, 0.f, 0.f};
#pragma unroll
                  for (int kk = 0; kk < 4; ++kk) { const bf16x8 af = *(const LAS bf16x8*)(KD + (16 * sj + i16) * 272 + (32 * kk + 8 * (lane >> 4)) * 2), bfr = *(const LAS bf16x8*)(QD + (16 * ti + i16) * 272 + (32 * kk + 8 * (lane >> 4)) * 2);
                      a4 = MFMA16(af, bfr, a4); }
                  const int t = 16 * ti + i16, s0 = 16 * sj + 4 * (lane >> 4);
                  float pv[4];
#pragma unroll
                  for (int i = 0; i < 4; ++i) pv[i] = (s0 + i <= t) ? a4[i] : 0.f;
                  u32x2 w; w.x = cvt_pk_bf16(pv[0], pv[1]); w.y = cvt_pk_bf16(pv[2], pv[3]);
                  *(LAS u32x2*)(PT + t * 144 + s0 * 2) = w; } }
            __syncthreads();
            bf16x8 vfr[4];
#pragma unroll
            for (int ss = 0; ss < 4; ++ss) { const LAS unsigned char* vp = VT + (16 * ss + 8 * hi + tq) * 528 + (32 * wave + 16 * blk + 4 * tp) * 2; vfr[ss] = cat4(tr_read(vp), tr_read(vp + 4 * 528)); }
            f32x16 oT[2];
#pragma unroll
            for (int tb = 0; tb < 2; ++tb)
#pragma unroll
                for (int i = 0; i < 16; ++i) oT[tb][i] = 0.f;
#pragma unroll
            for (int kb = 0; kb < 4; ++kb)
#pragma unroll
                for (int s2 = 0; s2 < 2; ++s2) { const bf16x8 ap = pack8(S[kb], s2);
#pragma unroll
                    for (int tb = 0; tb < 2; ++tb) { const LAS unsigned char* qp = QD + (32 * tb + r32) * 272 + (32 * kb + 16 * s2 + 4 * hi) * 2;
                        const bf16x8 bq = cat4(*(const LAS s16x4*)qp, *(const LAS s16x4*)(qp + 16)); oT[tb] = MFMA32(ap, bq, oT[tb]); } }
#pragma unroll
            for (int tb = 0; tb < 2; ++tb)
#pragma unroll
                for (int ss = 0; ss < 4; ++ss) { if (tb == 0 && ss >= 2) continue;
                    const bf16x8 bp = *(const LAS bf16x8*)(PT + (32 * tb + r32) * 144 + (16 * ss + 8 * hi) * 2); oT[tb] = MFMA32(vfr[ss], bp, oT[tb]); }
#pragma unroll
            for (int tb = 0; tb < 2; ++tb) { const int tok = tbase + sgn * (32 * tb + r32); bf16_t* op = OUT + (size_t)tok * 1024 + hd * 256 + 32 * wave + 4 * hi;
#pragma unroll
                for (int i4 = 0; i4 < 4; ++i4) { u32x2 w; w.x = cvt_pk_bf16(oT[tb][4 * i4], oT[tb][4 * i4 + 1]); w.y = cvt_pk_bf16(oT[tb][4 * i4 + 2], oT[tb][4 * i4 + 3]); *(u32x2*)(op + 8 * i4) = w; } }
#pragma unroll
            for (int kb = 0; kb < 4; ++kb) {
#pragma unroll
                for (int i4 = 0; i4 < 4; ++i4) { const f32x4 d4 = *(const LAS f32x4*)(DEC + 32 * kb + 8 * i4 + 4 * hi);
#pragma unroll
                    for (int e = 0; e < 4; ++e) S[kb][4 * i4 + e] *= d4[e]; }
#pragma unroll
                for (int ss = 0; ss < 4; ++ss) { const LAS unsigned char* zp = KZ + (16 * ss + 8 * hi + tq) * 272 + (32 * kb + 16 * blk + 4 * tp) * 2;
                    const bf16x8 az = cat4(tr_read(zp), tr_read(zp + 4 * 272)); S[kb] = MFMA32(az, vfr[ss], S[kb]); } }
        }
    }
}

DI void gla_norm_phase(Frame& F, int j) {
    unsigned char* const ws = KWS; const bf16_t* OFW = (const bf16_t*)(ws + WS_H); const bf16_t* OBW = (const bf16_t*)KOUT; const bf16_t* GB = (const bf16_t*)(ws + WS_R2) + (size_t)MT * 1024; bf16_t* A2 = (bf16_t*)(ws + WS_R2);
    const int gw = blockIdx.x * NWAVES + F.wave, NGW = F.G * NWAVES;
    const f32x4 ng = *(const f32x4*)(KIN(I_GNORM) + j * 256 + 4 * F.lane);
    for (int row = gw; row < MT; row += NGW) {
#pragma unroll
        for (int hh = 0; hh < 4; ++hh) { const size_t off = (size_t)row * 1024 + hh * 256 + 4 * F.lane;
            const u32x2 a = *(const u32x2*)(OFW + off), bq = *(const u32x2*)(OBW + off), gg = *(const u32x2*)(GB + off);
            float ov[4] = {bf_lo(a.x) + bf_lo(bq.x), bf_hi(a.x) + bf_hi(bq.x), bf_lo(a.y) + bf_lo(bq.y), bf_hi(a.y) + bf_hi(bq.y)};
            const float gv[4] = {bf_lo(gg.x), bf_hi(gg.x), bf_lo(gg.y), bf_hi(gg.y)};
            float ss = ov[0] * ov[0] + ov[1] * ov[1] + ov[2] * ov[2] + ov[3] * ov[3];
            ss = wave_sum(ss);
            const float rstd = 1.0f / sqrtf(ss * (1.0f / 256.0f) + RMS_EPS);
#pragma unroll
            for (int e = 0; e < 4; ++e) ov[e] = ov[e] * rstd * ng[e] * siluf_(gv[e]);
            u32x2 w; w.x = cvt_pk_bf16(ov[0], ov[1]); w.y = cvt_pk_bf16(ov[2], ov[3]);
            *(u32x2*)(A2 + off) = w; }
    }
}

DI void final_phase(Frame& F) {
    unsigned char* const ws = KWS; const bf16_t* XRp = (const bf16_t*)(ws + WS_XR); float* outp = KOUT; const float* fg = KIN(I_FINALG);
    const int gw = blockIdx.x * NWAVES + F.wave, NGW = F.G * NWAVES; const int c0 = 8 * F.lane;
    float gn[16];
#pragma unroll
    for (int hh = 0; hh < 2; ++hh)
#pragma unroll
        for (int q = 0; q < 2; ++q) { const f32x4 g4 = *(const f32x4*)(fg + hh * 512 + c0 + 4 * q);
#pragma unroll
            for (int e = 0; e < 4; ++e) gn[hh * 8 + q * 4 + e] = g4[e]; }
    for (int row = gw; row < NL; row += NGW) {
        const bf16_t* xr = XRp + (size_t)row * 1024;
        const u32x4 xa = *(const u32x4*)(xr + c0), xb = *(const u32x4*)(xr + 512 + c0);
        float v[16];
        v[0] = bf_lo(xa.x); v[1] = bf_hi(xa.x); v[2] = bf_lo(xa.y); v[3] = bf_hi(xa.y); v[4] = bf_lo(xa.z); v[5] = bf_hi(xa.z); v[6] = bf_lo(xa.w); v[7] = bf_hi(xa.w);
        v[8] = bf_lo(xb.x); v[9] = bf_hi(xb.x); v[10] = bf_lo(xb.y); v[11] = bf_hi(xb.y); v[12] = bf_lo(xb.z); v[13] = bf_hi(xb.z); v[14] = bf_lo(xb.w); v[15] = bf_hi(xb.w);
        float ss = 0.f;
#pragma unroll
        for (int e = 0; e < 16; ++e) ss += v[e] * v[e];
        ss = wave_sum(ss);
        const float rstd = 1.0f / sqrtf(ss * (1.0f / 1024.0f) + RMS_EPS);
        float* op = outp + (size_t)row * 1024;
#pragma unroll
        for (int hh = 0; hh < 2; ++hh)
#pragma unroll
            for (int q = 0; q < 2; ++q) { f32x4 o4;
#pragma unroll
                for (int e = 0; e < 4; ++e) o4[e] = v[hh * 8 + q * 4 + e] * rstd * gn[hh * 8 + q * 4 + e];
                *(f32x4*)(op + hh * 512 + c0 + 4 * q) = o4; }
    }
}

DI int moe_table(Frame& F, int layer) {
    LAS int* bs = (LAS int*)(F.lds + MOE_TAB_OFF); LAS int* cnt = bs + 32;
    __syncthreads();
    if (F.tid < NCLS) cnt[F.tid] = (int)__hip_atomic_load((unsigned*)KWS + CW_MOE + 32 * layer + F.tid, __ATOMIC_RELAXED, __HIP_MEMORY_SCOPE_AGENT);
    __syncthreads();
    if (F.tid == 0) { int a = 0; for (int k = 0; k < NCLS; ++k) { bs[k] = a; a += (cnt[k] + 255) >> 8; } bs[NCLS] = a; }
    __syncthreads();
    return bs[NCLS];
}

struct Args { const float* in[23]; float* out; unsigned char* ws; int ph_lo, ph_hi; };
constexpr int PH_PER_LAYER = 8, N_PHASES = 1 + DEPTH * PH_PER_LAYER + 1;

__global__ void __launch_bounds__(NWAVES * 64, 2) fwd_kernel(Args args) {
    extern __shared__ __attribute__((aligned(16))) unsigned char lds[];
    LAS unsigned char* const ldsb = (LAS unsigned char*)lds;
    for (int u = threadIdx.x; u < (LDS_BYTES - MISC_OFF) / 4; u += NWAVES * 64) ((LAS unsigned*)(ldsb + MISC_OFF))[u] = 0u;
    __syncthreads();
    const int lo = args.ph_lo, hi = args.ph_hi;
    XcdBarrier bar; bar.bar = nullptr; bar.x = 0; bar.st = (volatile LAS unsigned*)(ldsb + MISC_OFF) + 8;
    if (hi - lo > 1) bar = xcd_barrier_post((unsigned*)KWS + CW_BAR, (volatile LAS unsigned*)(ldsb + MISC_OFF) + 8);
#define IN(k) (lo <= (k) && (k) < hi)
#define SEAM(k) do { if (IN(k) && IN((k) + 1)) { bar.bar = (unsigned*)KWS + CW_BAR; xcd_barrier(bar); } } while (0)

    if (PHE(0) && IN(0)) { Frame F = mkframe(ldsb); p0_prologue(F); }
    SEAM(0);
#pragma unroll 1
    for (int layer = 0; layer < DEPTH; ++layer) {
        const int pb = 1 + layer * PH_PER_LAYER; const int j = layer >> 1; const bool gla = layer & 1;
        if (PHE(1) && IN(pb + 0)) { Frame F = mkframe(ldsb); norm_phase<false>(F, layer); }
        SEAM(pb + 0);
        if (IN(pb + 1)) { Frame F = mkframe(ldsb);
            if (PHE(2) && !gla) { unsigned char* const ws = KWS;
                DenseOrder S{MT / 256, NQKV / 256, F.G, (int)blockIdx.x, 2048u, (const char*)(ws + WS_WQKV) + (size_t)j * NQKV * 2048, 2048u}; EpiQKV E{(bf16_t*)(ws + WS_R2), (const float*)(ws + WS_ROPE)};
                pg8::gemm_phase<EpiQKV, DenseOrder>(F.lds, (const char*)(ws + WS_H), 1024, 2048u, S, E); }
            else if (PHE(3) && gla) { unsigned char* const ws = KWS;
                DenseOrder S{MT / 256, NGIN / 256, F.G, (int)blockIdx.x, 2048u, (const char*)(ws + WS_WIN) + (size_t)j * NGIN * 2048, 2048u};
                EpiGLA E{(bf16_t*)(ws + WS_R2), (float*)(ws + WS_R)};
                pg8::gemm_phase<EpiGLA, DenseOrder>(F.lds, (const char*)(ws + WS_H), 1024, 2048u, S, E); }
        }
        SEAM(pb + 1);
        if (IN(pb + 2)) { Frame F = mkframe(ldsb); if (PHE(4) && !gla) attn_phase(F, j); else if (PHE(5) && gla) gla_phase(F, j); }
        SEAM(pb + 2);
        if (PHE(6) && IN(pb + 3)) { Frame F = mkframe(ldsb); if (gla) gla_norm_phase(F, j); }
        SEAM(pb + 3);
        if (PHE(7) && IN(pb + 4)) { Frame F = mkframe(ldsb); unsigned char* const ws = KWS;
            const char* A = (const char*)(ws + (gla ? WS_R2 : WS_R3)); const char* W = (const char*)(ws + (gla ? WS_WGO : WS_WO)) + (size_t)j * 1024 * 2048;
            DenseOrder S{MT / 256, 4, F.G, (int)blockIdx.x, 2048u, W, 2048u}; EpiRes E{(bf16_t*)(ws + WS_XR), (const float*)(ws + WS_MOD) + (size_t)layer * 33 * 6144 + 2 * 1024};
            pg8::gemm_phase<EpiRes, DenseOrder>(F.lds, A, 1024, 2048u, S, E);
        }
        SEAM(pb + 4);
        if (PHE(8) && IN(pb + 5)) { Frame F = mkframe(ldsb); norm_phase<true>(F, layer); }
        SEAM(pb + 5);
        if (PHE(9) && IN(pb + 6)) { Frame F = mkframe(ldsb);
            const int nblk = moe_table(F, layer); const LAS int* bs = (const LAS int*)(F.lds + MOE_TAB_OFF); unsigned char* const ws = KWS;
            MoeUpOrder S{nblk, F.G, (int)blockIdx.x, bs, bs + 32, (const int*)(ws + WS_LIST), (const char*)(ws + WS_WGU) + (size_t)layer * 16 * 1024 * 2048}; EpiSwiGLU E{(bf16_t*)(ws + WS_R2), bs, bs + 32, (const f32x2*)(ws + WS_GLIST)};
            pg8::gemm_phase<EpiSwiGLU, MoeUpOrder>(F.lds, (const char*)(ws + WS_H), 1024, 2048u, S, E);
        }
        SEAM(pb + 6);
        if (PHE(10) && IN(pb + 7)) { Frame F = mkframe(ldsb);
            const int nblk = moe_table(F, layer); const LAS int* bs = (const LAS int*)(F.lds + MOE_TAB_OFF); unsigned char* const ws = KWS;
            MoeDownOrder S{nblk, F.G, (int)blockIdx.x, bs, (const char*)(ws + WS_WD) + (size_t)layer * 16 * 1024 * 1024}; EpiDown E{(bf16_t*)(ws + WS_XR), (const float*)(ws + WS_MOD) + (size_t)layer * 33 * 6144 + 5 * 1024, bs, bs + 32, (const int*)(ws + WS_LIST)};
            pg8::gemm_phase<EpiDown, MoeDownOrder>(F.lds, (const char*)(ws + WS_R2), 1024, 1024u, S, E);
        }
        SEAM(pb + 7);
    }
    if (PHE(11) && IN(N_PHASES - 1)) { Frame F = mkframe(ldsb); final_phase(F); }
#undef IN
#undef SEAM
}

extern "C" void kernel_launch(void* const* d_in, const int* in_sizes, int n_in, void* d_out, int out_size, void* d_ws, size_t ws_size, hipStream_t stream) {
    static int grid = 0;
    if (grid == 0) {
        if (n_in != 23 || out_size != NL * D || ws_size < WS_END) { fprintf(stderr, "kernel_launch: unexpected shapes (n_in %d, out %d, ws %zu; need ws >= %zu)\n", n_in, out_size, ws_size, (size_t)WS_END); grid = -1; return; }
        int dev = 0, cus = 0, per_cu = 0;
        if (hipGetDevice(&dev) != hipSuccess || hipDeviceGetAttribute(&cus, hipDeviceAttributeMultiprocessorCount, dev) != hipSuccess) { grid = -1; return; }
        if (hipFuncSetAttribute((const void*)fwd_kernel, hipFuncAttributeMaxDynamicSharedMemorySize, LDS_BYTES) != hipSuccess) { fprintf(stderr, "kernel_launch: hipFuncSetAttribute failed\n"); grid = -1; return; }
        if (hipOccupancyMaxActiveBlocksPerMultiprocessor(&per_cu, (const void*)fwd_kernel, NWAVES * 64, LDS_BYTES) != hipSuccess || per_cu < 1) { fprintf(stderr, "kernel_launch: occupancy query reports %d blocks per CU\n", per_cu); }
        (void)hipGetLastError();
        grid = cus;
        if (grid < 128) { fprintf(stderr, "kernel_launch: too few CUs (%d)\n", grid); grid = -1; return; }
    }
    if (grid < 0) return;
    (void)in_sizes;
    if (hipMemsetAsync((char*)d_ws + WS_CTL, 0, CTL_ZERO_BYTES, stream) != hipSuccess) return;
    Args a{};
    for (int i = 0; i < 23; ++i) a.in[i] = (const float*)d_in[i];
    a.out = (float*)d_out; a.ws = (unsigned char*)d_ws;
#if MK_N_LAUNCHES == 1
    a.ph_lo = 0; a.ph_hi = N_PHASES;
    hipLaunchKernelGGL(fwd_kernel, dim3(grid), dim3(NWAVES * 64), LDS_BYTES, stream, a);
#else
    for (int p = 0; p < N_PHASES; ++p) {
        if (p >= 1 && p < N_PHASES - 1) { const int s = (p - 1) % PH_PER_LAYER, layer = (p - 1) / PH_PER_LAYER; if (s == 3 && !(layer & 1)) continue; }
        a.ph_lo = p; a.ph_hi = p + 1;
        hipLaunchKernelGGL(fwd_kernel, dim3(grid), dim3(NWAVES * 64), LDS_BYTES, stream, a);
    }
#endif
}
```

```cpp
#include <hip/hip_runtime.h>
#include <cstdio>
#include <cstdint>

#ifndef PROBE_MASK
#define PROBE_MASK 0
#endif
#define PROBE_AMP 4
#ifndef PROBE_GEMM
#define PROBE_GEMM 0
#endif
#ifndef PROBE_ATT
#define PROBE_ATT 0
#endif
#ifndef PROBE_SCAN
#define PROBE_SCAN 0
#endif
#ifndef GEMM_STAGGER_TICKS
#define GEMM_STAGGER_TICKS 0
#endif
#ifndef MK_N_LAUNCHES
#define MK_N_LAUNCHES 1
#endif

#ifndef PH_SEL
#define PH_SEL -1
#endif
#define PHE(k) (PH_SEL < 0 || PH_SEL == (k))
#define LAS __attribute__((address_space(3)))
#define GAS __attribute__((address_space(1)))
#define LDS_BAR() asm volatile("s_waitcnt lgkmcnt(0)\n\ts_barrier" ::: "memory")
typedef unsigned short bf16_t;
typedef short bf16x8 __attribute__((ext_vector_type(8)));
typedef short s16x4 __attribute__((ext_vector_type(4)));
typedef float f32x4 __attribute__((ext_vector_type(4)));
typedef float f32x2 __attribute__((ext_vector_type(2)));
typedef float f32x16 __attribute__((ext_vector_type(16)));
typedef unsigned u32x4 __attribute__((ext_vector_type(4)));
typedef unsigned u32x2 __attribute__((ext_vector_type(2)));
typedef int i32x4 __attribute__((ext_vector_type(4)));
typedef int i32x8 __attribute__((ext_vector_type(8)));
#define DI __device__ __forceinline__

constexpr int D = 1024, NB = 32, SEQ = 2048, CTX = 256, DEPTH = 4;
constexpr int NL = NB * SEQ, NC = NB * CTX, MT = NL + NC;
constexpr int NQKV = 1536, NGIN = 3328;
constexpr int NCLS = 24;
constexpr float RMS_EPS = 1e-6f;
constexpr float QSCALE = 0.125f * 1.4426950408889634f;
constexpr float LOG2E = 1.4426950408889634f;

constexpr size_t MiB = (size_t)1 << 20;
constexpr size_t WS_CTL = 0, CTL_ZERO_BYTES = 1 * MiB;
constexpr size_t WS_MOD = 1 * MiB;
constexpr size_t WS_ROPE = 5 * MiB;
constexpr size_t WS_TOKPOS = 5 * MiB + 256 * 1024;
constexpr size_t WS_LIST = 6 * MiB;
constexpr size_t WS_GLIST = 13 * MiB;
constexpr size_t WS_R = 27 * MiB;
constexpr size_t WS_WQKV = 36 * MiB, WS_WO = 42 * MiB, WS_WIN = 46 * MiB, WS_WGO = 59 * MiB, WS_WGU = 63 * MiB, WS_WD = 191 * MiB;
constexpr size_t WS_XR = 256 * MiB;
constexpr size_t WS_H = 400 * MiB;
constexpr size_t WS_R2 = 544 * MiB;
static_assert(544 * MiB + 2 * ((size_t)73728 * 1024 * 2) == 832 * MiB, "R3 = R2 + 2 activations");
constexpr size_t WS_R3 = 832 * MiB;
constexpr size_t WS_SA = 992 * MiB;
constexpr size_t WS_SLIST = 993 * MiB;
constexpr size_t WS_SBQKV = 1000 * MiB, WS_SBIN = 1000 * MiB + 65536, WS_SBGU = 1000 * MiB + 131072;
constexpr size_t WS_SBGO = 1000 * MiB + 131072 + 262144;
constexpr size_t WS_SBD = 1000 * MiB + 131072 + 262144 + 65536;
constexpr size_t WS_SBO = 1000 * MiB + 524288;
constexpr float ATT_O_SCALE = 32.0f;
constexpr float Y_SCALE = 16.0f;
constexpr float HID_SCALE = 16.0f;
constexpr size_t WS_END = 1001 * MiB;
constexpr size_t ACT_BYTES = (size_t)MT * 1024 * 2;
constexpr int CW_BAR = 4096;
constexpr int CW_MOE = 16384;

constexpr int RING_BYTES = 131072;
constexpr int LDS_BYTES = 163840;
constexpr int MISC_OFF = LDS_BYTES - 2048;
constexpr int MOE_TAB_OFF = MISC_OFF + 256;
constexpr int PHASE_LDS = MISC_OFF;
static_assert(RING_BYTES + 8192 <= MISC_OFF, "rope table above the ring");
constexpr int TAB_OFF = RING_BYTES + 8192, TAB_STRIDE = 5120;
static_assert(TAB_OFF + 2 * TAB_STRIDE <= MISC_OFF, "unit tables above the rope table");
constexpr int NWAVES = 8;

typedef __bf16 bf16x2_t __attribute__((ext_vector_type(2)));
DI unsigned cvt_pk_bf16(float lo, float hi) { f32x2 v = {lo, hi}; bf16x2_t b = __builtin_convertvector(v, bf16x2_t); return __builtin_bit_cast(unsigned, b); }
DI float bf_lo(unsigned w) { return __uint_as_float(w << 16); }
DI float bf_hi(unsigned w) { return __uint_as_float(w & 0xffff0000u); }
DI float shx(float v, int o, int lane) { return __int_as_float(__builtin_amdgcn_ds_bpermute((lane ^ o) << 2, __float_as_int(v))); }
#define DPPF(v, ctrl) __int_as_float(__builtin_amdgcn_update_dpp(0, __float_as_int(v), (ctrl), 0xF, 0xF, false))
DI float wave_sum(float v, int lane) {
    v += DPPF(v, 0xB1); v += DPPF(v, 0x4E); v += DPPF(v, 0x141); v += DPPF(v, 0x140);
    v += shx(v, 16, lane); v += shx(v, 32, lane);
    return v;
}
DI float wave_max(float v, int lane) {
    v = fmaxf(v, DPPF(v, 0xB1)); v = fmaxf(v, DPPF(v, 0x4E)); v = fmaxf(v, DPPF(v, 0x141)); v = fmaxf(v, DPPF(v, 0x140));
    v = fmaxf(v, shx(v, 16, lane)); v = fmaxf(v, shx(v, 32, lane));
    return v;
}
DI float half_sum32(float v, int lane) {
    v += DPPF(v, 0xB1); v += DPPF(v, 0x4E); v += DPPF(v, 0x141); v += DPPF(v, 0x140);
    v += shx(v, 16, lane);
    return v;
}
DI float sigmoidf_(float x) { return 1.0f / (1.0f + __expf(-x)); }
DI float siluf_(float x) { return x / (1.0f + __expf(-x)); }
#define MFMA32(a, b, c) __builtin_amdgcn_mfma_f32_32x32x16_bf16((a), (b), (c), 0, 0, 0)
#define MFMA16(a, b, c) __builtin_amdgcn_mfma_f32_16x16x32_bf16((a), (b), (c), 0, 0, 0)
DI int crow(int r, int hi) { return (r & 3) + 8 * (r >> 2) + 4 * hi; }
DI bf16x8 pack8(const f32x16& x, int s) {
    u32x4 p; p[0] = cvt_pk_bf16(x[8 * s + 0], x[8 * s + 1]); p[1] = cvt_pk_bf16(x[8 * s + 2], x[8 * s + 3]); p[2] = cvt_pk_bf16(x[8 * s + 4], x[8 * s + 5]); p[3] = cvt_pk_bf16(x[8 * s + 6], x[8 * s + 7]);
    return __builtin_bit_cast(bf16x8, p);
}
DI s16x4 tr_read(const LAS unsigned char* p) { return __builtin_bit_cast(s16x4, __builtin_amdgcn_ds_read_tr16_b64_v4i16((LAS s16x4*)p)); }
DI bf16x8 cat4(s16x4 lo, s16x4 hi) { return __builtin_shufflevector(lo, hi, 0, 1, 2, 3, 4, 5, 6, 7); }

DI unsigned lane_id_() { unsigned l; asm volatile("v_mbcnt_lo_u32_b32 %0, -1, 0\n\tv_mbcnt_hi_u32_b32 %0, -1, %0" : "=v"(l)); return l; }
#define XB_TMO      128
#define XB_XCNT(j)  (256  + 64 * (j))
#define XB_XSUB(j)  (1280 + 64 * (j))
#define XB_XGEN(j)  (2304 + 64 * (j))
#define XB_TOP      3328
#define XB_TOPGEN   3392
#define XCD_BAR_WORDS 3456
#define XB_SPIN_CAP (1u << 18)
__device__ __forceinline__ unsigned xb_ld(unsigned* p)              { return __hip_atomic_load(p, __ATOMIC_RELAXED, __HIP_MEMORY_SCOPE_AGENT); }
__device__ __forceinline__ unsigned xb_add(unsigned* p, unsigned v) { return __hip_atomic_fetch_add(p, v, __ATOMIC_RELAXED, __HIP_MEMORY_SCOPE_AGENT); }
__device__ __forceinline__ unsigned xb_xcc_id() { return (unsigned)__builtin_amdgcn_s_getreg((3 << 11) | 20) & 0xFu; }
#define XB_SPIN(cond, bar) do { unsigned _sp = 0; while (cond) { __builtin_amdgcn_s_sleep(1); \
    if ((++_sp & 255u) == 0u) { if (xb_ld(&(bar)[XB_TMO])) break; if (_sp > XB_SPIN_CAP) { atomicAdd(&(bar)[XB_TMO], 1u); break; } } } } while (0)
struct XcdBarrier { unsigned* bar; unsigned x; volatile LAS unsigned* st; unsigned w; };
__device__ __forceinline__ XcdBarrier xcd_barrier_post(unsigned* bar, volatile LAS unsigned* st, unsigned w) {
    XcdBarrier b; b.bar = bar; b.x = xb_xcc_id(); b.st = st; b.w = w;
    if (w == 0u && lane_id_() == 0u) (void)xb_add(&bar[XB_XCNT(b.x)], 1u);
    return b;
}
__device__ __forceinline__ void xcd_barrier_complete(unsigned* bar, unsigned x, unsigned& nloc, unsigned& nx) {
    const unsigned G = gridDim.x * gridDim.y * gridDim.z;
    unsigned sum, cnt, mine, sp = 0u;
    for (;;) {
        sum = 0u; cnt = 0u; mine = 0u;
#pragma unroll
        for (unsigned j = 0; j < 16; ++j) { const unsigned c = xb_ld(&bar[XB_XCNT(j)]); sum += c; cnt += (c > 0u) ? 1u : 0u; mine = (j == x) ? c : mine; }
        if (sum == G) break;
        __builtin_amdgcn_s_sleep(1);
        if ((++sp & 255u) == 0u) { if (xb_ld(&bar[XB_TMO])) break; if (sp > XB_SPIN_CAP) { atomicAdd(&bar[XB_TMO], 1u); break; } }
    }
    nloc = mine > 0u ? mine : 1u; nx = cnt > 0u ? cnt : 1u;
}
__device__ __forceinline__ void xcd_barrier(const XcdBarrier& b) {
    asm volatile("s_waitcnt vmcnt(0)" ::: "memory");
    __syncthreads();
    if (b.w == 0u && lane_id_() == 0u) {
        unsigned* bar = b.bar;
        __builtin_amdgcn_s_waitcnt(0);
        unsigned nloc = b.st[0], nx = b.st[1];
        if (nloc == 0u) { xcd_barrier_complete(bar, b.x, nloc, nx); b.st[0] = nloc; b.st[1] = nx; }
        const unsigned old = xb_add(&bar[XB_XSUB(b.x)], 1u);
        const unsigned gen = old / nloc;
        if (old + 1u == (gen + 1u) * nloc) {
            __builtin_amdgcn_fence(__ATOMIC_RELEASE, "agent");
            asm volatile("s_waitcnt vmcnt(0)" ::: "memory");
            const unsigned og = xb_add(&bar[XB_TOP], 1u);
            const unsigned tg = og / nx;
            if (og + 1u == (tg + 1u) * nx) xb_add(&bar[XB_TOPGEN], 1u);
            else XB_SPIN(xb_ld(&bar[XB_TOPGEN]) == tg, bar);
            __builtin_amdgcn_fence(__ATOMIC_ACQUIRE, "agent");
            xb_add(&bar[XB_XGEN(b.x)], 1u);
            asm volatile("s_waitcnt vmcnt(0)" ::: "memory");
        } else {
            XB_SPIN(xb_ld(&bar[XB_XGEN(b.x)]) == gen, bar);
            __builtin_amdgcn_fence(__ATOMIC_ACQUIRE, "agent");
            asm volatile("s_waitcnt vmcnt(0)" ::: "memory");
        }
    }
    __syncthreads();
}

struct Frame {
    LAS unsigned char* lds;
    int tid, lane, wave, G;
};
DI Frame mkframe(LAS unsigned char* lds, int wv) { Frame F; int l = (int)lane_id_(); asm volatile("" : "+v"(l)); F.lane = l; F.wave = wv; F.tid = wv * 64 + l; F.G = gridDim.x; F.lds = lds; return F; }
DI const void* karg(int slot) {
    const volatile __attribute__((address_space(4))) unsigned long long* ka = (const volatile __attribute__((address_space(4))) unsigned long long*)__builtin_amdgcn_kernarg_segment_ptr();
    return (const void*)(const GAS void*)ka[slot];
}
#define KIN(i) ((const float*)karg(i))
#define KOUT ((float*)karg(23))
#define KWS ((unsigned char*)karg(24))
enum { I_X = 0, I_C, I_CTX, I_CCTX, I_ADAW, I_ADAB, I_NMIX, I_NFFN, I_FINALG, I_WQKV, I_WO, I_SINKS, I_GWIN, I_GWA1, I_GWA2, I_GBA, I_GNORM, I_GWO, I_RW, I_RB, I_MG, I_MU, I_MD };

namespace pg8 {
constexpr int BM = 256, BK = 64, HALF = 128, HTB = HALF * BK * 2, STAGE_BYTES = 8 * HTB, NXCD = 8, WGM = 8;
__host__ __device__ __forceinline__ int lds_byte(int r, int c) { const int st = (r >> 4) * 2 + (c >> 5), rr = r & 15, cc = c & 31, ob = rr * 64 + cc * 2; return st * 1024 + (ob ^ (((ob >> 9) & 1) << 5)); }
__host__ __device__ __forceinline__ void stage_rc(int b, int& R, int& C) { const int st = b / 1024, sb = b % 1024, swz = sb ^ (((sb >> 9) & 1) << 5); R = (st >> 1) * 16 + swz / 64; C = (st & 1) * 32 + (swz % 64) / 2; }
__host__ __device__ __forceinline__ int perm32(int rho) { const int n = rho >> 4, i = rho & 15; return 8 * (i >> 2) + 4 * n + (i & 3); }
struct Unit { int pm, pn; const char* bA; const char* bB; int cl, slot0, n; const float* bsc; };
DI bool static_next(int i, int G, int c, int nM, int nN, Unit& u) {
    const int nwg = nM * nN; const long L = (long)i * G + c; if (L >= nwg) return false;
    int wgid = (int)L; { const int q = nwg / NXCD, r = nwg % NXCD, xcd = wgid % NXCD, off = wgid / NXCD; wgid = (xcd < r ? xcd * (q + 1) : r * (q + 1) + (xcd - r) * q) + off; }
    const int nig = WGM * nN, gid = wgid / nig, fm = gid * WGM, gsz = (nM - fm) < WGM ? (nM - fm) : WGM;
    u.pm = fm + ((wgid % nig) % gsz); u.pn = (wgid % nig) / gsz; return true;
}
template <class Epi, class Sched, int MODE = 0>
__device__ __forceinline__ void gemm_phase(LAS unsigned char* lds, const int tid_in, const char* Abase, const int Kbytes, const unsigned ldb, const Sched& S, const Epi& E, unsigned long long& pacc) {
    constexpr bool I8 = MODE == 1, F8 = MODE == 2;
    int tid_ = tid_in; asm volatile("" : "+v"(tid_));
    const int tid = tid_, wid = __builtin_amdgcn_readfirstlane(tid >> 6), lane = tid & 63, wr = wid >> 2, wc = wid & 3, fr = lane & 15, fq = lane >> 4;
    const int nt = Kbytes / 128;
    int Rr[2], Cc[2]; unsigned voffB[2];
#pragma unroll
    for (int i = 0; i < 2; ++i) { int R, C; stage_rc(tid * 16 + i * 8192, R, C); Rr[i] = R; Cc[i] = C; const int Rb = Epi::PERM ? ((R & ~31) + perm32(R & 31)) : R; voffB[i] = (unsigned)Rb * ldb + (unsigned)C * 2u; }
    const size_t kstep = (size_t)(BK * 2);
    const size_t hstepB = (size_t)HALF * ldb;
    const unsigned ldsw = (unsigned)wid * 1024u;
    const int aoff = lds_byte(wr * 64 + fr, fq * 8), boff = lds_byte(wc * 32 + fr, fq * 8);
#define PG8_SA(b, h) (((b) * 2 + (h)) * HTB)
#define PG8_SB(b, h) ((4 + (b) * 2 + (h)) * HTB)
#define PG8_STAGE_B(bufoff, gbase) do { _Pragma("unroll") for (int _i = 0; _i < 2; ++_i) \
        __builtin_amdgcn_global_load_lds((const unsigned*)((const char*)(gbase) + voffB[_i]), (LAS unsigned*)(lds + (bufoff) + ldsw + _i * 8192), 16, 0, 0); } while (0)
#define PG8_STAGE_A(bufoff, koff, offs) do { _Pragma("unroll") for (int _i = 0; _i < 2; ++_i) \
        __builtin_amdgcn_global_load_lds((const unsigned*)(Abase + (koff) + (offs)[_i]), (LAS unsigned*)(lds + (bufoff) + ldsw + _i * 8192), 16, 0, 0); } while (0)
#define PG8_CAT8(p_) __builtin_shufflevector(*(const LAS i32x4*)(p_), *(const LAS i32x4*)((p_) + 1024), 0, 1, 2, 3, 4, 5, 6, 7)
#define PG8_LDA(dst, b, h) do { if constexpr (F8) { _Pragma("unroll") for (int m = 0; m < 4; ++m) dst##8[m] = PG8_CAT8(lds + PG8_SA(b, h) + aoff + m * 2048); } \
        else { _Pragma("unroll") for (int m = 0; m < 4; ++m) _Pragma("unroll") for (int k = 0; k < 2; ++k) dst[m][k] = *(const LAS bf16x8*)(lds + PG8_SA(b, h) + aoff + m * 2048 + k * 1024); } } while (0)
#define PG8_LDB(dst, b, h) do { if constexpr (F8) { _Pragma("unroll") for (int n = 0; n < 2; ++n) dst##8[n] = PG8_CAT8(lds + PG8_SB(b, h) + boff + n * 2048); } \
        else { _Pragma("unroll") for (int n = 0; n < 2; ++n) _Pragma("unroll") for (int k = 0; k < 2; ++k) dst[n][k] = *(const LAS bf16x8*)(lds + PG8_SB(b, h) + boff + n * 2048 + k * 1024); } } while (0)
#define PG8_MMA(ai, bj, At, Bt) do { __builtin_amdgcn_s_setprio(1); _Pragma("unroll") for (int m = 0; m < 4; ++m) _Pragma("unroll") for (int n = 0; n < 2; ++n) _Pragma("unroll") for (int k = 0; k < 2; ++k) { \
        if constexpr (F8) { if (k == 0) asm volatile("v_mfma_scale_f32_16x16x128_f8f6f4 %0, %1, %2, %0, %3, %3 op_sel_hi:[0,0,0]" : "+v"(acc[ai][bj][m][n]) : "v"(Bt##8[n]), "v"(At##8[m]), "v"(f8one)); } \
        else if constexpr (I8) acc[ai][bj][m][n] = __builtin_bit_cast(f32x4, __builtin_amdgcn_mfma_i32_16x16x64_i8(__builtin_bit_cast(i32x4, Bt[n][k]), __builtin_bit_cast(i32x4, At[m][k]), __builtin_bit_cast(i32x4, acc[ai][bj][m][n]), 0, 0, 0)); \
        else acc[ai][bj][m][n] = __builtin_amdgcn_mfma_f32_16x16x32_bf16(Bt[n][k], At[m][k], acc[ai][bj][m][n], 0, 0, 0); } __builtin_amdgcn_s_setprio(0); } while (0)
#define PG8_WAIT_V(n) asm volatile("s_waitcnt vmcnt(" #n ")" ::: "memory")
#define PG8_WAIT_L(n) asm volatile("s_waitcnt lgkmcnt(" #n ")" ::: "memory")
#define PG8_BAR __builtin_amdgcn_s_barrier()
#define PG8_SCHED __builtin_amdgcn_sched_barrier(0)
#if PROBE_GEMM
    unsigned long long gtp_ = __builtin_amdgcn_s_memrealtime();
#define GEMT(k) do { const unsigned long long tn_ = __builtin_amdgcn_s_memrealtime(); if (PROBE_GEMM == (k)) pacc += tn_ - gtp_; gtp_ = tn_; } while (0)
#else
#define GEMT(k) do { } while (0)
#endif
    Unit cur, nxt; int ui = 0;
    if (!S.next(0, cur)) return;
#if GEMM_STAGGER_TICKS
    { const int nwg_ = S.total(), G_ = (int)gridDim.x, c_ = (int)blockIdx.x; const int nmax_ = (nwg_ + G_ - 1) / G_, mine_ = (nwg_ - 1 - c_) / G_ + 1;
      if (mine_ < nmax_) { const unsigned long long t0_ = __builtin_amdgcn_s_memrealtime(); while (__builtin_amdgcn_s_memrealtime() - t0_ < (unsigned long long)GEMM_STAGGER_TICKS) __builtin_amdgcn_s_sleep(16); } }
#endif
    f32x4 acc[2][2][4][2];
#pragma unroll
    for (int a = 0; a < 2; ++a)
#pragma unroll
        for (int b = 0; b < 2; ++b)
#pragma unroll
            for (int m = 0; m < 4; ++m)
#pragma unroll
                for (int n = 0; n < 2; ++n) acc[a][b][m][n] = (f32x4){0.f, 0.f, 0.f, 0.f};
    int f8one = 0x7F7F7F7F; asm volatile("" : "+v"(f8one));
    bf16x8 At[4][2], B0[2][2], B1[2][2]; i32x8 At8[4], B08[2], B18[2];
    unsigned oC[2][2], oN[2][2];
#pragma unroll
    for (int h = 0; h < 2; ++h)
#pragma unroll
        for (int i = 0; i < 2; ++i) { oC[h][i] = S.a_off(cur, h * HALF + Rr[i]) + (unsigned)Cc[i] * 2u; asm volatile("" : "+v"(oC[h][i])); }
#define PG8_BPTR(u, t) (((t) < Sched::KSPLIT ? (u).bA : (u).bB) + (size_t)((t) & (Sched::KSPLIT - 1)) * 128)
    const char* cB = PG8_BPTR(cur, 0);
    PG8_STAGE_B(PG8_SB(0, 0), cB); PG8_STAGE_B(PG8_SB(0, 1), cB + hstepB); PG8_STAGE_A(PG8_SA(0, 0), 0, oC[0]); PG8_STAGE_A(PG8_SA(0, 1), 0, oC[1]);
    if (wr == 1) PG8_BAR;
    PG8_WAIT_V(2); PG8_BAR;
    { const char* cB1 = PG8_BPTR(cur, 1); PG8_STAGE_B(PG8_SB(1, 0), cB1); PG8_STAGE_A(PG8_SA(1, 0), kstep, oC[0]); PG8_STAGE_B(PG8_SB(1, 1), cB1 + hstepB); }
    PG8_WAIT_V(6); PG8_BAR;
    for (;;) {
        const bool has_next = S.next(ui + 1, nxt);
        if (!has_next) nxt = cur;
        if constexpr (!Sched::GATHER) {
#pragma unroll
            for (int h = 0; h < 2; ++h)
#pragma unroll
                for (int i = 0; i < 2; ++i) { oN[h][i] = S.a_off(nxt, h * HALF + Rr[i]) + (unsigned)Cc[i] * 2u; asm volatile("" : "+v"(oN[h][i])); }
        }
        if constexpr (I8 || F8 || Sched::GATHER || Epi::HAS_GL) {
            int t8 = tid; asm volatile("" : "+v"(t8)); const int wid8 = __builtin_amdgcn_readfirstlane(t8 >> 6); const unsigned l8 = (unsigned)(t8 & 63) * 4u;
            LAS unsigned char* tbc = lds + TAB_OFF + (ui & 1) * TAB_STRIDE;
            if constexpr (F8) { if (wid8 >= 4) __builtin_amdgcn_global_load_lds((const unsigned*)((const char*)S.b_scale(cur) + (wid8 - 4) * 256 + l8), (LAS unsigned*)(tbc + wid8 * 256), 4, 0, 0); }
            if constexpr (I8) { const char* g8 = wid8 < 4 ? (const char*)S.sa_ptr(cur) + wid8 * 256 : (const char*)S.b_scale(cur) + (wid8 - 4) * 256;
                __builtin_amdgcn_global_load_lds((const unsigned*)(g8 + l8), (LAS unsigned*)(tbc + wid8 * 256), 4, 0, 0); }
            if constexpr (Epi::HAS_GL) __builtin_amdgcn_global_load_lds((const unsigned*)((const char*)E.gl_ptr(cur) + wid8 * 256 + l8), (LAS unsigned*)(tbc + 2048 + wid8 * 256), 4, 0, 0);
            if constexpr (Sched::GATHER) { if (wid8 < 4) __builtin_amdgcn_global_load_lds((const unsigned*)((const char*)S.list_ptr(nxt) + wid8 * 256 + l8), (LAS unsigned*)(lds + TAB_OFF + ((ui + 1) & 1) * TAB_STRIDE + 4096 + wid8 * 256), 4, 0, 0); }
        }
        GEMT(3);
        for (int t = 0; t < nt; t += 2) {
            const bool last = (t == nt - 2);
            const size_t a1k = (size_t)(t + 1) * kstep;
            const size_t a2k = last ? 0 : (size_t)(t + 2) * kstep, a3k = a2k + kstep;
            const char* b2 = last ? PG8_BPTR(nxt, 0) : PG8_BPTR(cur, t + 2);
            const char* b3 = last ? PG8_BPTR(nxt, 1) : PG8_BPTR(cur, t + 3);
            if constexpr (Sched::GATHER) {
                const LAS int* Ln = (const LAS int*)(lds + TAB_OFF + ((ui + 1) & 1) * TAB_STRIDE + 4096);
#pragma unroll
                for (int h = 0; h < 2; ++h)
#pragma unroll
                    for (int i = 0; i < 2; ++i) { const int row = h * HALF + Rr[i]; int tok = Ln[row]; tok = S.row_valid(nxt, row) ? tok : 0; oN[h][i] = (unsigned)tok * 1024u + (unsigned)Cc[i] * 2u; }
            }
            unsigned o2[2][2];
            { const unsigned c00 = oC[0][0], c01 = oC[0][1], c10 = oC[1][0], c11 = oC[1][1], n00 = oN[0][0], n01 = oN[0][1], n10 = oN[1][0], n11 = oN[1][1];
              o2[0][0] = last ? n00 : c00; o2[0][1] = last ? n01 : c01; o2[1][0] = last ? n10 : c10; o2[1][1] = last ? n11 : c11; }
            PG8_LDB(B0, 0, 0); PG8_LDB(B1, 0, 1); PG8_SCHED; PG8_LDA(At, 0, 0); PG8_STAGE_A(PG8_SA(1, 1), a1k, oC[1]);
            PG8_WAIT_V(8); PG8_WAIT_L(0); PG8_BAR; PG8_MMA(0, 0, At, B0); PG8_MMA(0, 1, At, B1); PG8_BAR; PG8_SCHED;
            PG8_LDA(At, 0, 1); PG8_STAGE_B(PG8_SB(0, 0), b2); PG8_STAGE_B(PG8_SB(0, 1), b2 + hstepB); PG8_STAGE_A(PG8_SA(0, 0), a2k, o2[0]);
            PG8_WAIT_V(8); PG8_WAIT_L(0); PG8_BAR; PG8_MMA(1, 0, At, B0); PG8_MMA(1, 1, At, B1); PG8_BAR; PG8_SCHED;
            PG8_LDB(B0, 1, 0); PG8_LDB(B1, 1, 1); PG8_SCHED; PG8_LDA(At, 1, 0); PG8_STAGE_A(PG8_SA(0, 1), a2k, o2[1]);
            PG8_WAIT_V(8); PG8_WAIT_L(0); PG8_BAR; PG8_MMA(0, 0, At, B0); PG8_MMA(0, 1, At, B1); PG8_BAR; PG8_SCHED;
            PG8_LDA(At, 1, 1); PG8_STAGE_B(PG8_SB(1, 0), b3); PG8_STAGE_B(PG8_SB(1, 1), b3 + hstepB); PG8_STAGE_A(PG8_SA(1, 0), a3k, o2[0]);
            PG8_WAIT_V(8); PG8_WAIT_L(0); PG8_BAR; PG8_MMA(1, 0, At, B0); PG8_MMA(1, 1, At, B1); PG8_BAR; PG8_SCHED;
        }
        GEMT(1);
        if constexpr (F8) asm volatile("s_nop 15\n\ts_nop 15" ::: "memory");
        if (wr == 0) PG8_BAR;
        if constexpr (I8) {
            int t7 = tid; asm volatile("" : "+v"(t7)); const int wid7 = __builtin_amdgcn_readfirstlane(t7 >> 6), l7 = t7 & 63, wr7 = wid7 >> 2, wc7 = wid7 & 3, fr7 = l7 & 15, fq7 = l7 >> 4;
            const LAS float* sap = (const LAS float*)(lds + TAB_OFF + (ui & 1) * TAB_STRIDE); const LAS float* sbp = sap + 256 + wc7 * 32 + (Epi::PERM ? 8 * fq7 : 4 * fq7);
#pragma unroll
            for (int a = 0; a < 2; ++a)
#pragma unroll
                for (int m = 0; m < 4; ++m) { const int row7 = a * HALF + wr7 * 64 + m * 16 + fr7; float sa_ = sap[row7]; sa_ = S.row_valid(cur, row7) ? sa_ : 0.f;
#pragma unroll
                    for (int b = 0; b < 2; ++b)
#pragma unroll
                        for (int n = 0; n < 2; ++n) { const f32x4 sb_ = *(const LAS f32x4*)(sbp + b * HALF + (Epi::PERM ? 4 * n : 16 * n)); const i32x4 v = __builtin_bit_cast(i32x4, acc[a][b][m][n]);
                            acc[a][b][m][n] = (f32x4){(float)v[0], (float)v[1], (float)v[2], (float)v[3]} * sa_ * sb_; } }
        }
        if constexpr (F8) {
            int t7 = tid; asm volatile("" : "+v"(t7)); const int wid7 = __builtin_amdgcn_readfirstlane(t7 >> 6), l7 = t7 & 63, wc7 = wid7 & 3, fq7 = l7 >> 4;
            const LAS float* sbp = (const LAS float*)(lds + TAB_OFF + (ui & 1) * TAB_STRIDE) + 256 + wc7 * 32 + (Epi::PERM ? 8 * fq7 : 4 * fq7); const float ac_ = S.a_const();
#pragma unroll
            for (int b = 0; b < 2; ++b)
#pragma unroll
                for (int n = 0; n < 2; ++n) { const f32x4 sb_ = *(const LAS f32x4*)(sbp + b * HALF + (Epi::PERM ? 4 * n : 16 * n)) * ac_;
#pragma unroll
                    for (int a = 0; a < 2; ++a)
#pragma unroll
                        for (int m = 0; m < 4; ++m) acc[a][b][m][n] = acc[a][b][m][n] * sb_; }
        }
        E(acc, cur, wr, wc, fr, fq, (const LAS unsigned char*)(lds + TAB_OFF + (ui & 1) * TAB_STRIDE));
        GEMT(2);
        if (!has_next) break;
#pragma unroll
        for (int a = 0; a < 2; ++a)
#pragma unroll
            for (int b = 0; b < 2; ++b)
#pragma unroll
                for (int m = 0; m < 4; ++m)
#pragma unroll
                    for (int n = 0; n < 2; ++n) acc[a][b][m][n] = (f32x4){0.f, 0.f, 0.f, 0.f};
        cur = nxt; ++ui;
#pragma unroll
        for (int h = 0; h < 2; ++h)
#pragma unroll
            for (int i = 0; i < 2; ++i) oC[h][i] = oN[h][i];
        if (wr == 1) PG8_BAR;
    }
    PG8_WAIT_V(0);
    PG8_BAR;
    GEMT(3);
#undef GEMT
#undef PG8_BPTR
#undef PG8_SA
#undef PG8_SB
#undef PG8_STAGE_A
#undef PG8_STAGE_B
#undef PG8_LDA
#undef PG8_LDB
#undef PG8_MMA
#undef PG8_WAIT_V
#undef PG8_WAIT_L
#undef PG8_BAR
#undef PG8_SCHED
}
}
using pg8::Unit;

struct DenseOrder {
    int nM, nN, G, c; unsigned lda; const char* Bt; unsigned ldb; const float* sa; const float* sb; float ac = 1.f;
    DI float a_const() const { return ac; }
    DI bool next(int i, Unit& u) const { if (!pg8::static_next(i, G, c, nM, nN, u)) return false; u.bA = Bt + (size_t)u.pn * 256 * ldb; u.bB = u.bA + 1024; u.cl = 0; u.slot0 = 0; u.n = 0; u.bsc = sb + u.pn * 256; return true; }
    static constexpr bool GATHER = false; static constexpr int KSPLIT = 8;
    DI const float* sa_ptr(const Unit& u) const { return sa + u.pm * 256; }
    DI const float* b_scale(const Unit& u) const { return u.bsc; }
    DI bool row_valid(const Unit&, int) const { return true; }
    DI const int* list_ptr(const Unit&) const { return nullptr; }
    DI unsigned a_off(const Unit& u, int row) const { return (unsigned)(u.pm * 256 + row) * lda; }
    DI int total() const { return nM * nN; }
};
DI int moe_class(const LAS int* bs, int pm) { int c = 0;
#pragma unroll
    for (int k = 1; k < NCLS; ++k) c += (bs[k] <= pm) ? 1 : 0;
    return c; }
DI void moe_experts(int c, int& elo, int& ehi) { const int g = c / 6, p = c - 6 * g; const int lo = p < 3 ? 0 : (p < 5 ? 1 : 2), hi = p < 3 ? p + 1 : (p < 5 ? p - 1 : 3); elo = 4 * g + lo; ehi = 4 * g + hi; }
struct MoeUpOrder {
    int nM, G, c; const LAS int* bs; const LAS int* cnt; const int* list; const char* Wgu; const float* slist; const float* sbgu;
    DI bool next(int i, Unit& u) const { if (!pg8::static_next(i, G, c, nM, 8, u)) return false;
        const int cl = __builtin_amdgcn_readfirstlane(moe_class(bs, u.pm)); int elo, ehi; moe_experts(cl, elo, ehi); const int e = u.pn < 4 ? elo : ehi;
        u.bA = Wgu + (size_t)e * (1024 * 1024) + (size_t)(u.pn & 3) * 256 * 1024; u.bB = u.bA + 1024; u.cl = cl; u.slot0 = (u.pm - __builtin_amdgcn_readfirstlane(bs[cl])) * 256; u.n = __builtin_amdgcn_readfirstlane(cnt[cl]); u.bsc = sbgu + e * 1024 + (u.pn & 3) * 256; return true; }
    DI unsigned a_off(const Unit& u, int row) const { const int slot = u.slot0 + row; int tok = 0; if (slot < u.n) tok = list[(size_t)u.cl * MT + slot]; return (unsigned)tok * 1024u; }
    static constexpr int KSPLIT = 8;
    static constexpr bool GATHER = true;
    DI const float* sa_ptr(const Unit& u) const { return slist + (size_t)u.cl * MT + u.slot0; }
    DI const int* list_ptr(const Unit& u) const { return list + (size_t)u.cl * MT + u.slot0; }
    DI bool row_valid(const Unit& u, int row) const { return u.slot0 + row < u.n; }
    DI const float* b_scale(const Unit& u) const { return u.bsc; }
};
struct MoeDownOrder {
    int nM, G, c; const LAS int* bs; const char* Wd; const float* sbd;
    static constexpr bool GATHER = false; static constexpr int KSPLIT = 4;
    DI bool next(int i, Unit& u) const { if (!pg8::static_next(i, G, c, nM, 4, u)) return false;
        const int cl = __builtin_amdgcn_readfirstlane(moe_class(bs, u.pm)); int elo, ehi; moe_experts(cl, elo, ehi);
        u.bA = Wd + (size_t)elo * (1024 * 512) + (size_t)u.pn * 256 * 512; u.bB = Wd + (size_t)ehi * (1024 * 512) + (size_t)u.pn * 256 * 512; u.cl = cl; u.slot0 = 0; u.n = 0; u.bsc = sbd + (cl / 6) * 1024 + u.pn * 256; return true; }
    DI unsigned a_off(const Unit& u, int row) const { return (unsigned)(u.pm * 256 + row) * 1024u; }
    DI const float* sa_ptr(const Unit&) const { return nullptr; }
    DI const float* b_scale(const Unit& u) const { return u.bsc; }
    DI float a_const() const { return 1.0f / HID_SCALE; }
    DI bool row_valid(const Unit&, int) const { return true; }
    DI const int* list_ptr(const Unit&) const { return nullptr; }
    DI int total() const { return nM * 4; }
};

struct EpiQKV {
    static constexpr bool PERM = false, HAS_GL = false;
    bf16_t* P; const LAS float* rope;
    DI void operator()(const f32x4 (&acc)[2][2][4][2], const Unit& u, int wr, int wc, int fr, int fq, const LAS unsigned char* tb) const {
        const int row0 = u.pm * 256 + wr * 64 + fr; const bool lat = u.pm < 256; const bool dorope = lat && u.pn < 5; const float sc = u.pn < 4 ? QSCALE : 1.0f;
#pragma unroll
        for (int ai = 0; ai < 2; ++ai)
#pragma unroll
            for (int m = 0; m < 4; ++m) { const int row = row0 + ai * 128 + m * 16; const int t = row & 2047; const int pos = (wc & 1) ? (t & 63) : (t >> 6);
                f32x4 cs = (f32x4){1.f, 1.f, 1.f, 1.f}, sn = (f32x4){0.f, 0.f, 0.f, 0.f};
                if (dorope) { cs = *(const LAS f32x4*)(rope + pos * 32 + 4 * fq); sn = *(const LAS f32x4*)(rope + pos * 32 + 16 + 4 * fq); }
                bf16_t* rowp = P + (size_t)row * NQKV + u.pn * 256 + wc * 32 + 4 * fq;
#pragma unroll
                for (int bj = 0; bj < 2; ++bj) { const f32x4 y1 = acc[ai][bj][m][0], y2 = acc[ai][bj][m][1];
                    const f32x4 o1 = (y1 * cs - y2 * sn) * sc, o2 = (y2 * cs + y1 * sn) * sc;
                    u32x2 w1, w2; w1.x = cvt_pk_bf16(o1[0], o1[1]); w1.y = cvt_pk_bf16(o1[2], o1[3]); w2.x = cvt_pk_bf16(o2[0], o2[1]); w2.y = cvt_pk_bf16(o2[2], o2[3]);
                    *(u32x2*)(rowp + bj * 128) = w1; *(u32x2*)(rowp + bj * 128 + 16) = w2; } }
    }
};
struct EpiGLA {
    static constexpr bool PERM = true, HAS_GL = false;
    bf16_t* R2b; float* R;
    DI void operator()(const f32x4 (&acc)[2][2][4][2], const Unit& u, int wr, int wc, int fr, int fq, const LAS unsigned char* tb) const {
        const int row0 = u.pm * 256 + wr * 64 + fr;
        if (u.pn == 12) { if (wc == 0) {
#pragma unroll
            for (int ai = 0; ai < 2; ++ai)
#pragma unroll
                for (int m = 0; m < 4; ++m) { float* rp = R + (size_t)(row0 + ai * 128 + m * 16) * 32 + 8 * fq; *(f32x4*)rp = acc[ai][0][m][0]; *(f32x4*)(rp + 4) = acc[ai][0][m][1]; } }
            return; }
        const int tsel = u.pn < 4 ? 0 : (u.pn < 8 ? 2 : 1);
        bf16_t* base = R2b + (size_t)tsel * ((size_t)MT * 1024); const int colt = (u.pn & 3) * 256; const float sc = u.pn < 2 ? 0.08838834764831845f : 1.0f;
#pragma unroll
        for (int ai = 0; ai < 2; ++ai)
#pragma unroll
            for (int m = 0; m < 4; ++m) { bf16_t* rowp = base + (size_t)(row0 + ai * 128 + m * 16) * 1024 + colt + wc * 32 + 8 * fq;
#pragma unroll
                for (int bj = 0; bj < 2; ++bj) { const f32x4 v0 = acc[ai][bj][m][0] * sc, v1 = acc[ai][bj][m][1] * sc;
                    u32x4 w; w.x = cvt_pk_bf16(v0[0], v0[1]); w.y = cvt_pk_bf16(v0[2], v0[3]); w.z = cvt_pk_bf16(v1[0], v1[1]); w.w = cvt_pk_bf16(v1[2], v1[3]);
                    *(u32x4*)(rowp + bj * 128) = w; } }
    }
};
struct EpiY {
    static constexpr bool PERM = true, HAS_GL = false;
    unsigned char* Y;
    DI void operator()(const f32x4 (&acc)[2][2][4][2], const Unit& u, int wr, int wc, int fr, int fq, const LAS unsigned char* tb) const {
        const int row0 = u.pm * 256 + wr * 64 + fr; const int col0 = u.pn * 256 + wc * 32 + 8 * fq;
#pragma unroll
        for (int ai = 0; ai < 2; ++ai)
#pragma unroll
            for (int m = 0; m < 4; ++m) { unsigned char* rowp = Y + (size_t)(row0 + ai * 128 + m * 16) * 1024 + col0;
#pragma unroll
                for (int bj = 0; bj < 2; ++bj) { const f32x4 v0 = acc[ai][bj][m][0] * Y_SCALE, v1 = acc[ai][bj][m][1] * Y_SCALE;
                    int w0 = 0, w1 = 0;
                    w0 = __builtin_amdgcn_cvt_pk_fp8_f32(__builtin_amdgcn_fmed3f(v0[0], -448.f, 448.f), __builtin_amdgcn_fmed3f(v0[1], -448.f, 448.f), w0, false); w0 = __builtin_amdgcn_cvt_pk_fp8_f32(__builtin_amdgcn_fmed3f(v0[2], -448.f, 448.f), __builtin_amdgcn_fmed3f(v0[3], -448.f, 448.f), w0, true);
                    w1 = __builtin_amdgcn_cvt_pk_fp8_f32(__builtin_amdgcn_fmed3f(v1[0], -448.f, 448.f), __builtin_amdgcn_fmed3f(v1[1], -448.f, 448.f), w1, false); w1 = __builtin_amdgcn_cvt_pk_fp8_f32(__builtin_amdgcn_fmed3f(v1[2], -448.f, 448.f), __builtin_amdgcn_fmed3f(v1[3], -448.f, 448.f), w1, true);
                    *(u32x2*)(rowp + bj * 128) = (u32x2){(unsigned)w0, (unsigned)w1}; } }
    }
};
DI float silu_fast(float a) { return a * __builtin_amdgcn_rcpf(1.0f + __builtin_amdgcn_exp2f(-a * LOG2E)); }
struct EpiSwiGLU {
    static constexpr bool PERM = true, HAS_GL = true;
    unsigned char* HID; const f32x2* glist;
    DI const f32x2* gl_ptr(const Unit& u) const { return glist + (size_t)u.cl * MT + u.slot0; }
    DI void operator()(const f32x4 (&acc)[2][2][4][2], const Unit& u, int wr, int wc, int fr, int fq, const LAS unsigned char* tb) const {
        const int sel = u.pn >> 2, hb = u.pn & 3; const int r0 = wr * 64 + fr; const LAS f32x2* gl = (const LAS f32x2*)(tb + 2048);
#pragma unroll
        for (int ai = 0; ai < 2; ++ai) {
            float gwv[4];
#pragma unroll
            for (int m = 0; m < 4; ++m) { const int rr_ = r0 + ai * 128 + m * 16; const f32x2 gg = gl[rr_]; const float g = (sel ? gg.y : gg.x) * HID_SCALE; gwv[m] = (u.slot0 + rr_ < u.n) ? g : 0.f; }
#pragma unroll
            for (int m = 0; m < 4; ++m) { const int r = r0 + ai * 128 + m * 16; const float gw = gwv[m];
                const f32x4 a0 = acc[ai][0][m][0], a1 = acc[ai][0][m][1], b0 = acc[ai][1][m][0], b1 = acc[ai][1][m][1];
                float h[8];
#pragma unroll
                for (int e = 0; e < 4; ++e) { h[e] = __builtin_amdgcn_fmed3f(silu_fast(a0[e]) * b0[e] * gw, -448.f, 448.f); h[4 + e] = __builtin_amdgcn_fmed3f(silu_fast(a1[e]) * b1[e] * gw, -448.f, 448.f); }
                int w0 = 0, w1 = 0; w0 = __builtin_amdgcn_cvt_pk_fp8_f32(h[0], h[1], w0, false); w0 = __builtin_amdgcn_cvt_pk_fp8_f32(h[2], h[3], w0, true); w1 = __builtin_amdgcn_cvt_pk_fp8_f32(h[4], h[5], w1, false); w1 = __builtin_amdgcn_cvt_pk_fp8_f32(h[6], h[7], w1, true);
                *(u32x2*)(HID + (size_t)(u.pm * 256 + r) * 1024 + sel * 512 + hb * 128 + wc * 32 + 8 * fq) = (u32x2){(unsigned)w0, (unsigned)w1}; } }
    }
};

struct TItem { const float* W; int ldw; bf16_t* WT; int Kd, k0, n0, drow0; };
DI void titem_load(const TItem& I, f32x4 (&t)[8], int lane) {
#pragma unroll
    for (int i = 0; i < 8; ++i) { const int idx = lane + 64 * i; t[i] = *(const f32x4*)(I.W + (size_t)(I.k0 + (idx >> 3)) * I.ldw + I.n0 + 4 * (idx & 7)); }
}
DI void titem_store(const TItem& I, const f32x4 (&t)[8], LAS float* scr, int lane) {
#pragma unroll
    for (int i = 0; i < 8; ++i) { const int idx = lane + 64 * i; LAS float* d = scr + (idx >> 3) * 33 + 4 * (idx & 7); d[0] = t[i][0]; d[1] = t[i][1]; d[2] = t[i][2]; d[3] = t[i][3]; }
    asm volatile("s_waitcnt lgkmcnt(0)" ::: "memory");
    const int c = lane & 7;
#pragma unroll
    for (int j = 0; j < 4; ++j) { const int n = (lane >> 3) + 8 * j; const LAS float* s = scr + (8 * c) * 33 + n;
        u32x4 o; o.x = cvt_pk_bf16(s[0 * 33], s[1 * 33]); o.y = cvt_pk_bf16(s[2 * 33], s[3 * 33]); o.z = cvt_pk_bf16(s[4 * 33], s[5 * 33]); o.w = cvt_pk_bf16(s[6 * 33], s[7 * 33]);
        *(u32x4*)(I.WT + (size_t)(I.drow0 + n) * I.Kd + I.k0 + 8 * c) = o; }
    asm volatile("s_waitcnt lgkmcnt(0)" ::: "memory");
}
template <bool F8>
DI void wstrip_q(const float* W, int ldw, int nkb, int kbsh, size_t estride, int rowlen, signed char* W8, int n0, int drow0, float* sb, LAS float* scr, int lane) {
    constexpr float QMAX = F8 ? 224.0f : 127.0f;
    const int kmask = (1 << kbsh) - 1;
    float m4[4] = {0.f, 0.f, 0.f, 0.f};
    for (int kb = 0; kb < nkb; ++kb) { f32x4 t[8];
#pragma unroll
        for (int i = 0; i < 8; ++i) { const int idx = lane + 64 * i; t[i] = *(const f32x4*)(W + (size_t)(64 * kb + (idx >> 3)) * ldw + n0 + 4 * (idx & 7)); }
#pragma unroll
        for (int i = 0; i < 8; ++i)
#pragma unroll
            for (int e = 0; e < 4; ++e) m4[e] = fmaxf(m4[e], fabsf(t[i][e])); }
#pragma unroll
    for (int o = 8; o < 64; o <<= 1)
#pragma unroll
        for (int e = 0; e < 4; ++e) m4[e] = fmaxf(m4[e], shx(m4[e], o, lane));
    LAS float* inv = scr + 64 * 33;
    if (lane < 8) {
#pragma unroll
        for (int e = 0; e < 4; ++e) { const float am = m4[e]; sb[drow0 + 4 * lane + e] = am > 0.f ? am * (1.0f / QMAX) : 1.0f; inv[4 * lane + e] = am > 0.f ? QMAX / am : 0.f; } }
    asm volatile("s_waitcnt lgkmcnt(0)" ::: "memory");
    for (int kb = 0; kb < nkb; ++kb) { f32x4 t[8];
#pragma unroll
        for (int i = 0; i < 8; ++i) { const int idx = lane + 64 * i; t[i] = *(const f32x4*)(W + (size_t)(64 * kb + (idx >> 3)) * ldw + n0 + 4 * (idx & 7)); }
#pragma unroll
        for (int i = 0; i < 8; ++i) { const int idx = lane + 64 * i; LAS float* d = scr + (idx >> 3) * 33 + 4 * (idx & 7); d[0] = t[i][0]; d[1] = t[i][1]; d[2] = t[i][2]; d[3] = t[i][3]; }
        asm volatile("s_waitcnt lgkmcnt(0)" ::: "memory");
#pragma unroll
        for (int j = 0; j < 2; ++j) { const int p = lane + 64 * j; const int n = p >> 2, c = p & 3; const float iv = inv[n]; const LAS float* sp = scr + (16 * c) * 33 + n; unsigned w[4];
#pragma unroll
            for (int q = 0; q < 4; ++q) {
                if constexpr (F8) { int pk = 0; pk = __builtin_amdgcn_cvt_pk_fp8_f32(sp[(4 * q) * 33] * iv, sp[(4 * q + 1) * 33] * iv, pk, false); pk = __builtin_amdgcn_cvt_pk_fp8_f32(sp[(4 * q + 2) * 33] * iv, sp[(4 * q + 3) * 33] * iv, pk, true); w[q] = (unsigned)pk; }
                else { unsigned pk = 0u;
#pragma unroll
                    for (int e = 0; e < 4; ++e) { const int qi = (int)__builtin_rintf(sp[(4 * q + e) * 33] * iv); pk |= ((unsigned)qi & 0xffu) << (8 * e); }
                    w[q] = pk; } }
            *(u32x4*)(W8 + (size_t)(kb >> kbsh) * estride + (size_t)(drow0 + n) * rowlen + 64 * (kb & kmask) + 16 * c) = (u32x4){w[0], w[1], w[2], w[3]}; }
        asm volatile("s_waitcnt lgkmcnt(0)" ::: "memory"); }
}
DI void wstrip_i8(const float* W, int ldw, signed char* W8, int n0, int drow0, float* sb, LAS float* scr, int lane) { wstrip_q<false>(W, ldw, 16, 4, 0, 1024, W8, n0, drow0, sb, scr, lane); }
template <bool F8, int NB>
DI void wstrip_blk(LAS unsigned char* lds, int wave, int lane_in, const float* W, int ldw, int kbsh, size_t estride, int rowlen, signed char* W8, int n0, int drow0, float* sb, int par) {
    constexpr float QMAX = F8 ? 224.0f : 127.0f;
    int lane = lane_in; asm volatile("" : "+v"(lane));
    const int kmask = (1 << kbsh) - 1;
    LAS float* scr = (LAS float*)(lds + wave * 16384);
    LAS float* amx = (LAS float*)(lds + 131072 + par * 1024);
    f32x4 t[NB][8];
    const GAS char* wb = (const GAS char*)(W + (size_t)(64 * NB * wave) * ldw + n0); const unsigned lo = (unsigned)(((lane >> 3) * ldw + 4 * (lane & 7)) * 4);
#pragma unroll
    for (int b = 0; b < NB; ++b)
#pragma unroll
        for (int i = 0; i < 8; ++i) t[b][i] = *(const GAS f32x4*)(wb + (size_t)(64 * b + 8 * i) * ldw * 4 + lo);
    float m4[4] = {0.f, 0.f, 0.f, 0.f};
#pragma unroll
    for (int b = 0; b < NB; ++b)
#pragma unroll
        for (int i = 0; i < 8; ++i)
#pragma unroll
            for (int e = 0; e < 4; ++e) m4[e] = fmaxf(m4[e], fabsf(t[b][i][e]));
#pragma unroll
    for (int o = 8; o < 64; o <<= 1)
#pragma unroll
        for (int e = 0; e < 4; ++e) m4[e] = fmaxf(m4[e], shx(m4[e], o, lane));
    if (lane < 8) *(LAS f32x4*)(amx + wave * 32 + 4 * lane) = (f32x4){m4[0], m4[1], m4[2], m4[3]};
    __syncthreads();
    LAS float* inv = scr + 64 * 33;
    if (lane < 32) { float am = 0.f;
#pragma unroll
        for (int w = 0; w < 8; ++w) am = fmaxf(am, amx[w * 32 + lane]);
        inv[lane] = am > 0.f ? QMAX / am : 0.f; if (wave == 0) sb[drow0 + lane] = am > 0.f ? am * (1.0f / QMAX) : 1.0f; }
    asm volatile("s_waitcnt lgkmcnt(0)" ::: "memory");
#pragma unroll
    for (int b = 0; b < NB; ++b) { const int kb = NB * wave + b;
#pragma unroll
        for (int i = 0; i < 8; ++i) { const int idx = lane + 64 * i; LAS float* d = scr + (idx >> 3) * 33 + 4 * (idx & 7); d[0] = t[b][i][0]; d[1] = t[b][i][1]; d[2] = t[b][i][2]; d[3] = t[b][i][3]; }
        asm volatile("s_waitcnt lgkmcnt(0)" ::: "memory");
#pragma unroll
        for (int j = 0; j < 2; ++j) { const int p = lane + 64 * j; const int n = p >> 2, c = p & 3; const float iv = inv[n]; const LAS float* sp = scr + (16 * c) * 33 + n; unsigned w[4];
#pragma unroll
            for (int q = 0; q < 4; ++q) {
                if constexpr (F8) { int pk = 0; pk = __builtin_amdgcn_cvt_pk_fp8_f32(sp[(4 * q) * 33] * iv, sp[(4 * q + 1) * 33] * iv, pk, false); pk = __builtin_amdgcn_cvt_pk_fp8_f32(sp[(4 * q + 2) * 33] * iv, sp[(4 * q + 3) * 33] * iv, pk, true); w[q] = (unsigned)pk; }
                else { unsigned pk = 0u;
#pragma unroll
                    for (int e = 0; e < 4; ++e) { const int qi = (int)__builtin_rintf(sp[(4 * q + e) * 33] * iv); pk |= ((unsigned)qi & 0xffu) << (8 * e); }
                    w[q] = pk; } }
            GAS char* db = (GAS char*)W8 + (size_t)(kb >> kbsh) * estride + (size_t)(drow0 + 16 * j) * rowlen + 64 * (kb & kmask);
            *(GAS u32x4*)(db + (unsigned)((lane >> 2) * rowlen + 16 * c)) = (u32x4){w[0], w[1], w[2], w[3]}; }
        asm volatile("s_waitcnt lgkmcnt(0)" ::: "memory"); }
}
DI void p0_prologue(Frame& F) {
    unsigned char* const ws = KWS;
    const int gw = blockIdx.x * NWAVES + F.wave, NGW = F.G * NWAVES;
    const int gtid = blockIdx.x * 512 + F.tid, NT = F.G * 512;
    {
        LAS float* scr = (LAS float*)(F.lds + F.wave * 16384);
        constexpr int I_O = 16 * 32, I_D = 8 * 32;
        constexpr int S_QKV = 2 * 48, S_IN = 2 * 96, S_GO = 2 * 32, S_AO = 2 * 32, S_GU = 64 * 32, N_STRIPS = S_QKV + S_IN + S_GO + S_AO + S_GU;
        { int cnt = 0;
          for (int it = blockIdx.x; it < 512 + N_STRIPS; it += F.G, ++cnt) { const int par = cnt & 1;
            if (it < 512) { const int lg = it >> 5, nb = it & 31;
                wstrip_blk<true, 4>(F.lds, F.wave, F.lane, KIN(I_MD) + (size_t)lg * 4 * 512 * 1024, 1024, 3, (size_t)1024 * 512, 512, (signed char*)(ws + WS_WD) + (size_t)lg * 4 * 1024 * 512, 32 * nb, 32 * nb, (float*)(ws + WS_SBD) + lg * 1024, par); continue; }
            int r = it - 512;
            if (r < S_QKV) { const int j = r / 48, nb = r % 48; wstrip_blk<false, 2>(F.lds, F.wave, F.lane, KIN(I_WQKV) + (size_t)j * 1024 * NQKV, NQKV, 4, 0, 1024, (signed char*)(ws + WS_WQKV) + (size_t)j * NQKV * 1024, 32 * nb, 32 * nb, (float*)(ws + WS_SBQKV) + j * NQKV, par); continue; } r -= S_QKV;
            if (r < S_IN) { const int j = r / 96, nb = r % 96; wstrip_blk<false, 2>(F.lds, F.wave, F.lane, KIN(I_GWIN) + (size_t)j * 1024 * 3072, 3072, 4, 0, 1024, (signed char*)(ws + WS_WIN) + (size_t)j * NGIN * 1024, 32 * nb, 32 * nb, (float*)(ws + WS_SBIN) + j * NGIN, par); continue; } r -= S_IN;
            if (r < S_GO) { const int j = r / 32, nb = r % 32; wstrip_blk<false, 2>(F.lds, F.wave, F.lane, KIN(I_GWO) + (size_t)j * 1024 * 1024, 1024, 4, 0, 1024, (signed char*)(ws + WS_WGO) + (size_t)j * 1024 * 1024, 32 * nb, 32 * nb, (float*)(ws + WS_SBGO) + j * 1024, par); continue; } r -= S_GO;
            if (r < S_AO) { const int j = r / 32, nb = r % 32; wstrip_blk<true, 2>(F.lds, F.wave, F.lane, KIN(I_WO) + (size_t)j * 1024 * 1024, 1024, 4, 0, 1024, (signed char*)(ws + WS_WO) + (size_t)j * 1024 * 1024, 32 * nb, 32 * nb, (float*)(ws + WS_SBO) + j * 1024, par); continue; } r -= S_AO;
            { const int le = r >> 5, q = r & 31, up = q >> 4, nb = q & 15; const int n0 = 32 * nb;
              wstrip_blk<false, 2>(F.lds, F.wave, F.lane, (up ? KIN(I_MU) : KIN(I_MG)) + (size_t)le * 1024 * 512, 512, 4, 0, 1024, (signed char*)(ws + WS_WGU) + (size_t)le * 1024 * 1024, n0, (n0 >> 7) * 256 + up * 128 + (n0 & 127), (float*)(ws + WS_SBGU) + le * 1024, par); } } }
        { const float* wa1 = KIN(I_GWA1); signed char* Win8 = (signed char*)(ws + WS_WIN); float* sbin = (float*)(ws + WS_SBIN);
          for (int rw = gw; rw < 2 * 256; rw += NGW) { const int j = rw >> 8, rr = rw & 255; float v[16]; float am = 0.f;
#pragma unroll
              for (int e = 0; e < 16; ++e) { v[e] = rr < 32 ? wa1[(((size_t)j * 2 + (rr >> 4)) * 1024 + 16 * F.lane + e) * 16 + (rr & 15)] : 0.f; am = fmaxf(am, fabsf(v[e])); }
#pragma unroll
              for (int o = 1; o < 64; o <<= 1) am = fmaxf(am, shx(am, o, F.lane));
              const float iv = am > 0.f ? 127.0f / am : 0.f; unsigned w[4];
#pragma unroll
              for (int q = 0; q < 4; ++q) { unsigned pk = 0u;
#pragma unroll
                  for (int e = 0; e < 4; ++e) { const int qi = (int)__builtin_rintf(v[4 * q + e] * iv); pk |= ((unsigned)qi & 0xffu) << (8 * e); }
                  w[q] = pk; }
              *(u32x4*)(Win8 + ((size_t)j * NGIN + 3072 + rr) * 1024 + 16 * F.lane) = (u32x4){w[0], w[1], w[2], w[3]};
              if (F.lane == 0) sbin[j * NGIN + 3072 + rr] = am > 0.f ? am * (1.0f / 127.0f) : 1.0f; } }
    }
    __syncthreads();
    {
        LAS float* sl = (LAS float*)F.lds;
        LAS float* red = (LAS float*)(F.lds + 40960);
        float* modp = ((float*)(ws + WS_MOD));
        const int kq = F.wave & 3, chh = F.wave >> 2;
        for (int it = blockIdx.x; it < 4 * 48; it += F.G) {
            const int l = it / 48, n0 = (it % 48) * 128;
            const float* W = KIN(I_ADAW) + (size_t)l * 1024 * 6144 + n0 + 64 * chh + F.lane; const float* cin = KIN(I_C); const float* ccin = KIN(I_CCTX); const float* adab = KIN(I_ADAB);
            float acc[33];
#pragma unroll
            for (int i = 0; i < 33; ++i) acc[i] = 0.f;
            for (int kc = 0; kc < 4; ++kc) {
                __syncthreads();
                for (int idx = F.tid; idx < 33 * 256; idx += 512) { const int mb = idx >> 8, k = idx & 255; const float cv = mb < 32 ? cin[mb * 1024 + kc * 256 + k] : ccin[kc * 256 + k]; sl[k * 36 + mb] = siluf_(cv); }
                __syncthreads();
                for (int kk0 = 0; kk0 < 64; kk0 += 16) { float wv[16];
#pragma unroll
                    for (int i = 0; i < 16; ++i) wv[i] = W[(size_t)(kc * 256 + kq * 64 + kk0 + i) * 6144];
#pragma unroll
                    for (int i = 0; i < 16; ++i) { const int k = kq * 64 + kk0 + i; const LAS f32x4* sp = (const LAS f32x4*)(sl + k * 36);
#pragma unroll
                        for (int q = 0; q < 8; ++q) { const f32x4 s4 = sp[q]; acc[4 * q] += s4[0] * wv[i]; acc[4 * q + 1] += s4[1] * wv[i]; acc[4 * q + 2] += s4[2] * wv[i]; acc[4 * q + 3] += s4[3] * wv[i]; }
                        acc[32] += sl[k * 36 + 32] * wv[i]; } }
            }
#pragma unroll
            for (int i = 0; i < 33; ++i) red[(kq * 33 + i) * 128 + 64 * chh + F.lane] = acc[i];
            __syncthreads();
            for (int idx = F.tid; idx < 33 * 128; idx += 512) { const int mb = idx >> 7, nn = idx & 127; float sm = 0.f;
#pragma unroll
                for (int q = 0; q < 4; ++q) sm += red[(q * 33 + mb) * 128 + nn];
                modp[((size_t)l * 33 + mb) * 6144 + n0 + nn] = sm + adab[l * 6144 + n0 + nn]; }
            __syncthreads();
        }
    }
    if (blockIdx.x == 0) { float* ropep = ((float*)(ws + WS_ROPE)); for (int idx = F.tid; idx < 64 * 16; idx += 512) { const int pos = idx >> 4, j = idx & 15;
        const float inv = __builtin_amdgcn_exp2f(-(float)j * 0.8304820237218406f); const float ang = (float)pos * inv;
        const float kq = rintf(ang * 0.15915494309189535f); float r = fmaf(-kq, 6.28318548202514648f, ang); r = fmaf(-kq, -1.7484556000744883e-7f, r);
        ropep[pos * 32 + j] = cosf(r); ropep[pos * 32 + 16 + j] = sinf(r); } }
}

DI int moe_table(Frame& F, int layer) {
    LAS int* bs = (LAS int*)(F.lds + MOE_TAB_OFF); LAS int* cnt = bs + 32;
    __syncthreads();
    if (F.tid < NCLS) cnt[F.tid] = (int)__hip_atomic_load((unsigned*)KWS + CW_MOE + 32 * layer + F.tid, __ATOMIC_RELAXED, __HIP_MEMORY_SCOPE_AGENT);
    __syncthreads();
    if (F.tid == 0) { int a = 0; for (int k = 0; k < NCLS; ++k) { bs[k] = a; a += (cnt[k] + 255) >> 8; } bs[NCLS] = a; }
    __syncthreads();
    return __builtin_amdgcn_readfirstlane(bs[NCLS]);
}
DI void unpack16(const u32x4& a, const u32x4& b, float (&v)[16]) {
    v[0] = bf_lo(a.x); v[1] = bf_hi(a.x); v[2] = bf_lo(a.y); v[3] = bf_hi(a.y); v[4] = bf_lo(a.z); v[5] = bf_hi(a.z); v[6] = bf_lo(a.w); v[7] = bf_hi(a.w);
    v[8] = bf_lo(b.x); v[9] = bf_hi(b.x); v[10] = bf_lo(b.y); v[11] = bf_hi(b.y); v[12] = bf_lo(b.z); v[13] = bf_hi(b.z); v[14] = bf_lo(b.w); v[15] = bf_hi(b.w);
}
DI void unpack16_f8(unsigned a0, unsigned a1, unsigned b0, unsigned b1, float (&v)[16]) {
    f32x2 t;
    t = __builtin_amdgcn_cvt_pk_f32_fp8((int)a0, false); v[0] = t.x; v[1] = t.y; t = __builtin_amdgcn_cvt_pk_f32_fp8((int)a0, true); v[2] = t.x; v[3] = t.y;
    t = __builtin_amdgcn_cvt_pk_f32_fp8((int)a1, false); v[4] = t.x; v[5] = t.y; t = __builtin_amdgcn_cvt_pk_f32_fp8((int)a1, true); v[6] = t.x; v[7] = t.y;
    t = __builtin_amdgcn_cvt_pk_f32_fp8((int)b0, false); v[8] = t.x; v[9] = t.y; t = __builtin_amdgcn_cvt_pk_f32_fp8((int)b0, true); v[10] = t.x; v[11] = t.y;
    t = __builtin_amdgcn_cvt_pk_f32_fp8((int)b1, false); v[12] = t.x; v[13] = t.y; t = __builtin_amdgcn_cvt_pk_f32_fp8((int)b1, true); v[14] = t.x; v[15] = t.y;
}
DI void pack16(const float (&v)[16], u32x4& a, u32x4& b) {
    a.x = cvt_pk_bf16(v[0], v[1]); a.y = cvt_pk_bf16(v[2], v[3]); a.z = cvt_pk_bf16(v[4], v[5]); a.w = cvt_pk_bf16(v[6], v[7]);
    b.x = cvt_pk_bf16(v[8], v[9]); b.y = cvt_pk_bf16(v[10], v[11]); b.z = cvt_pk_bf16(v[12], v[13]); b.w = cvt_pk_bf16(v[14], v[15]);
}
DI float quant_row_i8(const float (&v)[16], signed char* dst_row, int c0, int lane) {
    float am = 0.f;
#pragma unroll
    for (int e = 0; e < 16; ++e) am = fmaxf(am, fabsf(v[e]));
    am = wave_max(am, lane);
    const float inv = am > 0.f ? 127.0f / am : 0.f;
    unsigned w[4];
#pragma unroll
    for (int q = 0; q < 4; ++q) { unsigned p = 0u;
#pragma unroll
        for (int e = 0; e < 4; ++e) { const int qi = (int)__builtin_rintf(v[4 * q + e] * inv); p |= ((unsigned)qi & 0xffu) << (8 * e); }
        w[q] = p; }
    *(u32x2*)(dst_row + c0) = (u32x2){w[0], w[1]}; *(u32x2*)(dst_row + 512 + c0) = (u32x2){w[2], w[3]};
    return am * (1.0f / 127.0f);
}
template <bool ROUTER>
DI void norm_phase(Frame& F, int layer) {
    unsigned char* const ws = KWS;
    const float* gain = (ROUTER ? KIN(I_NFFN) : KIN(I_NMIX)) + layer * 1024;
    const float* modl = (const float*)(ws + WS_MOD) + (size_t)layer * 33 * 6144 + (ROUTER ? 3 * 1024 : 0);
    const float* gatel = ROUTER ? (const float*)(ws + WS_MOD) + (size_t)layer * 33 * 6144 + 2 * 1024 : (const float*)(ws + WS_MOD) + (size_t)(layer > 0 ? layer - 1 : 0) * 33 * 6144 + 5 * 1024;
    const int ymode = ROUTER ? 1 : (layer > 0 ? 2 : 0);
    const bool src32 = !ROUTER && layer == 0;
    bf16_t* XRp = (bf16_t*)(ws + WS_XR); bf16_t* Hp = (bf16_t*)(ws + WS_H);
    const unsigned char* Yp = ROUTER ? (const unsigned char*)(ws + WS_H) : (const unsigned char*)(ws + WS_R3);
    const int* tokpos = (const int*)(ws + WS_TOKPOS);
    const float* xin = nullptr; const float* cxin = nullptr;
    if (!ROUTER) { xin = KIN(I_X); cxin = KIN(I_CTX); if (ymode == 2) (void)moe_table(F, layer - 1); }
    const LAS int* bs = (const LAS int*)(F.lds + MOE_TAB_OFF);
    const int NROWS = (ROUTER && layer == DEPTH - 1) ? NL : MT;
    const int RPB = (NROWS + F.G - 1) / F.G, RPW = (RPB + 7) / 8;
    const int brow0 = blockIdx.x * RPB; int bend = brow0 + RPB; if (bend > NROWS) bend = NROWS;
    const int row0 = brow0 + F.wave * RPW; int rend = row0 + RPW; if (rend > bend) rend = bend;
    LAS float* RW = (LAS float*)F.lds;
    LAS float* WL = (LAS float*)(F.lds + 67584) + F.wave * 64;
    LAS int* lcnt = (LAS int*)(F.lds + 69632); LAS int* lbase = (LAS int*)(F.lds + 69760);
    LAS int* rec = (LAS int*)(F.lds + 69888); LAS f32x2* recg = (LAS f32x2*)(F.lds + 73984);
    float rb[16];
    if (ROUTER) {
        const float* rwp = KIN(I_RW); const float* rbp = KIN(I_RB);
        for (int idx = F.tid; idx < 1024 * 16; idx += 512) { const int col = idx >> 4, e = idx & 15; RW[(col >> 3) * 132 + (col & 7) * 16 + e] = rwp[idx]; }
        if (F.tid < 32) lcnt[F.tid] = 0;
#pragma unroll
        for (int e = 0; e < 16; ++e) rb[e] = rbp[e];
        __syncthreads();
    }
    float gs[16], sh[16], gy[16]; int mb = -1;
    const int c0 = 8 * F.lane;
    constexpr int NBR = ROUTER ? 2 : 4;
    u32x4 xa[NBR], xb[NBR], ya[NBR], yb[NBR]; f32x4 xs[NBR][4];
    u32x4 nxa[NBR], nxb[NBR], nya[NBR], nyb[NBR]; f32x4 nxs[NBR][4];
#define NORM_LOAD(XA, XB, YA, YB, XS, rowb_) do { _Pragma("unroll") for (int u = 0; u < NBR; ++u) { const int rr = (rowb_) + u < rend ? (rowb_) + u : rend - 1; \
            if (!ROUTER && src32) { const float* src = rr < NL ? xin + (size_t)rr * 1024 : cxin + (size_t)(rr - NL) * 1024; \
                XS[u][0] = *(const f32x4*)(src + c0); XS[u][1] = *(const f32x4*)(src + c0 + 4); XS[u][2] = *(const f32x4*)(src + 512 + c0); XS[u][3] = *(const f32x4*)(src + 512 + c0 + 4); } \
            else { const bf16_t* xr = XRp + (size_t)rr * 1024; XA[u] = *(const u32x4*)(xr + c0); XB[u] = *(const u32x4*)(xr + 512 + c0); } \
            if (ymode) { size_t yrow = (size_t)rr; if (!ROUTER) { const int tp = tokpos[rr]; yrow = (size_t)bs[tp & 0xff] * 256 + (size_t)(tp >> 8); } \
                const unsigned char* yr = Yp + yrow * 1024; const u32x2 ta_ = *(const u32x2*)(yr + c0), tb_ = *(const u32x2*)(yr + 512 + c0); YA[u].x = ta_.x; YA[u].y = ta_.y; YB[u].x = tb_.x; YB[u].y = tb_.y; } } } while (0)
    constexpr bool PF = ROUTER;
    if (PF) { if (row0 < rend) NORM_LOAD(xa, xb, ya, yb, xs, row0); }
    for (int rowb = row0; rowb < rend; rowb += NBR) {
        if (PF) { if (rowb + NBR < rend) NORM_LOAD(nxa, nxb, nya, nyb, nxs, rowb + NBR); } else NORM_LOAD(xa, xb, ya, yb, xs, rowb);
#pragma unroll
        for (int up = 0; up < NBR; up += 2) {
        float vv[2][16];
#pragma unroll
        for (int u2 = 0; u2 < 2; ++u2) { const int u = up + u2; const int row = rowb + u; float (&v)[16] = vv[u2];
        if (row < rend) {
        const int mbn = row < NL ? (row >> 11) : 32;
        if (mbn != mb) { mb = mbn; const float* mp = modl + (size_t)mb * 6144; const float* gp = gatel + (size_t)mb * 6144;
#pragma unroll
            for (int hh = 0; hh < 2; ++hh)
#pragma unroll
                for (int q = 0; q < 2; ++q) { const int cc = hh * 512 + c0 + 4 * q; const f32x4 g4 = *(const f32x4*)(gain + cc), s4 = *(const f32x4*)(mp + 1024 + cc), h4 = *(const f32x4*)(mp + cc), y4 = *(const f32x4*)(gp + cc);
#pragma unroll
                    for (int e = 0; e < 4; ++e) { gs[hh * 8 + q * 4 + e] = g4[e] * (1.0f + s4[e]); sh[hh * 8 + q * 4 + e] = h4[e]; gy[hh * 8 + q * 4 + e] = y4[e] * (1.0f / Y_SCALE); } } }
        if (!ROUTER && src32) {
#pragma unroll
            for (int q = 0; q < 4; ++q)
#pragma unroll
                for (int e = 0; e < 4; ++e) v[4 * q + e] = xs[u][q][e]; }
        else unpack16(xa[u], xb[u], v);
        if (ymode) { float yv[16]; unpack16_f8(ya[u].x, ya[u].y, yb[u].x, yb[u].y, yv);
#pragma unroll
            for (int e = 0; e < 16; ++e) v[e] += gy[e] * yv[e]; }
        if (ymode || src32) { u32x4 wa, wb; pack16(v, wa, wb); bf16_t* xw = XRp + (size_t)row * 1024; *(u32x4*)(xw + c0) = wa; *(u32x4*)(xw + 512 + c0) = wb; }
        float ss = 0.f;
#pragma unroll
        for (int e = 0; e < 16; ++e) ss += v[e] * v[e];
        ss = wave_sum(ss, F.lane);
        const float rstd = 1.0f / sqrtf(ss * (1.0f / 1024.0f) + RMS_EPS);
#pragma unroll
        for (int e = 0; e < 16; ++e) v[e] = v[e] * rstd * gs[e] + sh[e];
        if (ROUTER) { u32x4 oa, ob; pack16(v, oa, ob); bf16_t* hr = Hp + (size_t)row * 1024; *(u32x4*)(hr + c0) = oa; *(u32x4*)(hr + 512 + c0) = ob; }
        else { const float sc_ = quant_row_i8(v, (signed char*)Hp + (size_t)row * 1024, c0, F.lane); if (F.lane == 0) ((float*)(ws + WS_SA))[row] = sc_; }
        } else {
#pragma unroll
            for (int e = 0; e < 16; ++e) v[e] = 0.f; }
        }
        if (ROUTER) {
            float pl[2][16];
#pragma unroll
            for (int u = 0; u < 2; ++u)
#pragma unroll
                for (int e = 0; e < 16; ++e) pl[u][e] = 0.f;
#pragma unroll
            for (int jj = 0; jj < 16; ++jj) { const LAS f32x4* wp = (const LAS f32x4*)(RW + ((jj >> 3) * 64 + F.lane) * 132 + (jj & 7) * 16);
#pragma unroll
                for (int q = 0; q < 4; ++q) { const f32x4 w4 = wp[q];
#pragma unroll
                    for (int u = 0; u < 2; ++u) { const float x = vv[u][jj]; pl[u][4 * q] += x * w4[0]; pl[u][4 * q + 1] += x * w4[1]; pl[u][4 * q + 2] += x * w4[2]; pl[u][4 * q + 3] += x * w4[3]; } } }
#pragma unroll
            for (int u = 0; u < 2; ++u) {
                float v8[8], v4[4], v2[2], v1;
                { const bool bt = (F.lane >> 5) & 1;
#pragma unroll
                  for (int i = 0; i < 8; ++i) { const float mine = bt ? pl[u][8 + i] : pl[u][i], theirs = bt ? pl[u][i] : pl[u][8 + i]; v8[i] = mine + shx(theirs, 32, F.lane); } }
                { const bool bt = (F.lane >> 4) & 1;
#pragma unroll
                  for (int i = 0; i < 4; ++i) { const float mine = bt ? v8[4 + i] : v8[i], theirs = bt ? v8[i] : v8[4 + i]; v4[i] = mine + shx(theirs, 16, F.lane); } }
                { const bool bt = (F.lane >> 3) & 1;
#pragma unroll
                  for (int i = 0; i < 2; ++i) { const float mine = bt ? v4[2 + i] : v4[i], theirs = bt ? v4[i] : v4[2 + i]; v2[i] = mine + shx(theirs, 8, F.lane); } }
                { const bool bt = (F.lane >> 2) & 1; const float mine = bt ? v2[1] : v2[0], theirs = bt ? v2[0] : v2[1]; v1 = mine + shx(theirs, 4, F.lane); }
                v1 += shx(v1, 2, F.lane); v1 += shx(v1, 1, F.lane);
                { const int ei = ((F.lane >> 5) & 1) * 8 + ((F.lane >> 4) & 1) * 4 + ((F.lane >> 3) & 1) * 2 + ((F.lane >> 2) & 1); WL[(F.lane & 3) == 0 ? u * 16 + ei : 32 + (F.lane >> 1)] = v1; }
            }
            asm volatile("s_waitcnt lgkmcnt(0)" ::: "memory");
            const int ur = F.lane & 1;
            float sc[16], sel[16];
#pragma unroll
            for (int q = 0; q < 4; ++q) { const f32x4 l4 = ((const LAS f32x4*)(WL + ur * 16))[q];
#pragma unroll
                for (int e = 0; e < 4; ++e) { sc[4 * q + e] = sigmoidf_(l4[e]); sel[4 * q + e] = sc[4 * q + e] + rb[4 * q + e]; } }
            asm volatile("s_waitcnt lgkmcnt(0)" ::: "memory");
            int grp = 0; float best = -1e30f;
#pragma unroll
            for (int g = 0; g < 4; ++g) { const float a = sel[4 * g], b = sel[4 * g + 1], c = sel[4 * g + 2], d = sel[4 * g + 3];
                const float m1 = fmaxf(fmaxf(a, b), fmaxf(c, d)); const float lo1 = fminf(a, b), hi1 = fmaxf(a, b), lo2 = fminf(c, d), hi2 = fmaxf(c, d);
                const float m2 = fmaxf(fminf(hi1, hi2), fmaxf(lo1, lo2)); const float gsum = m1 + m2;
                if (gsum > best) { best = gsum; grp = g; } }
            float s4[4], c4[4];
#pragma unroll
            for (int e = 0; e < 4; ++e) { s4[e] = grp == 0 ? sel[e] : (grp == 1 ? sel[4 + e] : (grp == 2 ? sel[8 + e] : sel[12 + e])); c4[e] = grp == 0 ? sc[e] : (grp == 1 ? sc[4 + e] : (grp == 2 ? sc[8 + e] : sc[12 + e])); }
            int i1 = 0; float b1 = s4[0];
#pragma unroll
            for (int e = 1; e < 4; ++e) if (s4[e] > b1) { b1 = s4[e]; i1 = e; }
            int i2 = -1; float b2 = -1e30f;
#pragma unroll
            for (int e = 0; e < 4; ++e) if (e != i1 && s4[e] > b2) { b2 = s4[e]; i2 = e; }
            const float g1 = i1 == 0 ? c4[0] : (i1 == 1 ? c4[1] : (i1 == 2 ? c4[2] : c4[3])), g2 = i2 == 0 ? c4[0] : (i2 == 1 ? c4[1] : (i2 == 2 ? c4[2] : c4[3]));
            const float inv = 1.0f / (g1 + g2);
            const int lo = i1 < i2 ? i1 : i2, hi = i1 < i2 ? i2 : i1;
            const int pidx = lo == 0 ? hi - 1 : (lo == 1 ? hi + 1 : 5);
            const int cls = grp * 6 + pidx;
            const float glo = (i1 < i2 ? g1 : g2) * inv, ghi = (i1 < i2 ? g2 : g1) * inv;
            if (F.lane < 2 && rowb + up + F.lane < rend) { const int sl_ = __hip_atomic_fetch_add(lcnt + cls, 1, __ATOMIC_RELAXED, __HIP_MEMORY_SCOPE_WORKGROUP); const int rbi = rowb + up + F.lane - brow0; rec[rbi] = cls | (sl_ << 8); recg[rbi] = (f32x2){glo, ghi}; }
        }
        }
        if (PF) {
#pragma unroll
            for (int u = 0; u < NBR; ++u) { xa[u] = nxa[u]; xb[u] = nxb[u]; ya[u] = nya[u]; yb[u] = nyb[u]; } }
    }
#undef NORM_LOAD
    if (ROUTER) {
        __syncthreads();
        if (F.tid < NCLS) { const int n = lcnt[F.tid]; int base = 0; if (n > 0) base = (int)__hip_atomic_fetch_add((unsigned*)ws + CW_MOE + 32 * layer + F.tid, (unsigned)n, __ATOMIC_RELAXED, __HIP_MEMORY_SCOPE_AGENT); lbase[F.tid] = base; }
        __syncthreads();
        int* listp = (int*)(ws + WS_LIST); f32x2* glistp = (f32x2*)(ws + WS_GLIST); int* tpw = (int*)(ws + WS_TOKPOS);
        for (int rbi = F.tid; rbi < bend - brow0; rbi += 512) { const int rc = rec[rbi]; const int cls = rc & 0xff; const int slot = lbase[cls] + (rc >> 8);
            listp[(size_t)cls * MT + slot] = brow0 + rbi; glistp[(size_t)cls * MT + slot] = recg[rbi]; tpw[brow0 + rbi] = cls | (slot << 8); }
        __syncthreads();
    }
}

DI void route_decide(const float (&lg)[16], const float (&rb)[16], int& cls, float& glo, float& ghi) {
    float sc[16], sel[16];
#pragma unroll
    for (int e = 0; e < 16; ++e) { sc[e] = sigmoidf_(lg[e]); sel[e] = sc[e] + rb[e]; }
    int grp = 0; float best = -1e30f;
#pragma unroll
    for (int g = 0; g < 4; ++g) { const float a = sel[4 * g], b = sel[4 * g + 1], c = sel[4 * g + 2], d = sel[4 * g + 3];
        const float m1 = fmaxf(fmaxf(a, b), fmaxf(c, d)); const float lo1 = fminf(a, b), hi1 = fmaxf(a, b), lo2 = fminf(c, d), hi2 = fmaxf(c, d);
        const float m2 = fmaxf(fminf(hi1, hi2), fmaxf(lo1, lo2)); const float gsum = m1 + m2;
        if (gsum > best) { best = gsum; grp = g; } }
    float s4[4], c4[4];
#pragma unroll
    for (int e = 0; e < 4; ++e) { s4[e] = grp == 0 ? sel[e] : (grp == 1 ? sel[4 + e] : (grp == 2 ? sel[8 + e] : sel[12 + e])); c4[e] = grp == 0 ? sc[e] : (grp == 1 ? sc[4 + e] : (grp == 2 ? sc[8 + e] : sc[12 + e])); }
    int i1 = 0; float b1 = s4[0];
#pragma unroll
    for (int e = 1; e < 4; ++e) if (s4[e] > b1) { b1 = s4[e]; i1 = e; }
    int i2 = -1; float b2 = -1e30f;
#pragma unroll
    for (int e = 0; e < 4; ++e) if (e != i1 && s4[e] > b2) { b2 = s4[e]; i2 = e; }
    const float g1 = i1 == 0 ? c4[0] : (i1 == 1 ? c4[1] : (i1 == 2 ? c4[2] : c4[3])), g2 = i2 == 0 ? c4[0] : (i2 == 1 ? c4[1] : (i2 == 2 ? c4[2] : c4[3]));
    const float inv = 1.0f / (g1 + g2);
    const int lo = i1 < i2 ? i1 : i2, hi = i1 < i2 ? i2 : i1;
    const int pidx = lo == 0 ? hi - 1 : (lo == 1 ? hi + 1 : 5);
    cls = grp * 6 + pidx;
    glo = (i1 < i2 ? g1 : g2) * inv; ghi = (i1 < i2 ? g2 : g1) * inv;
}

DI void n2_phase(Frame& F, int layer) {
    unsigned char* const ws = KWS;
    const float* gain = KIN(I_NFFN) + layer * 1024;
    const float* modl = (const float*)(ws + WS_MOD) + (size_t)layer * 33 * 6144 + 3 * 1024;
    const float* gatel = (const float*)(ws + WS_MOD) + (size_t)layer * 33 * 6144 + 2 * 1024;
    bf16_t* XRp = (bf16_t*)(ws + WS_XR); const unsigned char* Hp = ws + WS_H;
    const int NROWS = (layer == DEPTH - 1) ? NL : MT;
    const int RPB = (NROWS + F.G - 1) / F.G;
    const int brow0 = blockIdx.x * RPB; int bend = brow0 + RPB; if (bend > NROWS) bend = NROWS;
    const int nsteps = (bend - brow0 + 15) >> 4;
    constexpr int AST = 2064;
    LAS unsigned char* AH = F.lds; LAS unsigned char* AL = F.lds + 16 * AST; LAS unsigned char* WH = F.lds + 32 * AST; LAS unsigned char* WLo = F.lds + 48 * AST;
    LAS float* PART = (LAS float*)(F.lds + 64 * AST);
    LAS float* RB = (LAS float*)(F.lds + 64 * AST + 16384);
    LAS int* lcnt = (LAS int*)(F.lds + 64 * AST + 16384 + 128); LAS int* lbase = lcnt + 32;
    LAS int* rec = lbase + 32; LAS f32x2* recg = (LAS f32x2*)(rec + 512); LAS float* rsa = (LAS float*)(recg + 512);
    static_assert(64 * AST + 16384 + 128 + 256 + 2048 + 4096 + 2048 <= PHASE_LDS, "N2 LDS map");
    { const float* rwp = KIN(I_RW); const float* rbp = KIN(I_RB);
      for (int idx = F.tid; idx < 1024 * 16; idx += 512) { const int k = idx >> 4, e = idx & 15; const float w = rwp[idx]; const unsigned hh = cvt_pk_bf16(w, 0.f) & 0xffffu; const unsigned ll = cvt_pk_bf16(w - bf_lo(hh), 0.f) & 0xffffu;
          *(LAS unsigned short*)(WH + e * AST + 2 * k) = (unsigned short)hh; *(LAS unsigned short*)(WLo + e * AST + 2 * k) = (unsigned short)ll; }
      if (F.tid < 16) RB[F.tid] = rbp[F.tid];
      if (F.tid < 32) lcnt[F.tid] = 0; }
    __syncthreads();
    float gs[16], sh[16], gy[16]; int mb = -1;
    const int c0 = 8 * F.lane;
    const int i16 = F.lane & 15, qd = F.lane >> 4;
    u32x4 xa[2], xb[2], ya[2], yb[2], nxa[2], nxb[2], nya[2], nyb[2];
#define N2_LOAD(XA, XB, YA, YB, st_) do { _Pragma("unroll") for (int u = 0; u < 2; ++u) { int rr = brow0 + 16 * (st_) + 2 * F.wave + u; rr = rr < bend ? rr : bend - 1; \
            const bf16_t* xr = XRp + (size_t)rr * 1024; XA[u] = *(const u32x4*)(xr + c0); XB[u] = *(const u32x4*)(xr + 512 + c0); \
            const unsigned char* yr = Hp + (size_t)rr * 1024; const u32x2 ta_ = *(const u32x2*)(yr + c0), tb_ = *(const u32x2*)(yr + 512 + c0); YA[u].x = ta_.x; YA[u].y = ta_.y; YB[u].x = tb_.x; YB[u].y = tb_.y; } } while (0)
    if (nsteps > 0) N2_LOAD(xa, xb, ya, yb, 0);
    for (int st = 0; st < nsteps; ++st) {
#pragma unroll
        for (int u = 0; u < 2; ++u) { const int t = 2 * F.wave + u; const int row = brow0 + 16 * st + t;
            u32x4 oa = (u32x4){0u, 0u, 0u, 0u}, ob = oa, la = oa, lb = oa;
            if (row < bend) {
                const int mbn = row < NL ? (row >> 11) : 32;
                if (mbn != mb) { mb = mbn; const float* mp = modl + (size_t)mb * 6144; const float* gp = gatel + (size_t)mb * 6144;
#pragma unroll
                    for (int hh = 0; hh < 2; ++hh)
#pragma unroll
                        for (int q = 0; q < 2; ++q) { const int cc = hh * 512 + c0 + 4 * q; const f32x4 g4 = *(const f32x4*)(gain + cc), s4 = *(const f32x4*)(mp + 1024 + cc), h4 = *(const f32x4*)(mp + cc), y4 = *(const f32x4*)(gp + cc);
#pragma unroll
                            for (int e = 0; e < 4; ++e) { gs[hh * 8 + q * 4 + e] = g4[e] * (1.0f + s4[e]); sh[hh * 8 + q * 4 + e] = h4[e]; gy[hh * 8 + q * 4 + e] = y4[e] * (1.0f / Y_SCALE); } } }
                float v[16], yv[16]; unpack16(xa[u], xb[u], v); unpack16_f8(ya[u].x, ya[u].y, yb[u].x, yb[u].y, yv);
#pragma unroll
                for (int e = 0; e < 16; ++e) v[e] += gy[e] * yv[e];
                { u32x4 wa, wb; pack16(v, wa, wb); bf16_t* xw = XRp + (size_t)row * 1024; *(u32x4*)(xw + c0) = wa; *(u32x4*)(xw + 512 + c0) = wb; }
                float ss = 0.f;
#pragma unroll
                for (int e = 0; e < 16; ++e) ss += v[e] * v[e];
                ss = wave_sum(ss, F.lane);
                const float rstd = 1.0f / sqrtf(ss * (1.0f / 1024.0f) + RMS_EPS);
#pragma unroll
                for (int e = 0; e < 16; ++e) v[e] = v[e] * rstd * gs[e] + sh[e];
                pack16(v, oa, ob);
                { const float sc_ = quant_row_i8(v, (signed char*)(ws + WS_R3) + (size_t)row * 1024, c0, F.lane); if (F.lane == 0) rsa[row - brow0] = sc_; }
                float lo[16]; { float hv[16]; unpack16(oa, ob, hv);
#pragma unroll
                    for (int e = 0; e < 16; ++e) lo[e] = v[e] - hv[e]; }
                pack16(lo, la, lb);
            }
            *(LAS u32x4*)(AH + t * AST + 2 * c0) = oa; *(LAS u32x4*)(AH + t * AST + 1024 + 2 * c0) = ob;
            *(LAS u32x4*)(AL + t * AST + 2 * c0) = la; *(LAS u32x4*)(AL + t * AST + 1024 + 2 * c0) = lb; }
        if (st + 1 < nsteps) N2_LOAD(nxa, nxb, nya, nyb, st + 1);
        __syncthreads();
        { f32x4 acc = (f32x4){0.f, 0.f, 0.f, 0.f};
#pragma unroll
          for (int kk = 0; kk < 4; ++kk) { const int ko = (32 * (4 * F.wave + kk) + 8 * qd) * 2;
              const bf16x8 wh = *(const LAS bf16x8*)(WH + i16 * AST + ko), wl = *(const LAS bf16x8*)(WLo + i16 * AST + ko), fh = *(const LAS bf16x8*)(AH + i16 * AST + ko), fl = *(const LAS bf16x8*)(AL + i16 * AST + ko);
              acc = MFMA16(wh, fh, acc); acc = MFMA16(wh, fl, acc); acc = MFMA16(wl, fh, acc); }
          *(LAS f32x4*)(PART + (((st & 1) * 8 + F.wave) * 16 + i16) * 16 + 4 * qd) = acc; }
        __syncthreads();
        if (F.wave == (st & 7)) {
            float lg[16], rb[16];
#pragma unroll
            for (int e = 0; e < 16; ++e) lg[e] = 0.f;
#pragma unroll
            for (int w = 0; w < 8; ++w)
#pragma unroll
                for (int q = 0; q < 4; ++q) { const f32x4 p4 = *(const LAS f32x4*)(PART + (((st & 1) * 8 + w) * 16 + i16) * 16 + 4 * q); lg[4 * q] += p4[0]; lg[4 * q + 1] += p4[1]; lg[4 * q + 2] += p4[2]; lg[4 * q + 3] += p4[3]; }
#pragma unroll
            for (int q = 0; q < 4; ++q) { const f32x4 r4 = ((const LAS f32x4*)RB)[q]; rb[4 * q] = r4[0]; rb[4 * q + 1] = r4[1]; rb[4 * q + 2] = r4[2]; rb[4 * q + 3] = r4[3]; }
            int cls; float glo, ghi; route_decide(lg, rb, cls, glo, ghi);
            const int rbi = 16 * st + F.lane;
            if (F.lane < 16 && brow0 + rbi < bend) { const int sl_ = __hip_atomic_fetch_add(lcnt + cls, 1, __ATOMIC_RELAXED, __HIP_MEMORY_SCOPE_WORKGROUP); rec[rbi] = cls | (sl_ << 8); recg[rbi] = (f32x2){glo, ghi}; }
        }
#pragma unroll
        for (int u = 0; u < 2; ++u) { xa[u] = nxa[u]; xb[u] = nxb[u]; ya[u] = nya[u]; yb[u] = nyb[u]; }
    }
#undef N2_LOAD
    __syncthreads();
    if (F.tid < NCLS) { const int n = lcnt[F.tid]; int base = 0; if (n > 0) base = (int)__hip_atomic_fetch_add((unsigned*)ws + CW_MOE + 32 * layer + F.tid, (unsigned)n, __ATOMIC_RELAXED, __HIP_MEMORY_SCOPE_AGENT); lbase[F.tid] = base; }
    __syncthreads();
    int* listp = (int*)(ws + WS_LIST); f32x2* glistp = (f32x2*)(ws + WS_GLIST); int* tpw = (int*)(ws + WS_TOKPOS); float* slistp = (float*)(ws + WS_SLIST);
    for (int rbi = F.tid; rbi < bend - brow0; rbi += 512) { const int rc = rec[rbi]; const int cls = rc & 0xff; const int slot = lbase[cls] + (rc >> 8);
        listp[(size_t)cls * MT + slot] = brow0 + rbi; glistp[(size_t)cls * MT + slot] = recg[rbi]; slistp[(size_t)cls * MT + slot] = rsa[rbi]; tpw[brow0 + rbi] = cls | (slot << 8); }
    __syncthreads();
}

DI void attn_phase(Frame& F, int j, unsigned long long& pacc) {
    unsigned char* const ws = KWS; const bf16_t* P = (const bf16_t*)(ws + WS_R2); unsigned char* O = ws + WS_R3; const float* sinks = KIN(I_SINKS);
    const int lane = F.lane, wave = F.wave, tid = F.tid, r32 = lane & 31, hi = lane >> 5;
    const int g = wave & 3, qh = wave >> 2;
    LAS unsigned char* KB = F.lds; LAS unsigned char* VB = F.lds + 2 * 18432;
    const int i16 = lane & 15, tq = i16 >> 2, tp = i16 & 3, blk = (lane >> 4) & 1;
    const int nunits = 2048 + 256;
#if PROBE_ATT
    unsigned long long atp_ = __builtin_amdgcn_s_memrealtime();
#define ATTT(k) do { const unsigned long long tn_ = __builtin_amdgcn_s_memrealtime(); if (PROBE_ATT == (k)) pacc += tn_ - atp_; atp_ = tn_; } while (0)
#else
#define ATTT(k) do { } while (0)
#endif
    struct AU { int b, kvh, s, qrow0, klo, nwin; };
#define ATT_DECODE(U, u_) do { const int uu_ = (u_); if (uu_ < 2048) { U.b = uu_ >> 6; U.kvh = (uu_ >> 4) & 3; U.s = (uu_ & 15) * 128; U.qrow0 = U.b * SEQ + U.s; U.klo = U.s - 128 < 0 ? 0 : U.s - 128; \
            const int khi_ = U.s + 256 > SEQ ? SEQ : U.s + 256; U.nwin = (khi_ - U.klo) >> 7; } \
        else { const int v_ = uu_ - 2048; U.b = v_ >> 3; U.kvh = (v_ >> 1) & 3; U.s = (v_ & 1) * 128; U.qrow0 = NL + U.b * CTX + U.s; U.klo = 0; U.nwin = 0; } } while (0)
#define ATT_CHROW(U, ch) ((ch) < U.nwin ? (U.b * SEQ + U.klo + 128 * (ch)) : (NL + U.b * CTX + 128 * ((ch) - U.nwin)))
#define ATT_LOAD(U, ch) do { const int cr_ = ATT_CHROW(U, ch); _Pragma("unroll") for (int i_ = 0; i_ < 2; ++i_) { const int p_ = tid + 512 * i_; const bf16_t* src_ = P + (size_t)(cr_ + (p_ >> 3)) * NQKV + 1024 + U.kvh * 64 + (p_ & 7) * 8; \
            kst[i_] = *(const u32x4*)src_; vst[i_] = *(const u32x4*)(src_ + 256); } } while (0)
#define ATT_STORE(bufi) do { _Pragma("unroll") for (int i_ = 0; i_ < 2; ++i_) { const int p_ = tid + 512 * i_; const int off_ = (bufi) * 18432 + (p_ >> 3) * 144 + (p_ & 7) * 16; \
            *(LAS u32x4*)(KB + off_) = kst[i_]; *(LAS u32x4*)(VB + off_) = vst[i_]; } } while (0)
#define ATT_LOADQ(U) do { _Pragma("unroll") for (int gr = 0; gr < 2; ++gr) { const bf16_t* qp = P + (size_t)(U.qrow0 + 64 * gr + 32 * qh + r32) * NQKV + (U.kvh * 4 + g) * 64 + 8 * hi; \
            _Pragma("unroll") for (int ks = 0; ks < 4; ++ks) qf[gr][ks] = *(const bf16x8*)(qp + 16 * ks); } } while (0)
    float sk4[4];
#pragma unroll
    for (int kk = 0; kk < 4; ++kk) sk4[kk] = sinks[j * 16 + kk * 4 + g] * LOG2E;
    u32x4 kst[2], vst[2]; bf16x8 qf[2][4];
    AU UC, UN;
    if ((int)blockIdx.x < nunits) { ATT_DECODE(UC, (int)blockIdx.x); ATT_LOAD(UC, 0); ATT_LOADQ(UC); }
    for (int u = blockIdx.x; u < nunits; u += F.G) {
        const bool has_next = u + F.G < nunits;
        if (has_next) ATT_DECODE(UN, u + F.G); else UN = UC;
        const int s = UC.s, qrow0 = UC.qrow0, klo = UC.klo, nwin = UC.nwin, nch = UC.nwin + 2, hq = UC.kvh * 4 + g;
        const float sink2 = UC.kvh == 0 ? sk4[0] : (UC.kvh == 1 ? sk4[1] : (UC.kvh == 2 ? sk4[2] : sk4[3]));
        float mrun[2], lrun[2]; f32x16 o[2][2];
#pragma unroll
        for (int gr = 0; gr < 2; ++gr) { mrun[gr] = sink2; lrun[gr] = hi == 0 ? 1.0f : 0.0f;
#pragma unroll
            for (int d0 = 0; d0 < 2; ++d0)
#pragma unroll
                for (int i = 0; i < 16; ++i) o[gr][d0][i] = 0.f; }
        __syncthreads();
        ATT_STORE(0);
        __syncthreads();
        ATTT(3);
        for (int ch = 0; ch < nch; ++ch) {
            const int buf = ch & 1;
            if (ch + 1 < nch) ATT_LOAD(UC, ch + 1); else if (has_next) ATT_LOAD(UN, 0);
            ATTT(2);
            const bool masked = ch < nwin; const int kpos0 = klo + 128 * ch;
            const LAS unsigned char* kb = KB + buf * 18432; const LAS unsigned char* vb = VB + buf * 18432;
#pragma unroll 1
            for (int kt = 0; kt < 4; ++kt) {
                int tmode[2] = {0, 0};
                if (masked) {
#pragma unroll
                    for (int gr = 0; gr < 2; ++gr) { const int q0 = s + 64 * gr + 32 * qh; const int dmin = q0 - (kpos0 + 32 * kt + 31), dmax = (q0 + 31) - (kpos0 + 32 * kt);
                        tmode[gr] = (dmax < -128 || dmin > 128) ? 2 : ((dmin >= -128 && dmax <= 128) ? 0 : 1); } }
                if (tmode[0] == 2 && tmode[1] == 2) continue;
                bf16x8 kf[4];
#pragma unroll
                for (int ks = 0; ks < 4; ++ks) kf[ks] = *(const LAS bf16x8*)(kb + (32 * kt + r32) * 144 + (16 * ks + 8 * hi) * 2);
                bf16x8 vf[2][2];
#pragma unroll
                for (int d0 = 0; d0 < 2; ++d0)
#pragma unroll
                    for (int s2 = 0; s2 < 2; ++s2) { const LAS unsigned char* vp = vb + (32 * kt + 16 * s2 + 4 * hi + tq) * 144 + (32 * d0 + 16 * blk + 4 * tp) * 2;
                        vf[d0][s2] = cat4(tr_read(vp), tr_read(vp + 8 * 144)); }
#pragma unroll
                for (int gr = 0; gr < 2; ++gr) { if (tmode[gr] == 2) continue;
                    const float nm = -mrun[gr]; const f32x2 nm2 = (f32x2){nm, nm};
                    f32x16 st = __builtin_shufflevector(nm2, nm2, 0, 1, 0, 1, 0, 1, 0, 1, 0, 1, 0, 1, 0, 1, 0, 1);
#pragma unroll
                    for (int ks = 0; ks < 4; ++ks) st = MFMA32(kf[ks], qf[gr][ks], st);
                    if (tmode[gr] == 1) { const int qpos = s + 64 * gr + 32 * qh + r32; const int kb0 = kpos0 + 32 * kt + 4 * hi;
#pragma unroll
                        for (int i = 0; i < 16; ++i) { const int dlt = qpos - (kb0 + (i & 3) + 8 * (i >> 2)); if (dlt > 128 || dlt < -128) st[i] = -1e30f; } }
                    float tmax = fmaxf(st[0], st[1]);
#pragma unroll
                    for (int i = 2; i < 16; i += 2) tmax = fmaxf(fmaxf(tmax, st[i]), st[i + 1]);
                    { auto rr = __builtin_amdgcn_permlane32_swap(__float_as_uint(tmax), __float_as_uint(tmax), false, false); tmax = fmaxf(__uint_as_float(rr[0]), __uint_as_float(rr[1])); }
                    if (__any(tmax > 8.0f)) { const float dl = fmaxf(tmax, 0.f); mrun[gr] += dl; const float alpha = __builtin_amdgcn_exp2f(-dl); lrun[gr] *= alpha;
#pragma unroll
                        for (int i = 0; i < 16; ++i) st[i] -= dl;
#pragma unroll
                        for (int d0 = 0; d0 < 2; ++d0)
#pragma unroll
                            for (int i = 0; i < 16; ++i) o[gr][d0][i] *= alpha; }
#pragma unroll
                    for (int i = 0; i < 16; ++i) st[i] = __builtin_amdgcn_exp2f(st[i]);
                    f32x2 ps2 = (f32x2){st[0], st[1]};
#pragma unroll
                    for (int i = 2; i < 16; i += 2) ps2 += (f32x2){st[i], st[i + 1]};
                    lrun[gr] += ps2.x + ps2.y;
                    const bf16x8 p0 = pack8(st, 0), p1 = pack8(st, 1);
#pragma unroll
                    for (int d0 = 0; d0 < 2; ++d0) { o[gr][d0] = MFMA32(vf[d0][0], p0, o[gr][d0]); o[gr][d0] = MFMA32(vf[d0][1], p1, o[gr][d0]); }
                }
            }
            ATTT(1);
            if (ch + 1 < nch) ATT_STORE(buf ^ 1);
            __syncthreads();
            ATTT(2);
        }
        if (has_next) ATT_LOADQ(UN);
        { LAS unsigned char* OW = F.lds + wave * 9216;
#pragma unroll
        for (int gr = 0; gr < 2; ++gr) { float lt; { auto rr = __builtin_amdgcn_permlane32_swap(__float_as_uint(lrun[gr]), __float_as_uint(lrun[gr]), false, false); lt = __uint_as_float(rr[0]) + __uint_as_float(rr[1]); } const float inv = ATT_O_SCALE / lt;
#pragma unroll
            for (int d0 = 0; d0 < 2; ++d0)
#pragma unroll
                for (int i4 = 0; i4 < 4; ++i4) { int w = 0; w = __builtin_amdgcn_cvt_pk_fp8_f32(__builtin_amdgcn_fmed3f(o[gr][d0][4 * i4] * inv, -448.f, 448.f), __builtin_amdgcn_fmed3f(o[gr][d0][4 * i4 + 1] * inv, -448.f, 448.f), w, false);
                    w = __builtin_amdgcn_cvt_pk_fp8_f32(__builtin_amdgcn_fmed3f(o[gr][d0][4 * i4 + 2] * inv, -448.f, 448.f), __builtin_amdgcn_fmed3f(o[gr][d0][4 * i4 + 3] * inv, -448.f, 448.f), w, true);
                    *(LAS int*)(OW + (32 * gr + r32) * 80 + (32 * d0 + 8 * i4 + 4 * hi)) = w; } }
        asm volatile("s_waitcnt lgkmcnt(0)" ::: "memory");
#pragma unroll
        for (int it = 0; it < 4; ++it) { const int idx = lane + 64 * it; const int qr = idx >> 2, pc = idx & 3; const u32x4 w = *(const LAS u32x4*)(OW + qr * 80 + pc * 16);
            *(u32x4*)(O + (size_t)(qrow0 + 64 * (qr >> 5) + 32 * qh + (qr & 31)) * 1024 + hq * 64 + pc * 16) = w; } }
        UC = UN;
    }
    ATTT(3);
#undef ATTT
#undef ATT_DECODE
#undef ATT_LOADQ
#undef ATT_CHROW
#undef ATT_LOAD
#undef ATT_STORE
}

DI void gla_phase(Frame& F, int j, unsigned long long& pacc) {
    unsigned char* const ws = KWS; const bf16_t* QK = (const bf16_t*)(ws + WS_R2); const bf16_t* GV = (const bf16_t*)(ws + WS_R3); bf16_t* const OBp = (bf16_t*)KOUT;
    const float* wa2g = KIN(I_GWA2); const float* bag = KIN(I_GBA); const float* rbuf = (const float*)(ws + WS_R);
    const int lane = F.lane, wave = F.wave, tid = F.tid, r32 = lane & 31, hi = lane >> 5;
    const int i16 = lane & 15, tq = i16 >> 2, tp = i16 & 3, blk = (lane >> 4) & 1;
    LAS unsigned char* QD = F.lds; LAS unsigned char* KD = F.lds + 17408; LAS unsigned char* KZ = F.lds + 34816; LAS unsigned char* VT = F.lds + 52224; LAS unsigned char* PT = F.lds + 86016;
    LAS float* RR = (LAS float*)(F.lds + 95232); LAS float* SEG = (LAS float*)(F.lds + 99328); LAS float* DEC = (LAS float*)(F.lds + 103424);
    LAS float* WA2 = (LAS float*)(F.lds + 103936); LAS float* BA = (LAS float*)(F.lds + 112128);
    LAS unsigned char* OTW = F.lds + 114688 + wave * 4096;
    LAS float* XT = (LAS float*)(F.lds + 114688);
    static_assert(114688 + 8 * 4096 <= PHASE_LDS, "scan LDS map");
    const int kp = tid & 63, seg = tid >> 6;
    for (int u = blockIdx.x; u < 256; u += F.G) {
        const int b = u >> 3, hd = (u >> 1) & 3, dir = u & 1;
        bf16_t* OUT = dir ? OBp : (bf16_t*)(ws + WS_H);
        __syncthreads();
        { int t2 = tid; asm volatile("" : "+v"(t2));
          for (int idx = t2; idx < 16 * 128; idx += 512) WA2[idx] = wa2g[(((size_t)j * 2 + dir) * 16 + (idx >> 7)) * 512 + hd * 128 + (idx & 127)];
          if (t2 < 128) BA[t2] = bag[((size_t)j * 2 + dir) * 512 + hd * 128 + t2] * (-LOG2E); }
        f32x16 S[4];
#pragma unroll
        for (int kb = 0; kb < 4; ++kb)
#pragma unroll
            for (int i = 0; i < 16; ++i) S[kb][i] = 0.f;
        __syncthreads();
        bf16x8 wfh;
        { u32x4 bh;
#pragma unroll
          for (int q = 0; q < 4; ++q) bh[q] = cvt_pk_bf16(WA2[(8 * hi + 2 * q) * 128 + 32 * (wave & 3) + r32] * (-LOG2E), WA2[(8 * hi + 2 * q + 1) * 128 + 32 * (wave & 3) + r32] * (-LOG2E));
          wfh = __builtin_bit_cast(bf16x8, bh); }
        u32x4 vreg[4]; f32x4 rreg = (f32x4){0.f, 0.f, 0.f, 0.f}; unsigned q2[8], k2[8];
        const int sgn = dir ? -1 : 1;
        const unsigned vlo = (unsigned)((dir ? 63 - (tid >> 5) : (tid >> 5)) * 2048 + (tid & 31) * 16);
        const unsigned rlo = (unsigned)((dir ? 63 - (tid >> 2) : (tid >> 2)) * 128 + (tid & 3) * 16);
        const unsigned qlo = (unsigned)(4 * kp);
        const unsigned olo = (unsigned)((dir ? 63 - (lane >> 2) : (lane >> 2)) * 2048 + (lane & 3) * 16);
#define GLA_TLOW(cj_) ((cj_) < 4 ? (NL + b * CTX + (dir ? 192 - 64 * (cj_) : 64 * (cj_))) : (b * SEQ + (dir ? 1984 - 64 * ((cj_) - 4) : 64 * ((cj_) - 4))))
#define GLA_FETCH_V(cj_) do { const int tl_ = GLA_TLOW(cj_); \
            _Pragma("unroll") for (int i_ = 0; i_ < 4; ++i_) { const char* ub_ = (const char*)GV + ((size_t)(tl_ + sgn * 16 * i_)) * 2048 + hd * 512; vreg[i_] = *(const u32x4*)(ub_ + vlo); } \
            if (tid < 256) { const char* ub_ = (const char*)rbuf + (size_t)tl_ * 128 + dir * 64; rreg = *(const f32x4*)(ub_ + rlo); } } while (0)
#define GLA_FETCH_QK(cj_) do { const int tl_ = GLA_TLOW(cj_); \
            _Pragma("unroll") for (int e_ = 0; e_ < 8; ++e_) { const int ro_ = dir ? 63 - (8 * seg + e_) : 8 * seg + e_; const char* ub_ = (const char*)QK + ((size_t)(tl_ + ro_)) * 2048 + hd * 256; \
                q2[e_] = *(const unsigned*)(ub_ + qlo); k2[e_] = *(const unsigned*)(ub_ + 1024 + qlo); } } while (0)
        GLA_FETCH_V(0); GLA_FETCH_QK(0);
#if PROBE_SCAN
        unsigned long long tprev_ = __builtin_amdgcn_s_memrealtime();
#define SCANT(k) do { const unsigned long long tn_ = __builtin_amdgcn_s_memrealtime(); if (PROBE_SCAN == (k)) pacc += tn_ - tprev_; tprev_ = tn_; } while (0)
#else
#define SCANT(k) do { } while (0)
#endif
        for (int cj = 0; cj < 36; ++cj) {
            const int tlow = GLA_TLOW(cj);
            LDS_BAR();
#pragma unroll
            for (int i = 0; i < 4; ++i) { const int p = tid + 512 * i; *(LAS u32x4*)(VT + (p >> 5) * 528 + (p & 31) * 16) = vreg[i]; }
            if (tid < 256) *(LAS f32x4*)(RR + (tid >> 2) * 16 + (tid & 3) * 4) = rreg;
            LDS_BAR();
            SCANT(1);
            { const LAS float* rp = RR + (32 * (wave >> 2) + r32) * 16 + 8 * hi; const f32x4 ra = *(const LAS f32x4*)rp, rb4 = *(const LAS f32x4*)(rp + 4);
              const float rv[8] = {ra[0], ra[1], ra[2], ra[3], rb4[0], rb4[1], rb4[2], rb4[3]};
              u32x4 ah, al;
#pragma unroll
              for (int q = 0; q < 4; ++q) { const unsigned hh2 = cvt_pk_bf16(rv[2 * q], rv[2 * q + 1]); ah[q] = hh2; al[q] = cvt_pk_bf16(rv[2 * q] - bf_lo(hh2), rv[2 * q + 1] - bf_hi(hh2)); }
              f32x16 xt;
#pragma unroll
              for (int i = 0; i < 16; ++i) xt[i] = 0.f;
              xt = MFMA32(__builtin_bit_cast(bf16x8, ah), wfh, xt); xt = MFMA32(__builtin_bit_cast(bf16x8, al), wfh, xt);
              LAS float* xo = XT + (32 * (wave >> 2) + 4 * hi) * 128 + 32 * (wave & 3) + r32;
#pragma unroll
              for (int i = 0; i < 16; ++i) xo[((i & 3) + 8 * (i >> 2)) * 128] = xt[i]; }
            LDS_BAR();
            float bl[8][2];
            { const f32x2 ba2 = *(const LAS f32x2*)(BA + 2 * kp);
              float run0 = 0.f, run1 = 0.f;
#pragma unroll
              for (int e = 0; e < 8; ++e) { const f32x2 x2 = *(const LAS f32x2*)(XT + (8 * seg + e) * 128 + 2 * kp); const float t0 = fminf(x2[0] + ba2[0], 100.f), t1 = fminf(x2[1] + ba2[1], 100.f);
                  run0 = __builtin_fmaf(__builtin_amdgcn_logf(1.0f + __builtin_amdgcn_exp2f(t0)), -0.0625f, run0); run1 = __builtin_fmaf(__builtin_amdgcn_logf(1.0f + __builtin_amdgcn_exp2f(t1)), -0.0625f, run1); bl[e][0] = run0; bl[e][1] = run1; }
              *(LAS f32x2*)(SEG + seg * 128 + 2 * kp) = (f32x2){run0, run1}; }
            LDS_BAR();
            SCANT(2);
            { float off0 = 0.f, off1 = 0.f, tot0 = 0.f, tot1 = 0.f;
#pragma unroll
              for (int s2 = 0; s2 < 8; ++s2) { const f32x2 t2 = *(const LAS f32x2*)(SEG + s2 * 128 + 2 * kp); tot0 += t2[0]; tot1 += t2[1]; }
#pragma unroll 1
              for (int s2 = 0; s2 < seg; ++s2) { const f32x2 t2 = *(const LAS f32x2*)(SEG + s2 * 128 + 2 * kp); off0 += t2[0]; off1 += t2[1]; }
              const float et0 = __builtin_amdgcn_exp2f(tot0), et1 = __builtin_amdgcn_exp2f(tot1);
              if (seg == 0) *(LAS f32x2*)(DEC + 2 * kp) = (f32x2){et0, et1};
#pragma unroll
              for (int e = 0; e < 8; ++e) { const float b0 = bl[e][0] + off0, b1 = bl[e][1] + off1; const float q0 = bf_lo(q2[e]), q1 = bf_hi(q2[e]), k0 = bf_lo(k2[e]), k1 = bf_hi(k2[e]);
                  const float e0 = __builtin_amdgcn_exp2f(b0), e1 = __builtin_amdgcn_exp2f(b1), n0 = __builtin_amdgcn_exp2f(fminf(-b0, 86.f)), n1 = __builtin_amdgcn_exp2f(fminf(-b1, 86.f));
                  const int ro = (8 * seg + e) * 272 + 4 * kp;
                  *(LAS unsigned*)(QD + ro) = cvt_pk_bf16(q0 * e0, q1 * e1); *(LAS unsigned*)(KD + ro) = cvt_pk_bf16(k0 * n0, k1 * n1); } }
            LDS_BAR();
            SCANT(3);
            if (cj + 1 < 36) GLA_FETCH_V(cj + 1);
            { const int ti = wave >> 1;
#pragma unroll
              for (int uu = 0; uu < 2; ++uu) { const int sj = 2 * (wave & 1) + uu; f32x4 a4 = (f32x4){0.f, 0.f, 0.f, 0.f};
#pragma unroll
                  for (int kk = 0; kk < 4; ++kk) { const bf16x8 af = *(const LAS bf16x8*)(KD + (16 * sj + i16) * 272 + (32 * kk + 8 * (lane >> 4)) * 2), bfr = *(const LAS bf16x8*)(QD + (16 * ti + i16) * 272 + (32 * kk + 8 * (lane >> 4)) * 2);
                      a4 = MFMA16(af, bfr, a4); }
                  const int t = 16 * ti + i16, s0 = 16 * sj + 4 * (lane >> 4);
                  float pv[4];
#pragma unroll
                  for (int i = 0; i < 4; ++i) pv[i] = (s0 + i <= t) ? a4[i] : 0.f;
                  u32x2 w; w.x = cvt_pk_bf16(pv[0], pv[1]); w.y = cvt_pk_bf16(pv[2], pv[3]);
                  *(LAS u32x2*)(PT + t * 144 + s0 * 2) = w; } }
            LDS_BAR();
            SCANT(4);
#define SB_ asm volatile("" ::: "memory")
#define LD_INTER(Fx, kb_, s2_) do { _Pragma("unroll") for (int tb_ = 0; tb_ < 2; ++tb_) { const LAS unsigned char* qp_ = QD + (32 * tb_ + r32) * 272 + (32 * (kb_) + 16 * (s2_) + 4 * hi) * 2; \
                Fx[tb_] = cat4(*(const LAS s16x4*)qp_, *(const LAS s16x4*)(qp_ + 16)); } } while (0)
#define MM_INTER(Fx, kb_, s2_) do { const bf16x8 ap_ = pack8(S[kb_], s2_); oT[0] = MFMA32(ap_, Fx[0], oT[0]); oT[1] = MFMA32(ap_, Fx[1], oT[1]); } while (0)
#define LD_P(Fx, i_, tb_, ss_) Fx[i_] = *(const LAS bf16x8*)(PT + (32 * (tb_) + r32) * 144 + (16 * (ss_) + 8 * hi) * 2)
#define LD_STATE(Fx, kb_) do { _Pragma("unroll") for (int ss_ = 0; ss_ < 4; ++ss_) { const LAS unsigned char* zp_ = KD + (16 * ss_ + 8 * hi + tq) * 272 + (32 * (kb_) + 16 * blk + 4 * tp) * 2; Fx[ss_] = cat4(tr_read(zp_), tr_read(zp_ + 4 * 272)); } } while (0)
#define LD_DEC(kb_) do { } while (0)
#define DECAY(kb_) do { _Pragma("unroll") for (int i4_ = 0; i4_ < 4; ++i4_) { const f32x4 dv_ = *(const LAS f32x4*)(DEC + 32 * (kb_) + 8 * i4_ + 4 * hi); _Pragma("unroll") for (int e_ = 0; e_ < 4; ++e_) S[kb_][4 * i4_ + e_] *= dv_[e_]; } } while (0)
#define MM_STATE(Fx, kb_) do { _Pragma("unroll") for (int ss_ = 0; ss_ < 4; ++ss_) S[kb_] = MFMA32(Fx[ss_], vfr[ss_], S[kb_]); } while (0)
            bf16x8 vfr[4], fa[4], fb[4];
#pragma unroll
            for (int ss = 0; ss < 4; ++ss) { const LAS unsigned char* vp = VT + (16 * ss + 8 * hi + tq) * 528 + (32 * wave + 16 * blk + 4 * tp) * 2; vfr[ss] = cat4(tr_read(vp), tr_read(vp + 4 * 528)); }
            f32x16 oT[2];
#pragma unroll
            for (int tb = 0; tb < 2; ++tb)
#pragma unroll
                for (int i = 0; i < 16; ++i) oT[tb][i] = 0.f;
            LD_INTER(fa, 0, 0); LD_INTER(fb, 0, 1); SB_;
            MM_INTER(fa, 0, 0); LD_INTER(fa, 1, 0); SB_; MM_INTER(fb, 0, 1); LD_INTER(fb, 1, 1); SB_;
            MM_INTER(fa, 1, 0); LD_INTER(fa, 2, 0); SB_; MM_INTER(fb, 1, 1); LD_INTER(fb, 2, 1); SB_;
            MM_INTER(fa, 2, 0); LD_INTER(fa, 3, 0); SB_; MM_INTER(fb, 2, 1); LD_INTER(fb, 3, 1); SB_;
            MM_INTER(fa, 3, 0); SB_;
            LD_P(fa, 0, 0, 0); LD_P(fa, 1, 0, 1); LD_P(fa, 2, 1, 0); LD_P(fa, 3, 1, 1); SB_; MM_INTER(fb, 3, 1); SB_;
            LD_P(fb, 0, 1, 2); LD_P(fb, 1, 1, 3); LD_DEC(0); SB_;
            oT[0] = MFMA32(vfr[0], fa[0], oT[0]); oT[1] = MFMA32(vfr[0], fa[2], oT[1]); oT[0] = MFMA32(vfr[1], fa[1], oT[0]); oT[1] = MFMA32(vfr[1], fa[3], oT[1]); SB_;
            LD_STATE(fa, 0); SB_;
            oT[1] = MFMA32(vfr[2], fb[0], oT[1]); oT[1] = MFMA32(vfr[3], fb[1], oT[1]); SB_;
#pragma unroll
            for (int tb = 0; tb < 2; ++tb)
#pragma unroll
                for (int i4 = 0; i4 < 4; ++i4) { u32x2 w; w.x = cvt_pk_bf16(oT[tb][4 * i4], oT[tb][4 * i4 + 1]); w.y = cvt_pk_bf16(oT[tb][4 * i4 + 2], oT[tb][4 * i4 + 3]);
                    *(LAS u32x2*)(OTW + (32 * tb + r32) * 64 + (8 * i4 + 4 * hi) * 2) = w; }
            SB_;
            if (cj + 1 < 36) GLA_FETCH_QK(cj + 1);
            LD_DEC(1); LD_STATE(fb, 1); SB_; MM_STATE(fa, 0); SB_;
#pragma unroll
            for (int it = 0; it < 4; ++it) { const int idx = lane + 64 * it; const int trow = idx >> 2, pc = idx & 3; const u32x4 w = *(const LAS u32x4*)(OTW + trow * 64 + pc * 16);
                char* ub = (char*)OUT + ((size_t)(tlow + sgn * 16 * it)) * 2048 + hd * 512 + 64 * wave; *(u32x4*)(ub + olo) = w; }
            SB_;
            LD_DEC(2); LD_STATE(fa, 2); SB_; MM_STATE(fb, 1); SB_; DECAY(0);
            LD_DEC(3); LD_STATE(fb, 3); SB_; MM_STATE(fa, 2); SB_; DECAY(1);
            SB_; MM_STATE(fb, 3); DECAY(2); DECAY(3);
#undef SB_
#undef LD_INTER
#undef MM_INTER
#undef LD_P
#undef LD_STATE
#undef LD_DEC
#undef DECAY
#undef MM_STATE
            SCANT(5);
        }
    }
}
#undef SCANT

#undef GLA_TLOW
#undef GLA_FETCH_V
#undef GLA_FETCH_QK
DI void gla_norm_phase(Frame& F, int j, int nrows) {
    unsigned char* const ws = KWS; const bf16_t* OFW = (const bf16_t*)(ws + WS_H); const bf16_t* OBW = (const bf16_t*)KOUT; const bf16_t* GB = (const bf16_t*)(ws + WS_R2) + (size_t)MT * 1024; signed char* A2 = (signed char*)(ws + WS_R2); float* sap = (float*)(ws + WS_SA);
    const int gw = blockIdx.x * NWAVES + F.wave, NGW = F.G * NWAVES;
    const float* ngp = KIN(I_GNORM) + j * 256 + 8 * (F.lane & 31);
    const f32x4 ng0 = *(const f32x4*)ngp, ng1 = *(const f32x4*)(ngp + 4);
    const float ng[8] = {ng0[0], ng0[1], ng0[2], ng0[3], ng1[0], ng1[1], ng1[2], ng1[3]};
    for (int rowb = 2 * gw; rowb < nrows; rowb += 2 * NGW) {
        u32x4 a[2][2], bq[2][2], gg[2][2];
#pragma unroll
        for (int u = 0; u < 2; ++u)
#pragma unroll
            for (int it = 0; it < 2; ++it) { const size_t off = (size_t)(rowb + u) * 1024 + (size_t)(F.lane + 64 * it) * 8; a[u][it] = *(const u32x4*)(OFW + off); bq[u][it] = *(const u32x4*)(OBW + off); gg[u][it] = *(const u32x4*)(GB + off); }
#pragma unroll
        for (int u = 0; u < 2; ++u) { float v16[16];
#pragma unroll
            for (int it = 0; it < 2; ++it) {
                const unsigned aw[4] = {a[u][it].x, a[u][it].y, a[u][it].z, a[u][it].w}, bw[4] = {bq[u][it].x, bq[u][it].y, bq[u][it].z, bq[u][it].w}, gw4[4] = {gg[u][it].x, gg[u][it].y, gg[u][it].z, gg[u][it].w};
                float ov[8], gv[8]; float ss = 0.f;
#pragma unroll
                for (int q = 0; q < 4; ++q) { ov[2 * q] = bf_lo(aw[q]) + bf_lo(bw[q]); ov[2 * q + 1] = bf_hi(aw[q]) + bf_hi(bw[q]); gv[2 * q] = bf_lo(gw4[q]); gv[2 * q + 1] = bf_hi(gw4[q]); }
#pragma unroll
                for (int e = 0; e < 8; ++e) ss += ov[e] * ov[e];
                ss = half_sum32(ss, F.lane);
                const float rstd = 1.0f / sqrtf(ss * (1.0f / 256.0f) + RMS_EPS);
#pragma unroll
                for (int e = 0; e < 8; ++e) v16[8 * it + e] = ov[e] * rstd * ng[e] * silu_fast(gv[e]); }
            const float sc_ = quant_row_i8(v16, A2 + (size_t)(rowb + u) * 1024, 8 * F.lane, F.lane); if (F.lane == 0) sap[rowb + u] = sc_; }
    }
}

DI void final_phase(Frame& F) {
    unsigned char* const ws = KWS; const bf16_t* XRp = (const bf16_t*)(ws + WS_XR); const unsigned char* Yp = ws + WS_R3; float* outp = KOUT; const float* fg = KIN(I_FINALG);
    const float* gatel = (const float*)(ws + WS_MOD) + (size_t)(DEPTH - 1) * 33 * 6144 + 5 * 1024; const int* tokpos = (const int*)(ws + WS_TOKPOS);
    (void)moe_table(F, DEPTH - 1); const LAS int* bs = (const LAS int*)(F.lds + MOE_TAB_OFF);
    const int c0 = 8 * F.lane;
    const int RPB = (NL + F.G - 1) / F.G, RPW = (RPB + 7) / 8;
    const int brow0 = blockIdx.x * RPB; int bend = brow0 + RPB; if (bend > NL) bend = NL;
    const int row0 = brow0 + F.wave * RPW; int rend = row0 + RPW; if (rend > bend) rend = bend;
    float gn[16], gy[16]; int mb = -1;
#pragma unroll
    for (int hh = 0; hh < 2; ++hh)
#pragma unroll
        for (int q = 0; q < 2; ++q) { const f32x4 g4 = *(const f32x4*)(fg + hh * 512 + c0 + 4 * q);
#pragma unroll
            for (int e = 0; e < 4; ++e) gn[hh * 8 + q * 4 + e] = g4[e]; }
    for (int rowb = row0; rowb < rend; rowb += 4) {
        u32x4 xa[4], xb[4], ya[4], yb[4];
#pragma unroll
        for (int u = 0; u < 4; ++u) { const int rr = rowb + u < rend ? rowb + u : rend - 1; const bf16_t* xr = XRp + (size_t)rr * 1024; xa[u] = *(const u32x4*)(xr + c0); xb[u] = *(const u32x4*)(xr + 512 + c0);
            const int tp = tokpos[rr]; const unsigned char* yr = Yp + ((size_t)bs[tp & 0xff] * 256 + (size_t)(tp >> 8)) * 1024; const u32x2 ta_ = *(const u32x2*)(yr + c0), tb_ = *(const u32x2*)(yr + 512 + c0); ya[u].x = ta_.x; ya[u].y = ta_.y; yb[u].x = tb_.x; yb[u].y = tb_.y; }
#pragma unroll
        for (int u = 0; u < 4; ++u) { const int row = rowb + u; if (row < rend) {
            const int mbn = row >> 11;
            if (mbn != mb) { mb = mbn; const float* gp = gatel + (size_t)mb * 6144;
#pragma unroll
                for (int hh = 0; hh < 2; ++hh)
#pragma unroll
                    for (int q = 0; q < 2; ++q) { const f32x4 y4 = *(const f32x4*)(gp + hh * 512 + c0 + 4 * q);
#pragma unroll
                        for (int e = 0; e < 4; ++e) gy[hh * 8 + q * 4 + e] = y4[e] * (1.0f / Y_SCALE); } }
            float v[16], yv[16]; unpack16(xa[u], xb[u], v); unpack16_f8(ya[u].x, ya[u].y, yb[u].x, yb[u].y, yv);
            float ss = 0.f;
#pragma unroll
            for (int e = 0; e < 16; ++e) { v[e] += gy[e] * yv[e]; ss += v[e] * v[e]; }
            ss = wave_sum(ss, F.lane);
            const float rstd = 1.0f / sqrtf(ss * (1.0f / 1024.0f) + RMS_EPS);
            float* op = outp + (size_t)row * 1024;
#pragma unroll
            for (int hh = 0; hh < 2; ++hh)
#pragma unroll
                for (int q = 0; q < 2; ++q) { f32x4 o4;
#pragma unroll
                    for (int e = 0; e < 4; ++e) o4[e] = v[hh * 8 + q * 4 + e] * rstd * gn[hh * 8 + q * 4 + e];
                    *(f32x4*)(op + hh * 512 + c0 + 4 * q) = o4; }
        } }
    }
}

struct Args { const float* in[23]; float* out; unsigned char* ws; int ph_lo, ph_hi; };
constexpr int PH_PER_LAYER = 8, N_PHASES = 1 + DEPTH * PH_PER_LAYER + 1;

__global__ void __launch_bounds__(NWAVES * 64, 2) fwd_kernel(Args args) {
    extern __shared__ __attribute__((aligned(16))) unsigned char lds[];
    LAS unsigned char* const ldsb = (LAS unsigned char*)lds;
    const int wv0 = __builtin_amdgcn_readfirstlane((int)threadIdx.x >> 6);
    for (int u = wv0 * 64 + (int)lane_id_(); u < (LDS_BYTES - MISC_OFF) / 4; u += NWAVES * 64) ((LAS unsigned*)(ldsb + MISC_OFF))[u] = 0u;
    __syncthreads();
    const int lo = args.ph_lo, hi = args.ph_hi;
    XcdBarrier bar; bar.bar = nullptr; bar.x = 0; bar.st = (volatile LAS unsigned*)(ldsb + MISC_OFF) + 8; bar.w = (unsigned)wv0;
    if (hi - lo > 1) bar = xcd_barrier_post((unsigned*)KWS + CW_BAR, (volatile LAS unsigned*)(ldsb + MISC_OFF) + 8, (unsigned)wv0);
#define IN(k) (lo <= (k) && (k) < hi)
#if PROBE_MASK
    unsigned long long pr_prev = __builtin_amdgcn_s_memrealtime(), pr_acc = 0;
#define PSTAMP(slot) do { const unsigned long long tn_ = __builtin_amdgcn_s_memrealtime(); if ((PROBE_MASK >> (slot)) & 1) pr_acc += tn_ - pr_prev; pr_prev = tn_; } while (0)
#else
    unsigned long long pr_acc = 0;
#define PSTAMP(slot) do { } while (0)
#endif
#define SEAM(k, slot) do { if (IN(k) && IN((k) + 1)) { bar.bar = (unsigned*)KWS + CW_BAR; xcd_barrier(bar); } PSTAMP(slot); } while (0)

    if (PHE(0) && IN(0)) { Frame F = mkframe(ldsb, wv0); p0_prologue(F); }
    SEAM(0, 0);
#pragma unroll 1
    for (int layer = 0; layer < DEPTH; ++layer) {
        const int pb = 1 + layer * PH_PER_LAYER; const int j = layer >> 1; const bool gla = layer & 1;
        if (PHE(1) && IN(pb + 0)) { Frame F = mkframe(ldsb, wv0); norm_phase<false>(F, layer); }
        SEAM(pb + 0, 1);
        if (IN(pb + 1)) { Frame F = mkframe(ldsb, wv0);
            if (PHE(2) && !gla) { unsigned char* const ws = KWS;
                LAS float* ropeL = (LAS float*)(F.lds + RING_BYTES);
                { const float* rg = (const float*)(ws + WS_ROPE); for (int idx = F.tid; idx < 64 * 32; idx += 512) ropeL[idx] = rg[idx]; }
                __syncthreads();
                DenseOrder S{MT / 256, NQKV / 256, F.G, (int)blockIdx.x, 1024u, (const char*)(ws + WS_WQKV) + (size_t)j * NQKV * 1024, 1024u, (const float*)(ws + WS_SA), (const float*)(ws + WS_SBQKV) + j * NQKV}; EpiQKV E{(bf16_t*)(ws + WS_R2), ropeL};
                pg8::gemm_phase<EpiQKV, DenseOrder, 1>(F.lds, F.tid, (const char*)(ws + WS_H), 1024, 1024u, S, E, pr_acc); }
            else if (PHE(3) && gla) { unsigned char* const ws = KWS;
                DenseOrder S{MT / 256, NGIN / 256, F.G, (int)blockIdx.x, 1024u, (const char*)(ws + WS_WIN) + (size_t)j * NGIN * 1024, 1024u, (const float*)(ws + WS_SA), (const float*)(ws + WS_SBIN) + j * NGIN};
                EpiGLA E{(bf16_t*)(ws + WS_R2), (float*)(ws + WS_R)};
                pg8::gemm_phase<EpiGLA, DenseOrder, 1>(F.lds, F.tid, (const char*)(ws + WS_H), 1024, 1024u, S, E, pr_acc); }
        }
        SEAM(pb + 1, gla ? 3 : 2);
        if (IN(pb + 2)) { if (PHE(4) && !gla) { Frame F = mkframe(ldsb, wv0); attn_phase(F, j, pr_acc); } else if (PHE(5) && gla) { Frame F = mkframe(ldsb, wv0); gla_phase(F, j, pr_acc); } }
        SEAM(pb + 2, gla ? 5 : 4);
        if (PHE(6) && IN(pb + 3)) { Frame F = mkframe(ldsb, wv0); if (gla) gla_norm_phase(F, j, layer == DEPTH - 1 ? NL : MT); }
        if (gla) SEAM(pb + 3, 6);
        if (PHE(7) && IN(pb + 4)) { Frame F = mkframe(ldsb, wv0); unsigned char* const ws = KWS;
            const int nMp = layer == DEPTH - 1 ? NL / 256 : MT / 256;
            EpiY E{ws + WS_H};
            if (gla) { DenseOrder S{nMp, 4, F.G, (int)blockIdx.x, 1024u, (const char*)(ws + WS_WGO) + (size_t)j * 1024 * 1024, 1024u, (const float*)(ws + WS_SA), (const float*)(ws + WS_SBGO) + j * 1024};
                pg8::gemm_phase<EpiY, DenseOrder, 1>(F.lds, F.tid, (const char*)(ws + WS_R2), 1024, 1024u, S, E, pr_acc); }
            else { DenseOrder S{nMp, 4, F.G, (int)blockIdx.x, 1024u, (const char*)(ws + WS_WO) + (size_t)j * 1024 * 1024, 1024u, nullptr, (const float*)(ws + WS_SBO) + j * 1024, 1.0f / ATT_O_SCALE};
                pg8::gemm_phase<EpiY, DenseOrder, 2>(F.lds, F.tid, (const char*)(ws + WS_R3), 1024, 1024u, S, E, pr_acc); }
        }
        SEAM(pb + 4, 7);
        if (PHE(8) && IN(pb + 5)) { Frame F = mkframe(ldsb, wv0); n2_phase(F, layer); }
        SEAM(pb + 5, 8);
        if (PHE(9) && IN(pb + 6)) { Frame F = mkframe(ldsb, wv0);
            const int nblk = moe_table(F, layer); const LAS int* bs = (const LAS int*)(F.lds + MOE_TAB_OFF); unsigned char* const ws = KWS;
            MoeUpOrder S{nblk, F.G, (int)blockIdx.x, bs, bs + 32, (const int*)(ws + WS_LIST), (const char*)(ws + WS_WGU) + (size_t)layer * 16 * 1024 * 1024, (const float*)(ws + WS_SLIST), (const float*)(ws + WS_SBGU) + layer * 16 * 1024};
            EpiSwiGLU E{(unsigned char*)(ws + WS_R2), (const f32x2*)(ws + WS_GLIST)};
            pg8::gemm_phase<EpiSwiGLU, MoeUpOrder, 1>(F.lds, F.tid, (const char*)(ws + WS_R3), 1024, 1024u, S, E, pr_acc);
        }
        SEAM(pb + 6, 9);
        if (PHE(10) && IN(pb + 7)) { Frame F = mkframe(ldsb, wv0);
            const int nblk = moe_table(F, layer); const LAS int* bs = (const LAS int*)(F.lds + MOE_TAB_OFF); unsigned char* const ws = KWS;
            MoeDownOrder S{nblk, F.G, (int)blockIdx.x, bs, (const char*)(ws + WS_WD) + (size_t)layer * 16 * 1024 * 512, (const float*)(ws + WS_SBD) + layer * 4 * 1024}; EpiY E{ws + WS_R3};
            pg8::gemm_phase<EpiY, MoeDownOrder, 2>(F.lds, F.tid, (const char*)(ws + WS_R2), 1024, 512u, S, E, pr_acc);
        }
        SEAM(pb + 7, 10);
    }
    if (PHE(11) && IN(N_PHASES - 1)) { Frame F = mkframe(ldsb, wv0); final_phase(F); }
#if PROBE_MASK
    PSTAMP(11);
    if (blockIdx.x == 0 && wv0 == 0 && lane_id_() == 0u) { const unsigned long long t0_ = __builtin_amdgcn_s_memrealtime(); while (__builtin_amdgcn_s_memrealtime() - t0_ < (unsigned long long)PROBE_AMP * pr_acc) __builtin_amdgcn_s_sleep(8); }
#endif
#undef IN
#undef SEAM
}

extern "C" void kernel_launch(void* const* d_in, const int* in_sizes, int n_in, void* d_out, int out_size, void* d_ws, size_t ws_size, hipStream_t stream) {
    static int grid = 0;
    if (grid == 0) {
        if (n_in != 23 || out_size != NL * D || ws_size < WS_END) { fprintf(stderr, "kernel_launch: unexpected shapes (n_in %d, out %d, ws %zu; need ws >= %zu)\n", n_in, out_size, ws_size, (size_t)WS_END); grid = -1; return; }
        int dev = 0, cus = 0, per_cu = 0;
        if (hipGetDevice(&dev) != hipSuccess || hipDeviceGetAttribute(&cus, hipDeviceAttributeMultiprocessorCount, dev) != hipSuccess) { grid = -1; return; }
        if (hipFuncSetAttribute((const void*)fwd_kernel, hipFuncAttributeMaxDynamicSharedMemorySize, LDS_BYTES) != hipSuccess) { fprintf(stderr, "kernel_launch: hipFuncSetAttribute failed\n"); grid = -1; return; }
        if (hipOccupancyMaxActiveBlocksPerMultiprocessor(&per_cu, (const void*)fwd_kernel, NWAVES * 64, LDS_BYTES) != hipSuccess || per_cu < 1) { fprintf(stderr, "kernel_launch: occupancy query reports %d blocks per CU\n", per_cu); }
        (void)hipGetLastError();
        grid = cus;
        if (grid < 128) { fprintf(stderr, "kernel_launch: too few CUs (%d)\n", grid); grid = -1; return; }
    }
    if (grid < 0) return;
    (void)in_sizes;
    if (hipMemsetAsync((char*)d_ws + WS_CTL, 0, CTL_ZERO_BYTES, stream) != hipSuccess) return;
    Args a{};
    for (int i = 0; i < 23; ++i) a.in[i] = (const float*)d_in[i];
    a.out = (float*)d_out; a.ws = (unsigned char*)d_ws;
#if MK_N_LAUNCHES == 1
    a.ph_lo = 0; a.ph_hi = N_PHASES;
    hipLaunchKernelGGL(fwd_kernel, dim3(grid), dim3(NWAVES * 64), LDS_BYTES, stream, a);
#else
    for (int p = 0; p < N_PHASES; ++p) {
        if (p >= 1 && p < N_PHASES - 1) { const int s = (p - 1) % PH_PER_LAYER, layer = (p - 1) / PH_PER_LAYER; if (s == 3 && !(layer & 1)) continue; }
        a.ph_lo = p; a.ph_hi = p + 1;
        hipLaunchKernelGGL(fwd_kernel, dim3(grid), dim3(NWAVES * 64), LDS_BYTES, stream, a);
    }
#endif
}
```

```cpp
#include <hip/hip_runtime.h>
#include <cstdio>
#include <cstdint>

#ifndef PROBE_MASK
#define PROBE_MASK 0
#endif
#define PROBE_AMP 4
#ifndef PROBE_GEMM
#define PROBE_GEMM 0
#endif
#ifndef PROBE_ATT
#define PROBE_ATT 0
#endif
#ifndef PROBE_SCAN
#define PROBE_SCAN 0
#endif
#ifndef GEMM_STAGGER_TICKS
#define GEMM_STAGGER_TICKS 0
#endif
#ifndef MK_N_LAUNCHES
#define MK_N_LAUNCHES 1
#endif

#ifndef PH_SEL
#define PH_SEL -1
#endif
#define PHE(k) (PH_SEL < 0 || PH_SEL == (k))
#define LAS __attribute__((address_space(3)))
#define GAS __attribute__((address_space(1)))
#define LDS_BAR() asm volatile("s_waitcnt lgkmcnt(0)\n\ts_barrier" ::: "memory")
typedef unsigned short bf16_t;
typedef short bf16x8 __attribute__((ext_vector_type(8)));
typedef short s16x4 __attribute__((ext_vector_type(4)));
typedef float f32x4 __attribute__((ext_vector_type(4)));
typedef float f32x2 __attribute__((ext_vector_type(2)));
typedef float f32x16 __attribute__((ext_vector_type(16)));
typedef unsigned u32x4 __attribute__((ext_vector_type(4)));
typedef unsigned u32x2 __attribute__((ext_vector_type(2)));
typedef int i32x4 __attribute__((ext_vector_type(4)));
typedef int i32x8 __attribute__((ext_vector_type(8)));
#define DI __device__ __forceinline__

constexpr int D = 1024, NB = 32, SEQ = 2048, CTX = 256, DEPTH = 4;
constexpr int NL = NB * SEQ, NC = NB * CTX, MT = NL + NC;
constexpr int NQKV = 1536, NGIN = 3328;
constexpr int NCLS = 24;
constexpr float RMS_EPS = 1e-6f;
constexpr float QSCALE = 0.125f * 1.4426950408889634f;
constexpr float LOG2E = 1.4426950408889634f;

constexpr size_t MiB = (size_t)1 << 20;
constexpr size_t WS_CTL = 0, CTL_ZERO_BYTES = 1 * MiB;
constexpr size_t WS_MOD = 1 * MiB;
constexpr size_t WS_ROPE = 5 * MiB;
constexpr size_t WS_TOKPOS = 5 * MiB + 256 * 1024;
constexpr size_t WS_LIST = 6 * MiB;
constexpr size_t WS_GLIST = 13 * MiB;
constexpr size_t WS_R = 27 * MiB;
constexpr size_t WS_WQKV = 36 * MiB, WS_WO = 42 * MiB, WS_WIN = 46 * MiB, WS_WGO = 59 * MiB, WS_WGU = 63 * MiB, WS_WD = 191 * MiB;
constexpr size_t WS_XR = 256 * MiB;
constexpr size_t WS_H = 400 * MiB;
constexpr size_t WS_R2 = 544 * MiB;
static_assert(544 * MiB + 2 * ((size_t)73728 * 1024 * 2) == 832 * MiB, "R3 = R2 + 2 activations");
constexpr size_t WS_R3 = 832 * MiB;
constexpr size_t WS_SA = 992 * MiB;
constexpr size_t WS_SLIST = 993 * MiB;
constexpr size_t WS_SBQKV = 1000 * MiB, WS_SBIN = 1000 * MiB + 65536, WS_SBGU = 1000 * MiB + 131072;
constexpr size_t WS_SBGO = 1000 * MiB + 131072 + 262144;
constexpr size_t WS_SBD = 1000 * MiB + 131072 + 262144 + 65536;
constexpr size_t WS_SBO = 1000 * MiB + 524288;
constexpr float ATT_O_SCALE = 32.0f;
constexpr float Y_SCALE = 16.0f;
constexpr float HID_SCALE = 16.0f;
constexpr size_t WS_END = 1001 * MiB;
constexpr size_t ACT_BYTES = (size_t)MT * 1024 * 2;
constexpr int CW_BAR = 4096;
constexpr int CW_MOE = 16384;

constexpr int RING_BYTES = 131072;
constexpr int LDS_BYTES = 163840;
constexpr int MISC_OFF = LDS_BYTES - 2048;
constexpr int MOE_TAB_OFF = MISC_OFF + 256;
constexpr int PHASE_LDS = MISC_OFF;
static_assert(RING_BYTES + 8192 <= MISC_OFF, "rope table above the ring");
constexpr int TAB_OFF = RING_BYTES + 8192, TAB_STRIDE = 5120;
static_assert(TAB_OFF + 2 * TAB_STRIDE <= MISC_OFF, "unit tables above the rope table");
constexpr int NWAVES = 8;

typedef __bf16 bf16x2_t __attribute__((ext_vector_type(2)));
DI unsigned cvt_pk_bf16(float lo, float hi) { f32x2 v = {lo, hi}; bf16x2_t b = __builtin_convertvector(v, bf16x2_t); return __builtin_bit_cast(unsigned, b); }
DI float bf_lo(unsigned w) { return __uint_as_float(w << 16); }
DI float bf_hi(unsigned w) { return __uint_as_float(w & 0xffff0000u); }
DI float shx(float v, int o, int lane) { return __int_as_float(__builtin_amdgcn_ds_bpermute((lane ^ o) << 2, __float_as_int(v))); }
#define DPPF(v, ctrl) __int_as_float(__builtin_amdgcn_update_dpp(0, __float_as_int(v), (ctrl), 0xF, 0xF, false))
DI float wave_sum(float v, int lane) {
    v += DPPF(v, 0xB1); v += DPPF(v, 0x4E); v += DPPF(v, 0x141); v += DPPF(v, 0x140);
    v += shx(v, 16, lane); v += shx(v, 32, lane);
    return v;
}
DI float wave_max(float v, int lane) {
    v = fmaxf(v, DPPF(v, 0xB1)); v = fmaxf(v, DPPF(v, 0x4E)); v = fmaxf(v, DPPF(v, 0x141)); v = fmaxf(v, DPPF(v, 0x140));
    v = fmaxf(v, shx(v, 16, lane)); v = fmaxf(v, shx(v, 32, lane));
    return v;
}
DI float half_sum32(float v, int lane) {
    v += DPPF(v, 0xB1); v += DPPF(v, 0x4E); v += DPPF(v, 0x141); v += DPPF(v, 0x140);
    v += shx(v, 16, lane);
    return v;
}
DI float sigmoidf_(float x) { return 1.0f / (1.0f + __expf(-x)); }
DI float siluf_(float x) { return x / (1.0f + __expf(-x)); }
#define MFMA32(a, b, c) __builtin_amdgcn_mfma_f32_32x32x16_bf16((a), (b), (c), 0, 0, 0)
#define MFMA16(a, b, c) __builtin_amdgcn_mfma_f32_16x16x32_bf16((a), (b), (c), 0, 0, 0)
DI int crow(int r, int hi) { return (r & 3) + 8 * (r >> 2) + 4 * hi; }
DI bf16x8 pack8(const f32x16& x, int s) {
    u32x4 p; p[0] = cvt_pk_bf16(x[8 * s + 0], x[8 * s + 1]); p[1] = cvt_pk_bf16(x[8 * s + 2], x[8 * s + 3]); p[2] = cvt_pk_bf16(x[8 * s + 4], x[8 * s + 5]); p[3] = cvt_pk_bf16(x[8 * s + 6], x[8 * s + 7]);
    return __builtin_bit_cast(bf16x8, p);
}
DI s16x4 tr_read(const LAS unsigned char* p) { return __builtin_bit_cast(s16x4, __builtin_amdgcn_ds_read_tr16_b64_v4i16((LAS s16x4*)p)); }
DI bf16x8 cat4(s16x4 lo, s16x4 hi) { return __builtin_shufflevector(lo, hi, 0, 1, 2, 3, 4, 5, 6, 7); }

DI unsigned lane_id_() { unsigned l; asm volatile("v_mbcnt_lo_u32_b32 %0, -1, 0\n\tv_mbcnt_hi_u32_b32 %0, -1, %0" : "=v"(l)); return l; }
#define XB_TMO      128
#define XB_XCNT(j)  (256  + 64 * (j))
#define XB_XSUB(j)  (1280 + 64 * (j))
#define XB_XGEN(j)  (2304 + 64 * (j))
#define XB_TOP      3328
#define XB_TOPGEN   3392
#define XCD_BAR_WORDS 3456
#define XB_SPIN_CAP (1u << 18)
__device__ __forceinline__ unsigned xb_ld(unsigned* p)              { return __hip_atomic_load(p, __ATOMIC_RELAXED, __HIP_MEMORY_SCOPE_AGENT); }
__device__ __forceinline__ unsigned xb_add(unsigned* p, unsigned v) { return __hip_atomic_fetch_add(p, v, __ATOMIC_RELAXED, __HIP_MEMORY_SCOPE_AGENT); }
__device__ __forceinline__ unsigned xb_xcc_id() { return (unsigned)__builtin_amdgcn_s_getreg((3 << 11) | 20) & 0xFu; }
#define XB_SPIN(cond, bar) do { unsigned _sp = 0; while (cond) { __builtin_amdgcn_s_sleep(1); \
    if ((++_sp & 255u) == 0u) { if (xb_ld(&(bar)[XB_TMO])) break; if (_sp > XB_SPIN_CAP) { atomicAdd(&(bar)[XB_TMO], 1u); break; } } } } while (0)
struct XcdBarrier { unsigned* bar; unsigned x; volatile LAS unsigned* st; unsigned w; };
__device__ __forceinline__ XcdBarrier xcd_barrier_post(unsigned* bar, volatile LAS unsigned* st, unsigned w) {
    XcdBarrier b; b.bar = bar; b.x = xb_xcc_id(); b.st = st; b.w = w;
    if (w == 0u && lane_id_() == 0u) (void)xb_add(&bar[XB_XCNT(b.x)], 1u);
    return b;
}
__device__ __forceinline__ void xcd_barrier_complete(unsigned* bar, unsigned x, unsigned& nloc, unsigned& nx) {
    const unsigned G = gridDim.x * gridDim.y * gridDim.z;
    unsigned sum, cnt, mine, sp = 0u;
    for (;;) {
        sum = 0u; cnt = 0u; mine = 0u;
#pragma unroll
        for (unsigned j = 0; j < 16; ++j) { const unsigned c = xb_ld(&bar[XB_XCNT(j)]); sum += c; cnt += (c > 0u) ? 1u : 0u; mine = (j == x) ? c : mine; }
        if (sum == G) break;
        __builtin_amdgcn_s_sleep(1);
        if ((++sp & 255u) == 0u) { if (xb_ld(&bar[XB_TMO])) break; if (sp > XB_SPIN_CAP) { atomicAdd(&bar[XB_TMO], 1u); break; } }
    }
    nloc = mine > 0u ? mine : 1u; nx = cnt > 0u ? cnt : 1u;
}
__device__ __forceinline__ void xcd_barrier(const XcdBarrier& b) {
    asm volatile("s_waitcnt vmcnt(0)" ::: "memory");
    __syncthreads();
    if (b.w == 0u && lane_id_() == 0u) {
        unsigned* bar = b.bar;
        __builtin_amdgcn_s_waitcnt(0);
        unsigned nloc = b.st[0], nx = b.st[1];
        if (nloc == 0u) { xcd_barrier_complete(bar, b.x, nloc, nx); b.st[0] = nloc; b.st[1] = nx; }
        const unsigned old = xb_add(&bar[XB_XSUB(b.x)], 1u);
        const unsigned gen = old / nloc;
        if (old + 1u == (gen + 1u) * nloc) {
            __builtin_amdgcn_fence(__ATOMIC_RELEASE, "agent");
            asm volatile("s_waitcnt vmcnt(0)" ::: "memory");
            const unsigned og = xb_add(&bar[XB_TOP], 1u);
            const unsigned tg = og / nx;
            if (og + 1u == (tg + 1u) * nx) xb_add(&bar[XB_TOPGEN], 1u);
            else XB_SPIN(xb_ld(&bar[XB_TOPGEN]) == tg, bar);
            __builtin_amdgcn_fence(__ATOMIC_ACQUIRE, "agent");
            xb_add(&bar[XB_XGEN(b.x)], 1u);
            asm volatile("s_waitcnt vmcnt(0)" ::: "memory");
        } else {
            XB_SPIN(xb_ld(&bar[XB_XGEN(b.x)]) == gen, bar);
            __builtin_amdgcn_fence(__ATOMIC_ACQUIRE, "agent");
            asm volatile("s_waitcnt vmcnt(0)" ::: "memory");
        }
    }
    __syncthreads();
}

struct Frame {
    LAS unsigned char* lds;
    int tid, lane, wave, G;
};
DI Frame mkframe(LAS unsigned char* lds, int wv) { Frame F; int l = (int)lane_id_(); asm volatile("" : "+v"(l)); F.lane = l; F.wave = wv; F.tid = wv * 64 + l; F.G = gridDim.x; F.lds = lds; return F; }
DI const void* karg(int slot) {
    const volatile __attribute__((address_space(4))) unsigned long long* ka = (const volatile __attribute__((address_space(4))) unsigned long long*)__builtin_amdgcn_kernarg_segment_ptr();
    return (const void*)(const GAS void*)ka[slot];
}
#define KIN(i) ((const float*)karg(i))
#define KOUT ((float*)karg(23))
#define KWS ((unsigned char*)karg(24))
enum { I_X = 0, I_C, I_CTX, I_CCTX, I_ADAW, I_ADAB, I_NMIX, I_NFFN, I_FINALG, I_WQKV, I_WO, I_SINKS, I_GWIN, I_GWA1, I_GWA2, I_GBA, I_GNORM, I_GWO, I_RW, I_RB, I_MG, I_MU, I_MD };

namespace pg8 {
constexpr int BM = 256, BK = 64, HALF = 128, HTB = HALF * BK * 2, STAGE_BYTES = 8 * HTB, NXCD = 8, WGM = 8;
__host__ __device__ __forceinline__ int lds_byte(int r, int c) { const int st = (r >> 4) * 2 + (c >> 5), rr = r & 15, cc = c & 31, ob = rr * 64 + cc * 2; return st * 1024 + (ob ^ (((ob >> 9) & 1) << 5)); }
__host__ __device__ __forceinline__ void stage_rc(int b, int& R, int& C) { const int st = b / 1024, sb = b % 1024, swz = sb ^ (((sb >> 9) & 1) << 5); R = (st >> 1) * 16 + swz / 64; C = (st & 1) * 32 + (swz % 64) / 2; }
__host__ __device__ __forceinline__ int perm32(int rho) { const int n = rho >> 4, i = rho & 15; return 8 * (i >> 2) + 4 * n + (i & 3); }
struct Unit { int pm, pn; const char* bA; const char* bB; int cl, slot0, n; const float* bsc; };
DI bool static_next(int i, int G, int c, int nM, int nN, Unit& u) {
    const int nwg = nM * nN; const long L = (long)i * G + c; if (L >= nwg) return false;
    int wgid = (int)L; { const int q = nwg / NXCD, r = nwg % NXCD, xcd = wgid % NXCD, off = wgid / NXCD; wgid = (xcd < r ? xcd * (q + 1) : r * (q + 1) + (xcd - r) * q) + off; }
    const int nig = WGM * nN, gid = wgid / nig, fm = gid * WGM, gsz = (nM - fm) < WGM ? (nM - fm) : WGM;
    u.pm = fm + ((wgid % nig) % gsz); u.pn = (wgid % nig) / gsz; return true;
}
template <class Epi, class Sched, int MODE = 0>
__device__ __forceinline__ void gemm_phase(LAS unsigned char* lds, const int tid_in, const char* Abase, const int Kbytes, const unsigned ldb, const Sched& S, const Epi& E, unsigned long long& pacc) {
    constexpr bool I8 = MODE == 1, F8 = MODE == 2;
    int tid_ = tid_in; asm volatile("" : "+v"(tid_));
    const int tid = tid_, wid = __builtin_amdgcn_readfirstlane(tid >> 6), lane = tid & 63, wr = wid >> 2, wc = wid & 3, fr = lane & 15, fq = lane >> 4;
    const int nt = Kbytes / 128;
    int Rr[2], Cc[2]; unsigned voffB[2];
#pragma unroll
    for (int i = 0; i < 2; ++i) { int R, C; stage_rc(tid * 16 + i * 8192, R, C); Rr[i] = R; Cc[i] = C; const int Rb = Epi::PERM ? ((R & ~31) + perm32(R & 31)) : R; voffB[i] = (unsigned)Rb * ldb + (unsigned)C * 2u; }
    const size_t kstep = (size_t)(BK * 2);
    const size_t hstepB = (size_t)HALF * ldb;
    const unsigned ldsw = (unsigned)wid * 1024u;
    const int aoff = lds_byte(wr * 64 + fr, fq * 8), boff = lds_byte(wc * 32 + fr, fq * 8);
#define PG8_SA(b, h) (((b) * 2 + (h)) * HTB)
#define PG8_SB(b, h) ((4 + (b) * 2 + (h)) * HTB)
#define PG8_STAGE_B(bufoff, gbase) do { _Pragma("unroll") for (int _i = 0; _i < 2; ++_i) \
        __builtin_amdgcn_global_load_lds((const unsigned*)((const char*)(gbase) + voffB[_i]), (LAS unsigned*)(lds + (bufoff) + ldsw + _i * 8192), 16, 0, 0); } while (0)
#define PG8_STAGE_A(bufoff, koff, offs) do { _Pragma("unroll") for (int _i = 0; _i < 2; ++_i) \
        __builtin_amdgcn_global_load_lds((const unsigned*)(Abase + (koff) + (offs)[_i]), (LAS unsigned*)(lds + (bufoff) + ldsw + _i * 8192), 16, 0, 0); } while (0)
#define PG8_CAT8(p_) __builtin_shufflevector(*(const LAS i32x4*)(p_), *(const LAS i32x4*)((p_) + 1024), 0, 1, 2, 3, 4, 5, 6, 7)
#define PG8_LDA(dst, b, h) do { if constexpr (F8) { _Pragma("unroll") for (int m = 0; m < 4; ++m) dst##8[m] = PG8_CAT8(lds + PG8_SA(b, h) + aoff + m * 2048); } \
        else { _Pragma("unroll") for (int m = 0; m < 4; ++m) _Pragma("unroll") for (int k = 0; k < 2; ++k) dst[m][k] = *(const LAS bf16x8*)(lds + PG8_SA(b, h) + aoff + m * 2048 + k * 1024); } } while (0)
#define PG8_LDB(dst, b, h) do { if constexpr (F8) { _Pragma("unroll") for (int n = 0; n < 2; ++n) dst##8[n] = PG8_CAT8(lds + PG8_SB(b, h) + boff + n * 2048); } \
        else { _Pragma("unroll") for (int n = 0; n < 2; ++n) _Pragma("unroll") for (int k = 0; k < 2; ++k) dst[n][k] = *(const LAS bf16x8*)(lds + PG8_SB(b, h) + boff + n * 2048 + k * 1024); } } while (0)
#define PG8_MMA(ai, bj, At, Bt) do { __builtin_amdgcn_s_setprio(1); _Pragma("unroll") for (int m = 0; m < 4; ++m) _Pragma("unroll") for (int n = 0; n < 2; ++n) _Pragma("unroll") for (int k = 0; k < 2; ++k) { \
        if constexpr (F8) { if (k == 0) asm volatile("v_mfma_scale_f32_16x16x128_f8f6f4 %0, %1, %2, %0, %3, %3 op_sel_hi:[0,0,0]" : "+v"(acc[ai][bj][m][n]) : "v"(Bt##8[n]), "v"(At##8[m]), "v"(f8one)); } \
        else if constexpr (I8) acc[ai][bj][m][n] = __builtin_bit_cast(f32x4, __builtin_amdgcn_mfma_i32_16x16x64_i8(__builtin_bit_cast(i32x4, Bt[n][k]), __builtin_bit_cast(i32x4, At[m][k]), __builtin_bit_cast(i32x4, acc[ai][bj][m][n]), 0, 0, 0)); \
        else acc[ai][bj][m][n] = __builtin_amdgcn_mfma_f32_16x16x32_bf16(Bt[n][k], At[m][k], acc[ai][bj][m][n], 0, 0, 0); } __builtin_amdgcn_s_setprio(0); } while (0)
#define PG8_WAIT_V(n) asm volatile("s_waitcnt vmcnt(" #n ")" ::: "memory")
#define PG8_WAIT_L(n) asm volatile("s_waitcnt lgkmcnt(" #n ")" ::: "memory")
#define PG8_BAR __builtin_amdgcn_s_barrier()
#define PG8_SCHED __builtin_amdgcn_sched_barrier(0)
#if PROBE_GEMM
    unsigned long long gtp_ = __builtin_amdgcn_s_memrealtime();
#define GEMT(k) do { const unsigned long long tn_ = __builtin_amdgcn_s_memrealtime(); if (PROBE_GEMM == (k)) pacc += tn_ - gtp_; gtp_ = tn_; } while (0)
#else
#define GEMT(k) do { } while (0)
#endif
    Unit cur, nxt; int ui = 0;
    if (!S.next(0, cur)) return;
#if GEMM_STAGGER_TICKS
    { const int nwg_ = S.total(), G_ = (int)gridDim.x, c_ = (int)blockIdx.x; const int nmax_ = (nwg_ + G_ - 1) / G_, mine_ = (nwg_ - 1 - c_) / G_ + 1;
      if (mine_ < nmax_) { const unsigned long long t0_ = __builtin_amdgcn_s_memrealtime(); while (__builtin_amdgcn_s_memrealtime() - t0_ < (unsigned long long)GEMM_STAGGER_TICKS) __builtin_amdgcn_s_sleep(16); } }
#endif
    f32x4 acc[2][2][4][2];
#pragma unroll
    for (int a = 0; a < 2; ++a)
#pragma unroll
        for (int b = 0; b < 2; ++b)
#pragma unroll
            for (int m = 0; m < 4; ++m)
#pragma unroll
                for (int n = 0; n < 2; ++n) acc[a][b][m][n] = (f32x4){0.f, 0.f, 0.f, 0.f};
    int f8one = 0x7F7F7F7F; asm volatile("" : "+v"(f8one));
    bf16x8 At[4][2], B0[2][2], B1[2][2]; i32x8 At8[4], B08[2], B18[2];
    unsigned oC[2][2], oN[2][2];
#pragma unroll
    for (int h = 0; h < 2; ++h)
#pragma unroll
        for (int i = 0; i < 2; ++i) { oC[h][i] = S.a_off(cur, h * HALF + Rr[i]) + (unsigned)Cc[i] * 2u; asm volatile("" : "+v"(oC[h][i])); }
#define PG8_BPTR(u, t) (((t) < Sched::KSPLIT ? (u).bA : (u).bB) + (size_t)((t) & (Sched::KSPLIT - 1)) * 128)
    const char* cB = PG8_BPTR(cur, 0);
    PG8_STAGE_B(PG8_SB(0, 0), cB); PG8_STAGE_B(PG8_SB(0, 1), cB + hstepB); PG8_STAGE_A(PG8_SA(0, 0), 0, oC[0]); PG8_STAGE_A(PG8_SA(0, 1), 0, oC[1]);
    if (wr == 1) PG8_BAR;
    PG8_WAIT_V(2); PG8_BAR;
    { const char* cB1 = PG8_BPTR(cur, 1); PG8_STAGE_B(PG8_SB(1, 0), cB1); PG8_STAGE_A(PG8_SA(1, 0), kstep, oC[0]); PG8_STAGE_B(PG8_SB(1, 1), cB1 + hstepB); }
    PG8_WAIT_V(6); PG8_BAR;
    for (;;) {
        const bool has_next = S.next(ui + 1, nxt);
        if (!has_next) nxt = cur;
        if constexpr (!Sched::GATHER) {
#pragma unroll
            for (int h = 0; h < 2; ++h)
#pragma unroll
                for (int i = 0; i < 2; ++i) { oN[h][i] = S.a_off(nxt, h * HALF + Rr[i]) + (unsigned)Cc[i] * 2u; asm volatile("" : "+v"(oN[h][i])); }
        }
        if constexpr (I8 || F8 || Sched::GATHER || Epi::HAS_GL) {
            int t8 = tid; asm volatile("" : "+v"(t8)); const int wid8 = __builtin_amdgcn_readfirstlane(t8 >> 6); const unsigned l8 = (unsigned)(t8 & 63) * 4u;
            LAS unsigned char* tbc = lds + TAB_OFF + (ui & 1) * TAB_STRIDE;
            if constexpr (F8) { if (wid8 >= 4) __builtin_amdgcn_global_load_lds((const unsigned*)((const char*)S.b_scale(cur) + (wid8 - 4) * 256 + l8), (LAS unsigned*)(tbc + wid8 * 256), 4, 0, 0); }
            if constexpr (I8) { const char* g8 = wid8 < 4 ? (const char*)S.sa_ptr(cur) + wid8 * 256 : (const char*)S.b_scale(cur) + (wid8 - 4) * 256;
                __builtin_amdgcn_global_load_lds((const unsigned*)(g8 + l8), (LAS unsigned*)(tbc + wid8 * 256), 4, 0, 0); }
            if constexpr (Epi::HAS_GL) __builtin_amdgcn_global_load_lds((const unsigned*)((const char*)E.gl_ptr(cur) + wid8 * 256 + l8), (LAS unsigned*)(tbc + 2048 + wid8 * 256), 4, 0, 0);
            if constexpr (Sched::GATHER) { if (wid8 < 4) __builtin_amdgcn_global_load_lds((const unsigned*)((const char*)S.list_ptr(nxt) + wid8 * 256 + l8), (LAS unsigned*)(lds + TAB_OFF + ((ui + 1) & 1) * TAB_STRIDE + 4096 + wid8 * 256), 4, 0, 0); }
        }
        GEMT(3);
        for (int t = 0; t < nt; t += 2) {
            const bool last = (t == nt - 2);
            const size_t a1k = (size_t)(t + 1) * kstep;
            const size_t a2k = last ? 0 : (size_t)(t + 2) * kstep, a3k = a2k + kstep;
            const char* b2 = last ? PG8_BPTR(nxt, 0) : PG8_BPTR(cur, t + 2);
            const char* b3 = last ? PG8_BPTR(nxt, 1) : PG8_BPTR(cur, t + 3);
            if constexpr (Sched::GATHER) {
                const LAS int* Ln = (const LAS int*)(lds + TAB_OFF + ((ui + 1) & 1) * TAB_STRIDE + 4096);
#pragma unroll
                for (int h = 0; h < 2; ++h)
#pragma unroll
                    for (int i = 0; i < 2; ++i) { const int row = h * HALF + Rr[i]; int tok = Ln[row]; tok = S.row_valid(nxt, row) ? tok : 0; oN[h][i] = (unsigned)tok * 1024u + (unsigned)Cc[i] * 2u; }
            }
            unsigned o2[2][2];
            { const unsigned c00 = oC[0][0], c01 = oC[0][1], c10 = oC[1][0], c11 = oC[1][1], n00 = oN[0][0], n01 = oN[0][1], n10 = oN[1][0], n11 = oN[1][1];
              o2[0][0] = last ? n00 : c00; o2[0][1] = last ? n01 : c01; o2[1][0] = last ? n10 : c10; o2[1][1] = last ? n11 : c11; }
            PG8_LDB(B0, 0, 0); PG8_LDB(B1, 0, 1); PG8_SCHED; PG8_LDA(At, 0, 0); PG8_STAGE_A(PG8_SA(1, 1), a1k, oC[1]);
            PG8_WAIT_V(8); PG8_WAIT_L(0); PG8_BAR; PG8_MMA(0, 0, At, B0); PG8_MMA(0, 1, At, B1); PG8_BAR; PG8_SCHED;
            PG8_LDA(At, 0, 1); PG8_STAGE_B(PG8_SB(0, 0), b2); PG8_STAGE_B(PG8_SB(0, 1), b2 + hstepB); PG8_STAGE_A(PG8_SA(0, 0), a2k, o2[0]);
            PG8_WAIT_V(8); PG8_WAIT_L(0); PG8_BAR; PG8_MMA(1, 0, At, B0); PG8_MMA(1, 1, At, B1); PG8_BAR; PG8_SCHED;
            PG8_LDB(B0, 1, 0); PG8_LDB(B1, 1, 1); PG8_SCHED; PG8_LDA(At, 1, 0); PG8_STAGE_A(PG8_SA(0, 1), a2k, o2[1]);
            PG8_WAIT_V(8); PG8_WAIT_L(0); PG8_BAR; PG8_MMA(0, 0, At, B0); PG8_MMA(0, 1, At, B1); PG8_BAR; PG8_SCHED;
            PG8_LDA(At, 1, 1); PG8_STAGE_B(PG8_SB(1, 0), b3); PG8_STAGE_B(PG8_SB(1, 1), b3 + hstepB); PG8_STAGE_A(PG8_SA(1, 0), a3k, o2[0]);
            PG8_WAIT_V(8); PG8_WAIT_L(0); PG8_BAR; PG8_MMA(1, 0, At, B0); PG8_MMA(1, 1, At, B1); PG8_BAR; PG8_SCHED;
        }
        GEMT(1);
        if constexpr (F8) asm volatile("s_nop 15\n\ts_nop 15" ::: "memory");
        if (wr == 0) PG8_BAR;
        if constexpr (I8) {
            int t7 = tid; asm volatile("" : "+v"(t7)); const int wid7 = __builtin_amdgcn_readfirstlane(t7 >> 6), l7 = t7 & 63, wr7 = wid7 >> 2, wc7 = wid7 & 3, fr7 = l7 & 15, fq7 = l7 >> 4;
            const LAS float* sap = (const LAS float*)(lds + TAB_OFF + (ui & 1) * TAB_STRIDE); const LAS float* sbp = sap + 256 + wc7 * 32 + (Epi::PERM ? 8 * fq7 : 4 * fq7);
#pragma unroll
            for (int a = 0; a < 2; ++a)
#pragma unroll
                for (int m = 0; m < 4; ++m) { const int row7 = a * HALF + wr7 * 64 + m * 16 + fr7; float sa_ = sap[row7]; sa_ = S.row_valid(cur, row7) ? sa_ : 0.f;
#pragma unroll
                    for (int b = 0; b < 2; ++b)
#pragma unroll
                        for (int n = 0; n < 2; ++n) { const f32x4 sb_ = *(const LAS f32x4*)(sbp + b * HALF + (Epi::PERM ? 4 * n : 16 * n)); const i32x4 v = __builtin_bit_cast(i32x4, acc[a][b][m][n]);
                            acc[a][b][m][n] = (f32x4){(float)v[0], (float)v[1], (float)v[2], (float)v[3]} * sa_ * sb_; } }
        }
        if constexpr (F8) {
            int t7 = tid; asm volatile("" : "+v"(t7)); const int wid7 = __builtin_amdgcn_readfirstlane(t7 >> 6), l7 = t7 & 63, wc7 = wid7 & 3, fq7 = l7 >> 4;
            const LAS float* sbp = (const LAS float*)(lds + TAB_OFF + (ui & 1) * TAB_STRIDE) + 256 + wc7 * 32 + (Epi::PERM ? 8 * fq7 : 4 * fq7); const float ac_ = S.a_const();
#pragma unroll
            for (int b = 0; b < 2; ++b)
#pragma unroll
                for (int n = 0; n < 2; ++n) { const f32x4 sb_ = *(const LAS f32x4*)(sbp + b * HALF + (Epi::PERM ? 4 * n : 16 * n)) * ac_;
#pragma unroll
                    for (int a = 0; a < 2; ++a)
#pragma unroll
                        for (int m = 0; m < 4; ++m) acc[a][b][m][n] = acc[a][b][m][n] * sb_; }
        }
        E(acc, cur, wr, wc, fr, fq, (const LAS unsigned char*)(lds + TAB_OFF + (ui & 1) * TAB_STRIDE));
        GEMT(2);
        if (!has_next) break;
#pragma unroll
        for (int a = 0; a < 2; ++a)
#pragma unroll
            for (int b = 0; b < 2; ++b)
#pragma unroll
                for (int m = 0; m < 4; ++m)
#pragma unroll
                    for (int n = 0; n < 2; ++n) acc[a][b][m][n] = (f32x4){0.f, 0.f, 0.f, 0.f};
        cur = nxt; ++ui;
#pragma unroll
        for (int h = 0; h < 2; ++h)
#pragma unroll
            for (int i = 0; i < 2; ++i) oC[h][i] = oN[h][i];
        if (wr == 1) PG8_BAR;
    }
    PG8_WAIT_V(0);
    PG8_BAR;
    GEMT(3);
#undef GEMT
#undef PG8_BPTR
#undef PG8_SA
#undef PG8_SB
#undef PG8_STAGE_A
#undef PG8_STAGE_B
#undef PG8_LDA
#undef PG8_LDB
#undef PG8_MMA
#undef PG8_WAIT_V
#undef PG8_WAIT_L
#undef PG8_BAR
#undef PG8_SCHED
}
}
using pg8::Unit;

struct DenseOrder {
    int nM, nN, G, c; unsigned lda; const char* Bt; unsigned ldb; const float* sa; const float* sb; float ac = 1.f;
    DI float a_const() const { return ac; }
    DI bool next(int i, Unit& u) const { if (!pg8::static_next(i, G, c, nM, nN, u)) return false; u.bA = Bt + (size_t)u.pn * 256 * ldb; u.bB = u.bA + 1024; u.cl = 0; u.slot0 = 0; u.n = 0; u.bsc = sb + u.pn * 256; return true; }
    static constexpr bool GATHER = false; static constexpr int KSPLIT = 8;
    DI const float* sa_ptr(const Unit& u) const { return sa + u.pm * 256; }
    DI const float* b_scale(const Unit& u) const { return u.bsc; }
    DI bool row_valid(const Unit&, int) const { return true; }
    DI const int* list_ptr(const Unit&) const { return nullptr; }
    DI unsigned a_off(const Unit& u, int row) const { return (unsigned)(u.pm * 256 + row) * lda; }
    DI int total() const { return nM * nN; }
};
DI int moe_class(const LAS int* bs, int pm) { int c = 0;
#pragma unroll
    for (int k = 1; k < NCLS; ++k) c += (bs[k] <= pm) ? 1 : 0;
    return c; }
DI void moe_experts(int c, int& elo, int& ehi) { const int g = c / 6, p = c - 6 * g; const int lo = p < 3 ? 0 : (p < 5 ? 1 : 2), hi = p < 3 ? p + 1 : (p < 5 ? p - 1 : 3); elo = 4 * g + lo; ehi = 4 * g + hi; }
struct MoeUpOrder {
    int nM, G, c; const LAS int* bs; const LAS int* cnt; const int* list; const char* Wgu; const float* slist; const float* sbgu;
    DI bool next(int i, Unit& u) const { if (!pg8::static_next(i, G, c, nM, 8, u)) return false;
        const int cl = __builtin_amdgcn_readfirstlane(moe_class(bs, u.pm)); int elo, ehi; moe_experts(cl, elo, ehi); const int e = u.pn < 4 ? elo : ehi;
        u.bA = Wgu + (size_t)e * (1024 * 1024) + (size_t)(u.pn & 3) * 256 * 1024; u.bB = u.bA + 1024; u.cl = cl; u.slot0 = (u.pm - __builtin_amdgcn_readfirstlane(bs[cl])) * 256; u.n = __builtin_amdgcn_readfirstlane(cnt[cl]); u.bsc = sbgu + e * 1024 + (u.pn & 3) * 256; return true; }
    DI unsigned a_off(const Unit& u, int row) const { const int slot = u.slot0 + row; int tok = 0; if (slot < u.n) tok = list[(size_t)u.cl * MT + slot]; return (unsigned)tok * 1024u; }
    static constexpr int KSPLIT = 8;
    static constexpr bool GATHER = true;
    DI const float* sa_ptr(const Unit& u) const { return slist + (size_t)u.cl * MT + u.slot0; }
    DI const int* list_ptr(const Unit& u) const { return list + (size_t)u.cl * MT + u.slot0; }
    DI bool row_valid(const Unit& u, int row) const { return u.slot0 + row < u.n; }
    DI const float* b_scale(const Unit& u) const { return u.bsc; }
};
struct MoeDownOrder {
    int nM, G, c; const LAS int* bs; const char* Wd; const float* sbd;
    static constexpr bool GATHER = false; static constexpr int KSPLIT = 4;
    DI bool next(int i, Unit& u) const { if (!pg8::static_next(i, G, c, nM, 4, u)) return false;
        const int cl = __builtin_amdgcn_readfirstlane(moe_class(bs, u.pm)); int elo, ehi; moe_experts(cl, elo, ehi);
        u.bA = Wd + (size_t)elo * (1024 * 512) + (size_t)u.pn * 256 * 512; u.bB = Wd + (size_t)ehi * (1024 * 512) + (size_t)u.pn * 256 * 512; u.cl = cl; u.slot0 = 0; u.n = 0; u.bsc = sbd + (cl / 6) * 1024 + u.pn * 256; return true; }
    DI unsigned a_off(const Unit& u, int row) const { return (unsigned)(u.pm * 256 + row) * 1024u; }
    DI const float* sa_ptr(const Unit&) const { return nullptr; }
    DI const float* b_scale(const Unit& u) const { return u.bsc; }
    DI float a_const() const { return 1.0f / HID_SCALE; }
    DI bool row_valid(const Unit&, int) const { return true; }
    DI const int* list_ptr(const Unit&) const { return nullptr; }
    DI int total() const { return nM * 4; }
};

struct EpiQKV {
    static constexpr bool PERM = false, HAS_GL = false;
    bf16_t* P; const LAS float* rope;
    DI void operator()(const f32x4 (&acc)[2][2][4][2], const Unit& u, int wr, int wc, int fr, int fq, const LAS unsigned char* tb) const {
        const int row0 = u.pm * 256 + wr * 64 + fr; const bool lat = u.pm < 256; const bool dorope = lat && u.pn < 5; const float sc = u.pn < 4 ? QSCALE : 1.0f;
#pragma unroll
        for (int ai = 0; ai < 2; ++ai)
#pragma unroll
            for (int m = 0; m < 4; ++m) { const int row = row0 + ai * 128 + m * 16; const int t = row & 2047; const int pos = (wc & 1) ? (t & 63) : (t >> 6);
                f32x4 cs = (f32x4){1.f, 1.f, 1.f, 1.f}, sn = (f32x4){0.f, 0.f, 0.f, 0.f};
                if (dorope) { cs = *(const LAS f32x4*)(rope + pos * 32 + 4 * fq); sn = *(const LAS f32x4*)(rope + pos * 32 + 16 + 4 * fq); }
                bf16_t* rowp = P + (size_t)row * NQKV + u.pn * 256 + wc * 32 + 4 * fq;
#pragma unroll
                for (int bj = 0; bj < 2; ++bj) { const f32x4 y1 = acc[ai][bj][m][0], y2 = acc[ai][bj][m][1];
                    const f32x4 o1 = (y1 * cs - y2 * sn) * sc, o2 = (y2 * cs + y1 * sn) * sc;
                    u32x2 w1, w2; w1.x = cvt_pk_bf16(o1[0], o1[1]); w1.y = cvt_pk_bf16(o1[2], o1[3]); w2.x = cvt_pk_bf16(o2[0], o2[1]); w2.y = cvt_pk_bf16(o2[2], o2[3]);
                    *(u32x2*)(rowp + bj * 128) = w1; *(u32x2*)(rowp + bj * 128 + 16) = w2; } }
    }
};
struct EpiGLA {
    static constexpr bool PERM = true, HAS_GL = false;
    bf16_t* R2b; float* R;
    DI void operator()(const f32x4 (&acc)[2][2][4][2], const Unit& u, int wr, int wc, int fr, int fq, const LAS unsigned char* tb) const {
        const int row0 = u.pm * 256 + wr * 64 + fr;
        if (u.pn == 12) { if (wc == 0) {
#pragma unroll
            for (int ai = 0; ai < 2; ++ai)
#pragma unroll
                for (int m = 0; m < 4; ++m) { float* rp = R + (size_t)(row0 + ai * 128 + m * 16) * 32 + 8 * fq; *(f32x4*)rp = acc[ai][0][m][0]; *(f32x4*)(rp + 4) = acc[ai][0][m][1]; } }
            return; }
        const int tsel = u.pn < 4 ? 0 : (u.pn < 8 ? 2 : 1);
        bf16_t* base = R2b + (size_t)tsel * ((size_t)MT * 1024); const int colt = (u.pn & 3) * 256; const float sc = u.pn < 2 ? 0.08838834764831845f : 1.0f;
#pragma unroll
        for (int ai = 0; ai < 2; ++ai)
#pragma unroll
            for (int m = 0; m < 4; ++m) { bf16_t* rowp = base + (size_t)(row0 + ai * 128 + m * 16) * 1024 + colt + wc * 32 + 8 * fq;
#pragma unroll
                for (int bj = 0; bj < 2; ++bj) { const f32x4 v0 = acc[ai][bj][m][0] * sc, v1 = acc[ai][bj][m][1] * sc;
                    u32x4 w; w.x = cvt_pk_bf16(v0[0], v0[1]); w.y = cvt_pk_bf16(v0[2], v0[3]); w.z = cvt_pk_bf16(v1[0], v1[1]); w.w = cvt_pk_bf16(v1[2], v1[3]);
                    *(u32x4*)(rowp + bj * 128) = w; } }
    }
};
struct EpiY {
    static constexpr bool PERM = true, HAS_GL = false;
    unsigned char* Y;
    DI void operator()(const f32x4 (&acc)[2][2][4][2], const Unit& u, int wr, int wc, int fr, int fq, const LAS unsigned char* tb) const {
        const int row0 = u.pm * 256 + wr * 64 + fr; const int col0 = u.pn * 256 + wc * 32 + 8 * fq;
#pragma unroll
        for (int ai = 0; ai < 2; ++ai)
#pragma unroll
            for (int m = 0; m < 4; ++m) { unsigned char* rowp = Y + (size_t)(row0 + ai * 128 + m * 16) * 1024 + col0;
#pragma unroll
                for (int bj = 0; bj < 2; ++bj) { const f32x4 v0 = acc[ai][bj][m][0] * Y_SCALE, v1 = acc[ai][bj][m][1] * Y_SCALE;
                    int w0 = 0, w1 = 0;
                    w0 = __builtin_amdgcn_cvt_pk_fp8_f32(__builtin_amdgcn_fmed3f(v0[0], -448.f, 448.f), __builtin_amdgcn_fmed3f(v0[1], -448.f, 448.f), w0, false); w0 = __builtin_amdgcn_cvt_pk_fp8_f32(__builtin_amdgcn_fmed3f(v0[2], -448.f, 448.f), __builtin_amdgcn_fmed3f(v0[3], -448.f, 448.f), w0, true);
                    w1 = __builtin_amdgcn_cvt_pk_fp8_f32(__builtin_amdgcn_fmed3f(v1[0], -448.f, 448.f), __builtin_amdgcn_fmed3f(v1[1], -448.f, 448.f), w1, false); w1 = __builtin_amdgcn_cvt_pk_fp8_f32(__builtin_amdgcn_fmed3f(v1[2], -448.f, 448.f), __builtin_amdgcn_fmed3f(v1[3], -448.f, 448.f), w1, true);
                    *(u32x2*)(rowp + bj * 128) = (u32x2){(unsigned)w0, (unsigned)w1}; } }
    }
};
DI float silu_fast(float a) { return a * __builtin_amdgcn_rcpf(1.0f + __builtin_amdgcn_exp2f(-a * LOG2E)); }
struct EpiSwiGLU {
    static constexpr bool PERM = true, HAS_GL = true;
    unsigned char* HID; const f32x2* glist;
    DI const f32x2* gl_ptr(const Unit& u) const { return glist + (size_t)u.cl * MT + u.slot0; }
    DI void operator()(const f32x4 (&acc)[2][2][4][2], const Unit& u, int wr, int wc, int fr, int fq, const LAS unsigned char* tb) const {
        const int sel = u.pn >> 2, hb = u.pn & 3; const int r0 = wr * 64 + fr; const LAS f32x2* gl = (const LAS f32x2*)(tb + 2048);
#pragma unroll
        for (int ai = 0; ai < 2; ++ai) {
            float gwv[4];
#pragma unroll
            for (int m = 0; m < 4; ++m) { const int rr_ = r0 + ai * 128 + m * 16; const f32x2 gg = gl[rr_]; const float g = (sel ? gg.y : gg.x) * HID_SCALE; gwv[m] = (u.slot0 + rr_ < u.n) ? g : 0.f; }
#pragma unroll
            for (int m = 0; m < 4; ++m) { const int r = r0 + ai * 128 + m * 16; const float gw = gwv[m];
                const f32x4 a0 = acc[ai][0][m][0], a1 = acc[ai][0][m][1], b0 = acc[ai][1][m][0], b1 = acc[ai][1][m][1];
                float h[8];
#pragma unroll
                for (int e = 0; e < 4; ++e) { h[e] = __builtin_amdgcn_fmed3f(silu_fast(a0[e]) * b0[e] * gw, -448.f, 448.f); h[4 + e] = __builtin_amdgcn_fmed3f(silu_fast(a1[e]) * b1[e] * gw, -448.f, 448.f); }
                int w0 = 0, w1 = 0; w0 = __builtin_amdgcn_cvt_pk_fp8_f32(h[0], h[1], w0, false); w0 = __builtin_amdgcn_cvt_pk_fp8_f32(h[2], h[3], w0, true); w1 = __builtin_amdgcn_cvt_pk_fp8_f32(h[4], h[5], w1, false); w1 = __builtin_amdgcn_cvt_pk_fp8_f32(h[6], h[7], w1, true);
                *(u32x2*)(HID + (size_t)(u.pm * 256 + r) * 1024 + sel * 512 + hb * 128 + wc * 32 + 8 * fq) = (u32x2){(unsigned)w0, (unsigned)w1}; } }
    }
};

struct TItem { const float* W; int ldw; bf16_t* WT; int Kd, k0, n0, drow0; };
DI void titem_load(const TItem& I, f32x4 (&t)[8], int lane) {
#pragma unroll
    for (int i = 0; i < 8; ++i) { const int idx = lane + 64 * i; t[i] = *(const f32x4*)(I.W + (size_t)(I.k0 + (idx >> 3)) * I.ldw + I.n0 + 4 * (idx & 7)); }
}
DI void titem_store(const TItem& I, const f32x4 (&t)[8], LAS float* scr, int lane) {
#pragma unroll
    for (int i = 0; i < 8; ++i) { const int idx = lane + 64 * i; LAS float* d = scr + (idx >> 3) * 33 + 4 * (idx & 7); d[0] = t[i][0]; d[1] = t[i][1]; d[2] = t[i][2]; d[3] = t[i][3]; }
    asm volatile("s_waitcnt lgkmcnt(0)" ::: "memory");
    const int c = lane & 7;
#pragma unroll
    for (int j = 0; j < 4; ++j) { const int n = (lane >> 3) + 8 * j; const LAS float* s = scr + (8 * c) * 33 + n;
        u32x4 o; o.x = cvt_pk_bf16(s[0 * 33], s[1 * 33]); o.y = cvt_pk_bf16(s[2 * 33], s[3 * 33]); o.z = cvt_pk_bf16(s[4 * 33], s[5 * 33]); o.w = cvt_pk_bf16(s[6 * 33], s[7 * 33]);
        *(u32x4*)(I.WT + (size_t)(I.drow0 + n) * I.Kd + I.k0 + 8 * c) = o; }
    asm volatile("s_waitcnt lgkmcnt(0)" ::: "memory");
}
template <bool F8>
DI void wstrip_q(const float* W, int ldw, int nkb, int kbsh, size_t estride, int rowlen, signed char* W8, int n0, int drow0, float* sb, LAS float* scr, int lane) {
    constexpr float QMAX = F8 ? 224.0f : 127.0f;
    const int kmask = (1 << kbsh) - 1;
    float m4[4] = {0.f, 0.f, 0.f, 0.f};
    for (int kb = 0; kb < nkb; ++kb) { f32x4 t[8];
#pragma unroll
        for (int i = 0; i < 8; ++i) { const int idx = lane + 64 * i; t[i] = *(const f32x4*)(W + (size_t)(64 * kb + (idx >> 3)) * ldw + n0 + 4 * (idx & 7)); }
#pragma unroll
        for (int i = 0; i < 8; ++i)
#pragma unroll
            for (int e = 0; e < 4; ++e) m4[e] = fmaxf(m4[e], fabsf(t[i][e])); }
#pragma unroll
    for (int o = 8; o < 64; o <<= 1)
#pragma unroll
        for (int e = 0; e < 4; ++e) m4[e] = fmaxf(m4[e], shx(m4[e], o, lane));
    LAS float* inv = scr + 64 * 33;
    if (lane < 8) {
#pragma unroll
        for (int e = 0; e < 4; ++e) { const float am = m4[e]; sb[drow0 + 4 * lane + e] = am > 0.f ? am * (1.0f / QMAX) : 1.0f; inv[4 * lane + e] = am > 0.f ? QMAX / am : 0.f; } }
    asm volatile("s_waitcnt lgkmcnt(0)" ::: "memory");
    for (int kb = 0; kb < nkb; ++kb) { f32x4 t[8];
#pragma unroll
        for (int i = 0; i < 8; ++i) { const int idx = lane + 64 * i; t[i] = *(const f32x4*)(W + (size_t)(64 * kb + (idx >> 3)) * ldw + n0 + 4 * (idx & 7)); }
#pragma unroll
        for (int i = 0; i < 8; ++i) { const int idx = lane + 64 * i; LAS float* d = scr + (idx >> 3) * 33 + 4 * (idx & 7); d[0] = t[i][0]; d[1] = t[i][1]; d[2] = t[i][2]; d[3] = t[i][3]; }
        asm volatile("s_waitcnt lgkmcnt(0)" ::: "memory");
#pragma unroll
        for (int j = 0; j < 2; ++j) { const int p = lane + 64 * j; const int n = p >> 2, c = p & 3; const float iv = inv[n]; const LAS float* sp = scr + (16 * c) * 33 + n; unsigned w[4];
#pragma unroll
            for (int q = 0; q < 4; ++q) {
                if constexpr (F8) { int pk = 0; pk = __builtin_amdgcn_cvt_pk_fp8_f32(sp[(4 * q) * 33] * iv, sp[(4 * q + 1) * 33] * iv, pk, false); pk = __builtin_amdgcn_cvt_pk_fp8_f32(sp[(4 * q + 2) * 33] * iv, sp[(4 * q + 3) * 33] * iv, pk, true); w[q] = (unsigned)pk; }
                else { unsigned pk = 0u;
#pragma unroll
                    for (int e = 0; e < 4; ++e) { const int qi = (int)__builtin_rintf(sp[(4 * q + e) * 33] * iv); pk |= ((unsigned)qi & 0xffu) << (8 * e); }
                    w[q] = pk; } }
            *(u32x4*)(W8 + (size_t)(kb >> kbsh) * estride + (size_t)(drow0 + n) * rowlen + 64 * (kb & kmask) + 16 * c) = (u32x4){w[0], w[1], w[2], w[3]}; }
        asm volatile("s_waitcnt lgkmcnt(0)" ::: "memory"); }
}
DI void wstrip_i8(const float* W, int ldw, signed char* W8, int n0, int drow0, float* sb, LAS float* scr, int lane) { wstrip_q<false>(W, ldw, 16, 4, 0, 1024, W8, n0, drow0, sb, scr, lane); }
template <bool F8, int NB>
DI void wstrip_blk(LAS unsigned char* lds, int wave, int lane_in, const float* W, int ldw, int kbsh, size_t estride, int rowlen, signed char* W8, int n0, int drow0, float* sb, int par) {
    constexpr float QMAX = F8 ? 224.0f : 127.0f;
    int lane = lane_in; asm volatile("" : "+v"(lane));
    const int kmask = (1 << kbsh) - 1;
    LAS float* scr = (LAS float*)(lds + wave * 16384);
    LAS float* amx = (LAS float*)(lds + 131072 + par * 1024);
    f32x4 t[NB][8];
    const GAS char* wb = (const GAS char*)(W + (size_t)(64 * NB * wave) * ldw + n0); const unsigned lo = (unsigned)(((lane >> 3) * ldw + 4 * (lane & 7)) * 4);
#pragma unroll
    for (int b = 0; b < NB; ++b)
#pragma unroll
        for (int i = 0; i < 8; ++i) t[b][i] = *(const GAS f32x4*)(wb + (size_t)(64 * b + 8 * i) * ldw * 4 + lo);
    float m4[4] = {0.f, 0.f, 0.f, 0.f};
#pragma unroll
    for (int b = 0; b < NB; ++b)
#pragma unroll
        for (int i = 0; i < 8; ++i)
#pragma unroll
            for (int e = 0; e < 4; ++e) m4[e] = fmaxf(m4[e], fabsf(t[b][i][e]));
#pragma unroll
    for (int o = 8; o < 64; o <<= 1)
#pragma unroll
        for (int e = 0; e < 4; ++e) m4[e] = fmaxf(m4[e], shx(m4[e], o, lane));
    if (lane < 8) *(LAS f32x4*)(amx + wave * 32 + 4 * lane) = (f32x4){m4[0], m4[1], m4[2], m4[3]};
    __syncthreads();
    LAS float* inv = scr + 64 * 33;
    if (lane < 32) { float am = 0.f;
#pragma unroll
        for (int w = 0; w < 8; ++w) am = fmaxf(am, amx[w * 32 + lane]);
        inv[lane] = am > 0.f ? QMAX / am : 0.f; if (wave == 0) sb[drow0 + lane] = am > 0.f ? am * (1.0f / QMAX) : 1.0f; }
    asm volatile("s_waitcnt lgkmcnt(0)" ::: "memory");
#pragma unroll
    for (int b = 0; b < NB; ++b) { const int kb = NB * wave + b;
#pragma unroll
        for (int i = 0; i < 8; ++i) { const int idx = lane + 64 * i; LAS float* d = scr + (idx >> 3) * 33 + 4 * (idx & 7); d[0] = t[b][i][0]; d[1] = t[b][i][1]; d[2] = t[b][i][2]; d[3] = t[b][i][3]; }
        asm volatile("s_waitcnt lgkmcnt(0)" ::: "memory");
#pragma unroll
        for (int j = 0; j < 2; ++j) { const int p = lane + 64 * j; const int n = p >> 2, c = p & 3; const float iv = inv[n]; const LAS float* sp = scr + (16 * c) * 33 + n; unsigned w[4];
#pragma unroll
            for (int q = 0; q < 4; ++q) {
                if constexpr (F8) { int pk = 0; pk = __builtin_amdgcn_cvt_pk_fp8_f32(sp[(4 * q) * 33] * iv, sp[(4 * q + 1) * 33] * iv, pk, false); pk = __builtin_amdgcn_cvt_pk_fp8_f32(sp[(4 * q + 2) * 33] * iv, sp[(4 * q + 3) * 33] * iv, pk, true); w[q] = (unsigned)pk; }
                else { unsigned pk = 0u;
#pragma unroll
                    for (int e = 0; e < 4; ++e) { const int qi = (int)__builtin_rintf(sp[(4 * q + e) * 33] * iv); pk |= ((unsigned)qi & 0xffu) << (8 * e); }
                    w[q] = pk; } }
            GAS char* db = (GAS char*)W8 + (size_t)(kb >> kbsh) * estride + (size_t)(drow0 + 16 * j) * rowlen + 64 * (kb & kmask);
            *(GAS u32x4*)(db + (unsigned)((lane >> 2) * rowlen + 16 * c)) = (u32x4){w[0], w[1], w[2], w[3]}; }
        asm volatile("s_waitcnt lgkmcnt(0)" ::: "memory"); }
}
DI void p0_prologue(Frame& F) {
    unsigned char* const ws = KWS;
    const int gw = blockIdx.x * NWAVES + F.wave, NGW = F.G * NWAVES;
    const int gtid = blockIdx.x * 512 + F.tid, NT = F.G * 512;
    {
        LAS float* scr = (LAS float*)(F.lds + F.wave * 16384);
        constexpr int I_O = 16 * 32, I_D = 8 * 32;
        constexpr int S_QKV = 2 * 48, S_IN = 2 * 96, S_GO = 2 * 32, S_AO = 2 * 32, S_GU = 64 * 32, N_STRIPS = S_QKV + S_IN + S_GO + S_AO + S_GU;
        { int cnt = 0;
          for (int it = blockIdx.x; it < 512 + N_STRIPS; it += F.G, ++cnt) { const int par = cnt & 1;
            if (it < 512) { const int lg = it >> 5, nb = it & 31;
                wstrip_blk<true, 4>(F.lds, F.wave, F.lane, KIN(I_MD) + (size_t)lg * 4 * 512 * 1024, 1024, 3, (size_t)1024 * 512, 512, (signed char*)(ws + WS_WD) + (size_t)lg * 4 * 1024 * 512, 32 * nb, 32 * nb, (float*)(ws + WS_SBD) + lg * 1024, par); continue; }
            int r = it - 512;
            if (r < S_QKV) { const int j = r / 48, nb = r % 48; wstrip_blk<false, 2>(F.lds, F.wave, F.lane, KIN(I_WQKV) + (size_t)j * 1024 * NQKV, NQKV, 4, 0, 1024, (signed char*)(ws + WS_WQKV) + (size_t)j * NQKV * 1024, 32 * nb, 32 * nb, (float*)(ws + WS_SBQKV) + j * NQKV, par); continue; } r -= S_QKV;
            if (r < S_IN) { const int j = r / 96, nb = r % 96; wstrip_blk<false, 2>(F.lds, F.wave, F.lane, KIN(I_GWIN) + (size_t)j * 1024 * 3072, 3072, 4, 0, 1024, (signed char*)(ws + WS_WIN) + (size_t)j * NGIN * 1024, 32 * nb, 32 * nb, (float*)(ws + WS_SBIN) + j * NGIN, par); continue; } r -= S_IN;
            if (r < S_GO) { const int j = r / 32, nb = r % 32; wstrip_blk<false, 2>(F.lds, F.wave, F.lane, KIN(I_GWO) + (size_t)j * 1024 * 1024, 1024, 4, 0, 1024, (signed char*)(ws + WS_WGO) + (size_t)j * 1024 * 1024, 32 * nb, 32 * nb, (float*)(ws + WS_SBGO) + j * 1024, par); continue; } r -= S_GO;
            if (r < S_AO) { const int j = r / 32, nb = r % 32; wstrip_blk<true, 2>(F.lds, F.wave, F.lane, KIN(I_WO) + (size_t)j * 1024 * 1024, 1024, 4, 0, 1024, (signed char*)(ws + WS_WO) + (size_t)j * 1024 * 1024, 32 * nb, 32 * nb, (float*)(ws + WS_SBO) + j * 1024, par); continue; } r -= S_AO;
            { const int le = r >> 5, q = r & 31, up = q >> 4, nb = q & 15; const int n0 = 32 * nb;
              wstrip_blk<false, 2>(F.lds, F.wave, F.lane, (up ? KIN(I_MU) : KIN(I_MG)) + (size_t)le * 1024 * 512, 512, 4, 0, 1024, (signed char*)(ws + WS_WGU) + (size_t)le * 1024 * 1024, n0, (n0 >> 7) * 256 + up * 128 + (n0 & 127), (float*)(ws + WS_SBGU) + le * 1024, par); } } }
        { const float* wa1 = KIN(I_GWA1); signed char* Win8 = (signed char*)(ws + WS_WIN); float* sbin = (float*)(ws + WS_SBIN);
          for (int rw = gw; rw < 2 * 256; rw += NGW) { const int j = rw >> 8, rr = rw & 255; float v[16]; float am = 0.f;
#pragma unroll
              for (int e = 0; e < 16; ++e) { v[e] = rr < 32 ? wa1[(((size_t)j * 2 + (rr >> 4)) * 1024 + 16 * F.lane + e) * 16 + (rr & 15)] : 0.f; am = fmaxf(am, fabsf(v[e])); }
#pragma unroll
              for (int o = 1; o < 64; o <<= 1) am = fmaxf(am, shx(am, o, F.lane));
              const float iv = am > 0.f ? 127.0f / am : 0.f; unsigned w[4];
#pragma unroll
              for (int q = 0; q < 4; ++q) { unsigned pk = 0u;
#pragma unroll
                  for (int e = 0; e < 4; ++e) { const int qi = (int)__builtin_rintf(v[4 * q + e] * iv); pk |= ((unsigned)qi & 0xffu) << (8 * e); }
                  w[q] = pk; }
              *(u32x4*)(Win8 + ((size_t)j * NGIN + 3072 + rr) * 1024 + 16 * F.lane) = (u32x4){w[0], w[1], w[2], w[3]};
              if (F.lane == 0) sbin[j * NGIN + 3072 + rr] = am > 0.f ? am * (1.0f / 127.0f) : 1.0f; } }
    }
    __syncthreads();
    {
        LAS float* sl = (LAS float*)F.lds;
        LAS float* red = (LAS float*)(F.lds + 40960);
        float* modp = ((float*)(ws + WS_MOD));
        const int kq = F.wave & 3, chh = F.wave >> 2;
        for (int it = blockIdx.x; it < 4 * 48; it += F.G) {
            const int l = it / 48, n0 = (it % 48) * 128;
            const float* W = KIN(I_ADAW) + (size_t)l * 1024 * 6144 + n0 + 64 * chh + F.lane; const float* cin = KIN(I_C); const float* ccin = KIN(I_CCTX); const float* adab = KIN(I_ADAB);
            float acc[33];
#pragma unroll
            for (int i = 0; i < 33; ++i) acc[i] = 0.f;
            for (int kc = 0; kc < 4; ++kc) {
                __syncthreads();
                for (int idx = F.tid; idx < 33 * 256; idx += 512) { const int mb = idx >> 8, k = idx & 255; const float cv = mb < 32 ? cin[mb * 1024 + kc * 256 + k] : ccin[kc * 256 + k]; sl[k * 36 + mb] = siluf_(cv); }
                __syncthreads();
                for (int kk0 = 0; kk0 < 64; kk0 += 16) { float wv[16];
#pragma unroll
                    for (int i = 0; i < 16; ++i) wv[i] = W[(size_t)(kc * 256 + kq * 64 + kk0 + i) * 6144];
#pragma unroll
                    for (int i = 0; i < 16; ++i) { const int k = kq * 64 + kk0 + i; const LAS f32x4* sp = (const LAS f32x4*)(sl + k * 36);
#pragma unroll
                        for (int q = 0; q < 8; ++q) { const f32x4 s4 = sp[q]; acc[4 * q] += s4[0] * wv[i]; acc[4 * q + 1] += s4[1] * wv[i]; acc[4 * q + 2] += s4[2] * wv[i]; acc[4 * q + 3] += s4[3] * wv[i]; }
                        acc[32] += sl[k * 36 + 32] * wv[i]; } }
            }
#pragma unroll
            for (int i = 0; i < 33; ++i) red[(kq * 33 + i) * 128 + 64 * chh + F.lane] = acc[i];
            __syncthreads();
            for (int idx = F.tid; idx < 33 * 128; idx += 512) { const int mb = idx >> 7, nn = idx & 127; float sm = 0.f;
#pragma unroll
                for (int q = 0; q < 4; ++q) sm += red[(q * 33 + mb) * 128 + nn];
                modp[((size_t)l * 33 + mb) * 6144 + n0 + nn] = sm + adab[l * 6144 + n0 + nn]; }
            __syncthreads();
        }
    }
    if (blockIdx.x == 0) { float* ropep = ((float*)(ws + WS_ROPE)); for (int idx = F.tid; idx < 64 * 16; idx += 512) { const int pos = idx >> 4, j = idx & 15;
        const float inv = __builtin_amdgcn_exp2f(-(float)j * 0.8304820237218406f); const float ang = (float)pos * inv;
        const float kq = rintf(ang * 0.15915494309189535f); float r = fmaf(-kq, 6.28318548202514648f, ang); r = fmaf(-kq, -1.7484556000744883e-7f, r);
        ropep[pos * 32 + j] = cosf(r); ropep[pos * 32 + 16 + j] = sinf(r); } }
}

DI int moe_table(Frame& F, int layer) {
    LAS int* bs = (LAS int*)(F.lds + MOE_TAB_OFF); LAS int* cnt = bs + 32;
    __syncthreads();
    if (F.tid < NCLS) cnt[F.tid] = (int)__hip_atomic_load((unsigned*)KWS + CW_MOE + 32 * layer + F.tid, __ATOMIC_RELAXED, __HIP_MEMORY_SCOPE_AGENT);
    __syncthreads();
    if (F.tid == 0) { int a = 0; for (int k = 0; k < NCLS; ++k) { bs[k] = a; a += (cnt[k] + 255) >> 8; } bs[NCLS] = a; }
    __syncthreads();
    return __builtin_amdgcn_readfirstlane(bs[NCLS]);
}
DI void unpack16(const u32x4& a, const u32x4& b, float (&v)[16]) {
    v[0] = bf_lo(a.x); v[1] = bf_hi(a.x); v[2] = bf_lo(a.y); v[3] = bf_hi(a.y); v[4] = bf_lo(a.z); v[5] = bf_hi(a.z); v[6] = bf_lo(a.w); v[7] = bf_hi(a.w);
    v[8] = bf_lo(b.x); v[9] = bf_hi(b.x); v[10] = bf_lo(b.y); v[11] = bf_hi(b.y); v[12] = bf_lo(b.z); v[13] = bf_hi(b.z); v[14] = bf_lo(b.w); v[15] = bf_hi(b.w);
}
DI void unpack16_f8(unsigned a0, unsigned a1, unsigned b0, unsigned b1, float (&v)[16]) {
    f32x2 t;
    t = __builtin_amdgcn_cvt_pk_f32_fp8((int)a0, false); v[0] = t.x; v[1] = t.y; t = __builtin_amdgcn_cvt_pk_f32_fp8((int)a0, true); v[2] = t.x; v[3] = t.y;
    t = __builtin_amdgcn_cvt_pk_f32_fp8((int)a1, false); v[4] = t.x; v[5] = t.y; t = __builtin_amdgcn_cvt_pk_f32_fp8((int)a1, true); v[6] = t.x; v[7] = t.y;
    t = __builtin_amdgcn_cvt_pk_f32_fp8((int)b0, false); v[8] = t.x; v[9] = t.y; t = __builtin_amdgcn_cvt_pk_f32_fp8((int)b0, true); v[10] = t.x; v[11] = t.y;
    t = __builtin_amdgcn_cvt_pk_f32_fp8((int)b1, false); v[12] = t.x; v[13] = t.y; t = __builtin_amdgcn_cvt_pk_f32_fp8((int)b1, true); v[14] = t.x; v[15] = t.y;
}
DI void pack16(const float (&v)[16], u32x4& a, u32x4& b) {
    a.x = cvt_pk_bf16(v[0], v[1]); a.y = cvt_pk_bf16(v[2], v[3]); a.z = cvt_pk_bf16(v[4], v[5]); a.w = cvt_pk_bf16(v[6], v[7]);
    b.x = cvt_pk_bf16(v[8], v[9]); b.y = cvt_pk_bf16(v[10], v[11]); b.z = cvt_pk_bf16(v[12], v[13]); b.w = cvt_pk_bf16(v[14], v[15]);
}
DI float quant_row_i8(const float (&v)[16], signed char* dst_row, int c0, int lane) {
    float am = 0.f;
#pragma unroll
    for (int e = 0; e < 16; ++e) am = fmaxf(am, fabsf(v[e]));
    am = wave_max(am, lane);
    const float inv = am > 0.f ? 127.0f / am : 0.f;
    unsigned w[4];
#pragma unroll
    for (int q = 0; q < 4; ++q) { unsigned p = 0u;
#pragma unroll
        for (int e = 0; e < 4; ++e) { const int qi = (int)__builtin_rintf(v[4 * q + e] * inv); p |= ((unsigned)qi & 0xffu) << (8 * e); }
        w[q] = p; }
    *(u32x2*)(dst_row + c0) = (u32x2){w[0], w[1]}; *(u32x2*)(dst_row + 512 + c0) = (u32x2){w[2], w[3]};
    return am * (1.0f / 127.0f);
}
template <bool ROUTER>
DI void norm_phase(Frame& F, int layer) {
    unsigned char* const ws = KWS;
    const float* gain = (ROUTER ? KIN(I_NFFN) : KIN(I_NMIX)) + layer * 1024;
    const float* modl = (const float*)(ws + WS_MOD) + (size_t)layer * 33 * 6144 + (ROUTER ? 3 * 1024 : 0);
    const float* gatel = ROUTER ? (const float*)(ws + WS_MOD) + (size_t)layer * 33 * 6144 + 2 * 1024 : (const float*)(ws + WS_MOD) + (size_t)(layer > 0 ? layer - 1 : 0) * 33 * 6144 + 5 * 1024;
    const int ymode = ROUTER ? 1 : (layer > 0 ? 2 : 0);
    const bool src32 = !ROUTER && layer == 0;
    bf16_t* XRp = (bf16_t*)(ws + WS_XR); bf16_t* Hp = (bf16_t*)(ws + WS_H);
    const unsigned char* Yp = ROUTER ? (const unsigned char*)(ws + WS_H) : (const unsigned char*)(ws + WS_R3);
    const int* tokpos = (const int*)(ws + WS_TOKPOS);
    const float* xin = nullptr; const float* cxin = nullptr;
    if (!ROUTER) { xin = KIN(I_X); cxin = KIN(I_CTX); if (ymode == 2) (void)moe_table(F, layer - 1); }
    const LAS int* bs = (const LAS int*)(F.lds + MOE_TAB_OFF);
    const int NROWS = (ROUTER && layer == DEPTH - 1) ? NL : MT;
    const int RPB = (NROWS + F.G - 1) / F.G, RPW = (RPB + 7) / 8;
    const int brow0 = blockIdx.x * RPB; int bend = brow0 + RPB; if (bend > NROWS) bend = NROWS;
    const int row0 = brow0 + F.wave * RPW; int rend = row0 + RPW; if (rend > bend) rend = bend;
    LAS float* RW = (LAS float*)F.lds;
    LAS float* WL = (LAS float*)(F.lds + 67584) + F.wave * 64;
    LAS int* lcnt = (LAS int*)(F.lds + 69632); LAS int* lbase = (LAS int*)(F.lds + 69760);
    LAS int* rec = (LAS int*)(F.lds + 69888); LAS f32x2* recg = (LAS f32x2*)(F.lds + 73984);
    float rb[16];
    if (ROUTER) {
        const float* rwp = KIN(I_RW); const float* rbp = KIN(I_RB);
        for (int idx = F.tid; idx < 1024 * 16; idx += 512) { const int col = idx >> 4, e = idx & 15; RW[(col >> 3) * 132 + (col & 7) * 16 + e] = rwp[idx]; }
        if (F.tid < 32) lcnt[F.tid] = 0;
#pragma unroll
        for (int e = 0; e < 16; ++e) rb[e] = rbp[e];
        __syncthreads();
    }
    float gs[16], sh[16], gy[16]; int mb = -1;
    const int c0 = 8 * F.lane;
    constexpr int NBR = ROUTER ? 2 : 4;
    u32x4 xa[NBR], xb[NBR], ya[NBR], yb[NBR]; f32x4 xs[NBR][4];
    u32x4 nxa[NBR], nxb[NBR], nya[NBR], nyb[NBR]; f32x4 nxs[NBR][4];
#define NORM_LOAD(XA, XB, YA, YB, XS, rowb_) do { _Pragma("unroll") for (int u = 0; u < NBR; ++u) { const int rr = (rowb_) + u < rend ? (rowb_) + u : rend - 1; \
            if (!ROUTER && src32) { const float* src = rr < NL ? xin + (size_t)rr * 1024 : cxin + (size_t)(rr - NL) * 1024; \
                XS[u][0] = *(const f32x4*)(src + c0); XS[u][1] = *(const f32x4*)(src + c0 + 4); XS[u][2] = *(const f32x4*)(src + 512 + c0); XS[u][3] = *(const f32x4*)(src + 512 + c0 + 4); } \
            else { const bf16_t* xr = XRp + (size_t)rr * 1024; XA[u] = *(const u32x4*)(xr + c0); XB[u] = *(const u32x4*)(xr + 512 + c0); } \
            if (ymode) { size_t yrow = (size_t)rr; if (!ROUTER) { const int tp = tokpos[rr]; yrow = (size_t)bs[tp & 0xff] * 256 + (size_t)(tp >> 8); } \
                const unsigned char* yr = Yp + yrow * 1024; const u32x2 ta_ = *(const u32x2*)(yr + c0), tb_ = *(const u32x2*)(yr + 512 + c0); YA[u].x = ta_.x; YA[u].y = ta_.y; YB[u].x = tb_.x; YB[u].y = tb_.y; } } } while (0)
    constexpr bool PF = ROUTER;
    if (PF) { if (row0 < rend) NORM_LOAD(xa, xb, ya, yb, xs, row0); }
    for (int rowb = row0; rowb < rend; rowb += NBR) {
        if (PF) { if (rowb + NBR < rend) NORM_LOAD(nxa, nxb, nya, nyb, nxs, rowb + NBR); } else NORM_LOAD(xa, xb, ya, yb, xs, rowb);
#pragma unroll
        for (int up = 0; up < NBR; up += 2) {
        float vv[2][16];
#pragma unroll
        for (int u2 = 0; u2 < 2; ++u2) { const int u = up + u2; const int row = rowb + u; float (&v)[16] = vv[u2];
        if (row < rend) {
        const int mbn = row < NL ? (row >> 11) : 32;
        if (mbn != mb) { mb = mbn; const float* mp = modl + (size_t)mb * 6144; const float* gp = gatel + (size_t)mb * 6144;
#pragma unroll
            for (int hh = 0; hh < 2; ++hh)
#pragma unroll
                for (int q = 0; q < 2; ++q) { const int cc = hh * 512 + c0 + 4 * q; const f32x4 g4 = *(const f32x4*)(gain + cc), s4 = *(const f32x4*)(mp + 1024 + cc), h4 = *(const f32x4*)(mp + cc), y4 = *(const f32x4*)(gp + cc);
#pragma unroll
                    for (int e = 0; e < 4; ++e) { gs[hh * 8 + q * 4 + e] = g4[e] * (1.0f + s4[e]); sh[hh * 8 + q * 4 + e] = h4[e]; gy[hh * 8 + q * 4 + e] = y4[e] * (1.0f / Y_SCALE); } } }
        if (!ROUTER && src32) {
#pragma unroll
            for (int q = 0; q < 4; ++q)
#pragma unroll
                for (int e = 0; e < 4; ++e) v[4 * q + e] = xs[u][q][e]; }
        else unpack16(xa[u], xb[u], v);
        if (ymode) { float yv[16]; unpack16_f8(ya[u].x, ya[u].y, yb[u].x, yb[u].y, yv);
#pragma unroll
            for (int e = 0; e < 16; ++e) v[e] += gy[e] * yv[e]; }
        if (ymode || src32) { u32x4 wa, wb; pack16(v, wa, wb); bf16_t* xw = XRp + (size_t)row * 1024; *(u32x4*)(xw + c0) = wa; *(u32x4*)(xw + 512 + c0) = wb; }
        float ss = 0.f;
#pragma unroll
        for (int e = 0; e < 16; ++e) ss += v[e] * v[e];
        ss = wave_sum(ss, F.lane);
        const float rstd = 1.0f / sqrtf(ss * (1.0f / 1024.0f) + RMS_EPS);
#pragma unroll
        for (int e = 0; e < 16; ++e) v[e] = v[e] * rstd * gs[e] + sh[e];
        if (ROUTER) { u32x4 oa, ob; pack16(v, oa, ob); bf16_t* hr = Hp + (size_t)row * 1024; *(u32x4*)(hr + c0) = oa; *(u32x4*)(hr + 512 + c0) = ob; }
        else { const float sc_ = quant_row_i8(v, (signed char*)Hp + (size_t)row * 1024, c0, F.lane); if (F.lane == 0) ((float*)(ws + WS_SA))[row] = sc_; }
        } else {
#pragma unroll
            for (int e = 0; e < 16; ++e) v[e] = 0.f; }
        }
        if (ROUTER) {
            float pl[2][16];
#pragma unroll
            for (int u = 0; u < 2; ++u)
#pragma unroll
                for (int e = 0; e < 16; ++e) pl[u][e] = 0.f;
#pragma unroll
            for (int jj = 0; jj < 16; ++jj) { const LAS f32x4* wp = (const LAS f32x4*)(RW + ((jj >> 3) * 64 + F.lane) * 132 + (jj & 7) * 16);
#pragma unroll
                for (int q = 0; q < 4; ++q) { const f32x4 w4 = wp[q];
#pragma unroll
                    for (int u = 0; u < 2; ++u) { const float x = vv[u][jj]; pl[u][4 * q] += x * w4[0]; pl[u][4 * q + 1] += x * w4[1]; pl[u][4 * q + 2] += x * w4[2]; pl[u][4 * q + 3] += x * w4[3]; } } }
#pragma unroll
            for (int u = 0; u < 2; ++u) {
                float v8[8], v4[4], v2[2], v1;
                { const bool bt = (F.lane >> 5) & 1;
#pragma unroll
                  for (int i = 0; i < 8; ++i) { const float mine = bt ? pl[u][8 + i] : pl[u][i], theirs = bt ? pl[u][i] : pl[u][8 + i]; v8[i] = mine + shx(theirs, 32, F.lane); } }
                { const bool bt = (F.lane >> 4) & 1;
#pragma unroll
                  for (int i = 0; i < 4; ++i) { const float mine = bt ? v8[4 + i] : v8[i], theirs = bt ? v8[i] : v8[4 + i]; v4[i] = mine + shx(theirs, 16, F.lane); } }
                { const bool bt = (F.lane >> 3) & 1;
#pragma unroll
                  for (int i = 0; i < 2; ++i) { const float mine = bt ? v4[2 + i] : v4[i], theirs = bt ? v4[i] : v4[2 + i]; v2[i] = mine + shx(theirs, 8, F.lane); } }
                { const bool bt = (F.lane >> 2) & 1; const float mine = bt ? v2[1] : v2[0], theirs = bt ? v2[0] : v2[1]; v1 = mine + shx(theirs, 4, F.lane); }
                v1 += shx(v1, 2, F.lane); v1 += shx(v1, 1, F.lane);
                { const int ei = ((F.lane >> 5) & 1) * 8 + ((F.lane >> 4) & 1) * 4 + ((F.lane >> 3) & 1) * 2 + ((F.lane >> 2) & 1); WL[(F.lane & 3) == 0 ? u * 16 + ei : 32 + (F.lane >> 1)] = v1; }
            }
            asm volatile("s_waitcnt lgkmcnt(0)" ::: "memory");
            const int ur = F.lane & 1;
            float sc[16], sel[16];
#pragma unroll
            for (int q = 0; q < 4; ++q) { const f32x4 l4 = ((const LAS f32x4*)(WL + ur * 16))[q];
#pragma unroll
                for (int e = 0; e < 4; ++e) { sc[4 * q + e] = sigmoidf_(l4[e]); sel[4 * q + e] = sc[4 * q + e] + rb[4 * q + e]; } }
            asm volatile("s_waitcnt lgkmcnt(0)" ::: "memory");
            int grp = 0; float best = -1e30f;
#pragma unroll
            for (int g = 0; g < 4; ++g) { const float a = sel[4 * g], b = sel[4 * g + 1], c = sel[4 * g + 2], d = sel[4 * g + 3];
                const float m1 = fmaxf(fmaxf(a, b), fmaxf(c, d)); const float lo1 = fminf(a, b), hi1 = fmaxf(a, b), lo2 = fminf(c, d), hi2 = fmaxf(c, d);
                const float m2 = fmaxf(fminf(hi1, hi2), fmaxf(lo1, lo2)); const float gsum = m1 + m2;
                if (gsum > best) { best = gsum; grp = g; } }
            float s4[4], c4[4];
#pragma unroll
            for (int e = 0; e < 4; ++e) { s4[e] = grp == 0 ? sel[e] : (grp == 1 ? sel[4 + e] : (grp == 2 ? sel[8 + e] : sel[12 + e])); c4[e] = grp == 0 ? sc[e] : (grp == 1 ? sc[4 + e] : (grp == 2 ? sc[8 + e] : sc[12 + e])); }
            int i1 = 0; float b1 = s4[0];
#pragma unroll
            for (int e = 1; e < 4; ++e) if (s4[e] > b1) { b1 = s4[e]; i1 = e; }
            int i2 = -1; float b2 = -1e30f;
#pragma unroll
            for (int e = 0; e < 4; ++e) if (e != i1 && s4[e] > b2) { b2 = s4[e]; i2 = e; }
            const float g1 = i1 == 0 ? c4[0] : (i1 == 1 ? c4[1] : (i1 == 2 ? c4[2] : c4[3])), g2 = i2 == 0 ? c4[0] : (i2 == 1 ? c4[1] : (i2 == 2 ? c4[2] : c4[3]));
            const float inv = 1.0f / (g1 + g2);
            const int lo = i1 < i2 ? i1 : i2, hi = i1 < i2 ? i2 : i1;
            const int pidx = lo == 0 ? hi - 1 : (lo == 1 ? hi + 1 : 5);
            const int cls = grp * 6 + pidx;
            const float glo = (i1 < i2 ? g1 : g2) * inv, ghi = (i1 < i2 ? g2 : g1) * inv;
            if (F.lane < 2 && rowb + up + F.lane < rend) { const int sl_ = __hip_atomic_fetch_add(lcnt + cls, 1, __ATOMIC_RELAXED, __HIP_MEMORY_SCOPE_WORKGROUP); const int rbi = rowb + up + F.lane - brow0; rec[rbi] = cls | (sl_ << 8); recg[rbi] = (f32x2){glo, ghi}; }
        }
        }
        if (PF) {
#pragma unroll
            for (int u = 0; u < NBR; ++u) { xa[u] = nxa[u]; xb[u] = nxb[u]; ya[u] = nya[u]; yb[u] = nyb[u]; } }
    }
#undef NORM_LOAD
    if (ROUTER) {
        __syncthreads();
        if (F.tid < NCLS) { const int n = lcnt[F.tid]; int base = 0; if (n > 0) base = (int)__hip_atomic_fetch_add((unsigned*)ws + CW_MOE + 32 * layer + F.tid, (unsigned)n, __ATOMIC_RELAXED, __HIP_MEMORY_SCOPE_AGENT); lbase[F.tid] = base; }
        __syncthreads();
        int* listp = (int*)(ws + WS_LIST); f32x2* glistp = (f32x2*)(ws + WS_GLIST); int* tpw = (int*)(ws + WS_TOKPOS);
        for (int rbi = F.tid; rbi < bend - brow0; rbi += 512) { const int rc = rec[rbi]; const int cls = rc & 0xff; const int slot = lbase[cls] + (rc >> 8);
            listp[(size_t)cls * MT + slot] = brow0 + rbi; glistp[(size_t)cls * MT + slot] = recg[rbi]; tpw[brow0 + rbi] = cls | (slot << 8); }
        __syncthreads();
    }
}

DI void route_decide(const float (&lg)[16], const float (&rb)[16], int& cls, float& glo, float& ghi) {
    float sc[16], sel[16];
#pragma unroll
    for (int e = 0; e < 16; ++e) { sc[e] = sigmoidf_(lg[e]); sel[e] = sc[e] + rb[e]; }
    int grp = 0; float best = -1e30f;
#pragma unroll
    for (int g = 0; g < 4; ++g) { const float a = sel[4 * g], b = sel[4 * g + 1], c = sel[4 * g + 2], d = sel[4 * g + 3];
        const float m1 = fmaxf(fmaxf(a, b), fmaxf(c, d)); const float lo1 = fminf(a, b), hi1 = fmaxf(a, b), lo2 = fminf(c, d), hi2 = fmaxf(c, d);
        const float m2 = fmaxf(fminf(hi1, hi2), fmaxf(lo1, lo2)); const float gsum = m1 + m2;
        if (gsum > best) { best = gsum; grp = g; } }
    float s4[4], c4[4];
#pragma unroll
    for (int e = 0; e < 4; ++e) { s4[e] = grp == 0 ? sel[e] : (grp == 1 ? sel[4 + e] : (grp == 2 ? sel[8 + e] : sel[12 + e])); c4[e] = grp == 0 ? sc[e] : (grp == 1 ? sc[4 + e] : (grp == 2 ? sc[8 + e] : sc[12 + e])); }
    int i1 = 0; float b1 = s4[0];
#pragma unroll
    for (int e = 1; e < 4; ++e) if (s4[e] > b1) { b1 = s4[e]; i1 = e; }
    int i2 = -1; float b2 = -1e30f;
#pragma unroll
    for (int e = 0; e < 4; ++e) if (e != i1 && s4[e] > b2) { b2 = s4[e]; i2 = e; }
    const float g1 = i1 == 0 ? c4[0] : (i1 == 1 ? c4[1] : (i1 == 2 ? c4[2] : c4[3])), g2 = i2 == 0 ? c4[0] : (i2 == 1 ? c4[1] : (i2 == 2 ? c4[2] : c4[3]));
    const float inv = 1.0f / (g1 + g2);
    const int lo = i1 < i2 ? i1 : i2, hi = i1 < i2 ? i2 : i1;
    const int pidx = lo == 0 ? hi - 1 : (lo == 1 ? hi + 1 : 5);
    cls = grp * 6 + pidx;
    glo = (i1 < i2 ? g1 : g2) * inv; ghi = (i1 < i2 ? g2 : g1) * inv;
}

DI void n2_phase(Frame& F, int layer) {
    unsigned char* const ws = KWS;
    const float* gain = KIN(I_NFFN) + layer * 1024;
    const float* modl = (const float*)(ws + WS_MOD) + (size_t)layer * 33 * 6144 + 3 * 1024;
    const float* gatel = (const float*)(ws + WS_MOD) + (size_t)layer * 33 * 6144 + 2 * 1024;
    bf16_t* XRp = (bf16_t*)(ws + WS_XR); const unsigned char* Hp = ws + WS_H;
    const int NROWS = (layer == DEPTH - 1) ? NL : MT;
    const int RPB = (NROWS + F.G - 1) / F.G;
    const int brow0 = blockIdx.x * RPB; int bend = brow0 + RPB; if (bend > NROWS) bend = NROWS;
    const int nsteps = (bend - brow0 + 15) >> 4;
    constexpr int AST = 2064;
    LAS unsigned char* AH = F.lds; LAS unsigned char* AL = F.lds + 16 * AST; LAS unsigned char* WH = F.lds + 32 * AST; LAS unsigned char* WLo = F.lds + 48 * AST;
    LAS float* PART = (LAS float*)(F.lds + 64 * AST);
    LAS float* RB = (LAS float*)(F.lds + 64 * AST + 16384);
    LAS int* lcnt = (LAS int*)(F.lds + 64 * AST + 16384 + 128); LAS int* lbase = lcnt + 32;
    LAS int* rec = lbase + 32; LAS f32x2* recg = (LAS f32x2*)(rec + 512); LAS float* rsa = (LAS float*)(recg + 512);
    static_assert(64 * AST + 16384 + 128 + 256 + 2048 + 4096 + 2048 <= PHASE_LDS, "N2 LDS map");
    { const float* rwp = KIN(I_RW); const float* rbp = KIN(I_RB);
      for (int idx = F.tid; idx < 1024 * 16; idx += 512) { const int k = idx >> 4, e = idx & 15; const float w = rwp[idx]; const unsigned hh = cvt_pk_bf16(w, 0.f) & 0xffffu; const unsigned ll = cvt_pk_bf16(w - bf_lo(hh), 0.f) & 0xffffu;
          *(LAS unsigned short*)(WH + e * AST + 2 * k) = (unsigned short)hh; *(LAS unsigned short*)(WLo + e * AST + 2 * k) = (unsigned short)ll; }
      if (F.tid < 16) RB[F.tid] = rbp[F.tid];
      if (F.tid < 32) lcnt[F.tid] = 0; }
    __syncthreads();
    float gs[16], sh[16], gy[16]; int mb = -1;
    const int c0 = 8 * F.lane;
    const int i16 = F.lane & 15, qd = F.lane >> 4;
    u32x4 xa[2], xb[2], ya[2], yb[2], nxa[2], nxb[2], nya[2], nyb[2];
#define N2_LOAD(XA, XB, YA, YB, st_) do { _Pragma("unroll") for (int u = 0; u < 2; ++u) { int rr = brow0 + 16 * (st_) + 2 * F.wave + u; rr = rr < bend ? rr : bend - 1; \
            const bf16_t* xr = XRp + (size_t)rr * 1024; XA[u] = *(const u32x4*)(xr + c0); XB[u] = *(const u32x4*)(xr + 512 + c0); \
            const unsigned char* yr = Hp + (size_t)rr * 1024; const u32x2 ta_ = *(const u32x2*)(yr + c0), tb_ = *(const u32x2*)(yr + 512 + c0); YA[u].x = ta_.x; YA[u].y = ta_.y; YB[u].x = tb_.x; YB[u].y = tb_.y; } } while (0)
    if (nsteps > 0) N2_LOAD(xa, xb, ya, yb, 0);
    for (int st = 0; st < nsteps; ++st) {
#pragma unroll
        for (int u = 0; u < 2; ++u) { const int t = 2 * F.wave + u; const int row = brow0 + 16 * st + t;
            u32x4 oa = (u32x4){0u, 0u, 0u, 0u}, ob = oa, la = oa, lb = oa;
            if (row < bend) {
                const int mbn = row < NL ? (row >> 11) : 32;
                if (mbn != mb) { mb = mbn; const float* mp = modl + (size_t)mb * 6144; const float* gp = gatel + (size_t)mb * 6144;
#pragma unroll
                    for (int hh = 0; hh < 2; ++hh)
#pragma unroll
                        for (int q = 0; q < 2; ++q) { const int cc = hh * 512 + c0 + 4 * q; const f32x4 g4 = *(const f32x4*)(gain + cc), s4 = *(const f32x4*)(mp + 1024 + cc), h4 = *(const f32x4*)(mp + cc), y4 = *(const f32x4*)(gp + cc);
#pragma unroll
                            for (int e = 0; e < 4; ++e) { gs[hh * 8 + q * 4 + e] = g4[e] * (1.0f + s4[e]); sh[hh * 8 + q * 4 + e] = h4[e]; gy[hh * 8 + q * 4 + e] = y4[e] * (1.0f / Y_SCALE); } } }
                float v[16], yv[16]; unpack16(xa[u], xb[u], v); unpack16_f8(ya[u].x, ya[u].y, yb[u].x, yb[u].y, yv);
#pragma unroll
                for (int e = 0; e < 16; ++e) v[e] += gy[e] * yv[e];
                { u32x4 wa, wb; pack16(v, wa, wb); bf16_t* xw = XRp + (size_t)row * 1024; *(u32x4*)(xw + c0) = wa; *(u32x4*)(xw + 512 + c0) = wb; }
                float ss = 0.f;
#pragma unroll
                for (int e = 0; e < 16; ++e) ss += v[e] * v[e];
                ss = wave_sum(ss, F.lane);
                const float rstd = 1.0f / sqrtf(ss * (1.0f / 1024.0f) + RMS_EPS);
#pragma unroll
                for (int e = 0; e < 16; ++e) v[e] = v[e] * rstd * gs[e] + sh[e];
                pack16(v, oa, ob);
                { const float sc_ = quant_row_i8(v, (signed char*)(ws + WS_R3) + (size_t)row * 1024, c0, F.lane); if (F.lane == 0) rsa[row - brow0] = sc_; }
                float lo[16]; { float hv[16]; unpack16(oa, ob, hv);
#pragma unroll
                    for (int e = 0; e < 16; ++e) lo[e] = v[e] - hv[e]; }
                pack16(lo, la, lb);
            }
            *(LAS u32x4*)(AH + t * AST + 2 * c0) = oa; *(LAS u32x4*)(AH + t * AST + 1024 + 2 * c0) = ob;
            *(LAS u32x4*)(AL + t * AST + 2 * c0) = la; *(LAS u32x4*)(AL + t * AST + 1024 + 2 * c0) = lb; }
        if (st + 1 < nsteps) N2_LOAD(nxa, nxb, nya, nyb, st + 1);
        __syncthreads();
        { f32x4 acc = (f32x4){0.f, 0.f, 0.f, 0.f};
#pragma unroll
          for (int kk = 0; kk < 4; ++kk) { const int ko = (32 * (4 * F.wave + kk) + 8 * qd) * 2;
              const bf16x8 wh = *(const LAS bf16x8*)(WH + i16 * AST + ko), wl = *(const LAS bf16x8*)(WLo + i16 * AST + ko), fh = *(const LAS bf16x8*)(AH + i16 * AST + ko), fl = *(const LAS bf16x8*)(AL + i16 * AST + ko);
              acc = MFMA16(wh, fh, acc); acc = MFMA16(wh, fl, acc); acc = MFMA16(wl, fh, acc); }
          *(LAS f32x4*)(PART + (((st & 1) * 8 + F.wave) * 16 + i16) * 16 + 4 * qd) = acc; }
        __syncthreads();
        if (F.wave == (st & 7)) {
            float lg[16], rb[16];
#pragma unroll
            for (int e = 0; e < 16; ++e) lg[e] = 0.f;
#pragma unroll
            for (int w = 0; w < 8; ++w)
#pragma unroll
                for (int q = 0; q < 4; ++q) { const f32x4 p4 = *(const LAS f32x4*)(PART + (((st & 1) * 8 + w) * 16 + i16) * 16 + 4 * q); lg[4 * q] += p4[0]; lg[4 * q + 1] += p4[1]; lg[4 * q + 2] += p4[2]; lg[4 * q + 3] += p4[3]; }
#pragma unroll
            for (int q = 0; q < 4; ++q) { const f32x4 r4 = ((const LAS f32x4*)RB)[q]; rb[4 * q] = r4[0]; rb[4 * q + 1] = r4[1]; rb[4 * q + 2] = r4[2]; rb[4 * q + 3] = r4[3]; }
            int cls; float glo, ghi; route_decide(lg, rb, cls, glo, ghi);
            const int rbi = 16 * st + F.lane;
            if (F.lane < 16 && brow0 + rbi < bend) { const int sl_ = __hip_atomic_fetch_add(lcnt + cls, 1, __ATOMIC_RELAXED, __HIP_MEMORY_SCOPE_WORKGROUP); rec[rbi] = cls | (sl_ << 8); recg[rbi] = (f32x2){glo, ghi}; }
        }
#pragma unroll
        for (int u = 0; u < 2; ++u) { xa[u] = nxa[u]; xb[u] = nxb[u]; ya[u] = nya[u]; yb[u] = nyb[u]; }
    }
#undef N2_LOAD
    __syncthreads();
    if (F.tid < NCLS) { const int n = lcnt[F.tid]; int base = 0; if (n > 0) base = (int)__hip_atomic_fetch_add((unsigned*)ws + CW_MOE + 32 * layer + F.tid, (unsigned)n, __ATOMIC_RELAXED, __HIP_MEMORY_SCOPE_AGENT); lbase[F.tid] = base; }
    __syncthreads();
    int* listp = (int*)(ws + WS_LIST); f32x2* glistp = (f32x2*)(ws + WS_GLIST); int* tpw = (int*)(ws + WS_TOKPOS); float* slistp = (float*)(ws + WS_SLIST);
    for (int rbi = F.tid; rbi < bend - brow0; rbi += 512) { const int rc = rec[rbi]; const int cls = rc & 0xff; const int slot = lbase[cls] + (rc >> 8);
        listp[(size_t)cls * MT + slot] = brow0 + rbi; glistp[(size_t)cls * MT + slot] = recg[rbi]; slistp[(size_t)cls * MT + slot] = rsa[rbi]; tpw[brow0 + rbi] = cls | (slot << 8); }
    __syncthreads();
}

DI void attn_phase(Frame& F, int j, unsigned long long& pacc) {
    unsigned char* const ws = KWS; const bf16_t* P = (const bf16_t*)(ws + WS_R2); unsigned char* O = ws + WS_R3; const float* sinks = KIN(I_SINKS);
    const int lane = F.lane, wave = F.wave, tid = F.tid, r32 = lane & 31, hi = lane >> 5;
    const int g = wave & 3, qh = wave >> 2;
    LAS unsigned char* KB = F.lds; LAS unsigned char* VB = F.lds + 2 * 18432;
    const int i16 = lane & 15, tq = i16 >> 2, tp = i16 & 3, blk = (lane >> 4) & 1;
    const int nunits = 2048 + 256;
#if PROBE_ATT
    unsigned long long atp_ = __builtin_amdgcn_s_memrealtime();
#define ATTT(k) do { const unsigned long long tn_ = __builtin_amdgcn_s_memrealtime(); if (PROBE_ATT == (k)) pacc += tn_ - atp_; atp_ = tn_; } while (0)
#else
#define ATTT(k) do { } while (0)
#endif
    struct AU { int b, kvh, s, qrow0, klo, nwin; };
#define ATT_DECODE(U, u_) do { const int uu_ = (u_); if (uu_ < 2048) { U.b = uu_ >> 6; U.kvh = (uu_ >> 4) & 3; U.s = (uu_ & 15) * 128; U.qrow0 = U.b * SEQ + U.s; U.klo = U.s - 128 < 0 ? 0 : U.s - 128; \
            const int khi_ = U.s + 256 > SEQ ? SEQ : U.s + 256; U.nwin = (khi_ - U.klo) >> 7; } \
        else { const int v_ = uu_ - 2048; U.b = v_ >> 3; U.kvh = (v_ >> 1) & 3; U.s = (v_ & 1) * 128; U.qrow0 = NL + U.b * CTX + U.s; U.klo = 0; U.nwin = 0; } } while (0)
#define ATT_CHROW(U, ch) ((ch) < U.nwin ? (U.b * SEQ + U.klo + 128 * (ch)) : (NL + U.b * CTX + 128 * ((ch) - U.nwin)))
#define ATT_LOAD(U, ch) do { const int cr_ = ATT_CHROW(U, ch); _Pragma("unroll") for (int i_ = 0; i_ < 2; ++i_) { const int p_ = tid + 512 * i_; const bf16_t* src_ = P + (size_t)(cr_ + (p_ >> 3)) * NQKV + 1024 + U.kvh * 64 + (p_ & 7) * 8; \
            kst[i_] = *(const u32x4*)src_; vst[i_] = *(const u32x4*)(src_ + 256); } } while (0)
#define ATT_STORE(bufi) do { _Pragma("unroll") for (int i_ = 0; i_ < 2; ++i_) { const int p_ = tid + 512 * i_; const int off_ = (bufi) * 18432 + (p_ >> 3) * 144 + (p_ & 7) * 16; \
            *(LAS u32x4*)(KB + off_) = kst[i_]; *(LAS u32x4*)(VB + off_) = vst[i_]; } } while (0)
#define ATT_LOADQ(U) do { _Pragma("unroll") for (int gr = 0; gr < 2; ++gr) { const bf16_t* qp = P + (size_t)(U.qrow0 + 64 * gr + 32 * qh + r32) * NQKV + (U.kvh * 4 + g) * 64 + 8 * hi; \
            _Pragma("unroll") for (int ks = 0; ks < 4; ++ks) qf[gr][ks] = *(const bf16x8*)(qp + 16 * ks); } } while (0)
    float sk4[4];
#pragma unroll
    for (int kk = 0; kk < 4; ++kk) sk4[kk] = sinks[j * 16 + kk * 4 + g] * LOG2E;
    u32x4 kst[2], vst[2]; bf16x8 qf[2][4];
    AU UC, UN;
    if ((int)blockIdx.x < nunits) { ATT_DECODE(UC, (int)blockIdx.x); ATT_LOAD(UC, 0); ATT_LOADQ(UC); }
    for (int u = blockIdx.x; u < nunits; u += F.G) {
        const bool has_next = u + F.G < nunits;
        if (has_next) ATT_DECODE(UN, u + F.G); else UN = UC;
        const int s = UC.s, qrow0 = UC.qrow0, klo = UC.klo, nwin = UC.nwin, nch = UC.nwin + 2, hq = UC.kvh * 4 + g;
        const float sink2 = UC.kvh == 0 ? sk4[0] : (UC.kvh == 1 ? sk4[1] : (UC.kvh == 2 ? sk4[2] : sk4[3]));
        float mrun[2], lrun[2]; f32x16 o[2][2];
#pragma unroll
        for (int gr = 0; gr < 2; ++gr) { mrun[gr] = sink2; lrun[gr] = hi == 0 ? 1.0f : 0.0f;
#pragma unroll
            for (int d0 = 0; d0 < 2; ++d0)
#pragma unroll
                for (int i = 0; i < 16; ++i) o[gr][d0][i] = 0.f; }
        __syncthreads();
        ATT_STORE(0);
        __syncthreads();
        ATTT(3);
        for (int ch = 0; ch < nch; ++ch) {
            const int buf = ch & 1;
            if (ch + 1 < nch) ATT_LOAD(UC, ch + 1); else if (has_next) ATT_LOAD(UN, 0);
            ATTT(2);
            const bool masked = ch < nwin; const int kpos0 = klo + 128 * ch;
            const LAS unsigned char* kb = KB + buf * 18432; const LAS unsigned char* vb = VB + buf * 18432;
#pragma unroll 1
            for (int kt = 0; kt < 4; ++kt) {
                int tmode[2] = {0, 0};
                if (masked) {
#pragma unroll
                    for (int gr = 0; gr < 2; ++gr) { const int q0 = s + 64 * gr + 32 * qh; const int dmin = q0 - (kpos0 + 32 * kt + 31), dmax = (q0 + 31) - (kpos0 + 32 * kt);
                        tmode[gr] = (dmax < -128 || dmin > 128) ? 2 : ((dmin >= -128 && dmax <= 128) ? 0 : 1); } }
                if (tmode[0] == 2 && tmode[1] == 2) continue;
                bf16x8 kf[4];
#pragma unroll
                for (int ks = 0; ks < 4; ++ks) kf[ks] = *(const LAS bf16x8*)(kb + (32 * kt + r32) * 144 + (16 * ks + 8 * hi) * 2);
                bf16x8 vf[2][2];
#pragma unroll
                for (int d0 = 0; d0 < 2; ++d0)
#pragma unroll
                    for (int s2 = 0; s2 < 2; ++s2) { const LAS unsigned char* vp = vb + (32 * kt + 16 * s2 + 4 * hi + tq) * 144 + (32 * d0 + 16 * blk + 4 * tp) * 2;
                        vf[d0][s2] = cat4(tr_read(vp), tr_read(vp + 8 * 144)); }
#pragma unroll
                for (int gr = 0; gr < 2; ++gr) { if (tmode[gr] == 2) continue;
                    const float nm = -mrun[gr]; const f32x2 nm2 = (f32x2){nm, nm};
                    f32x16 st = __builtin_shufflevector(nm2, nm2, 0, 1, 0, 1, 0, 1, 0, 1, 0, 1, 0, 1, 0, 1, 0, 1);
#pragma unroll
                    for (int ks = 0; ks < 4; ++ks) st = MFMA32(kf[ks], qf[gr][ks], st);
                    if (tmode[gr] == 1) { const int qpos = s + 64 * gr + 32 * qh + r32; const int kb0 = kpos0 + 32 * kt + 4 * hi;
#pragma unroll
                        for (int i = 0; i < 16; ++i) { const int dlt = qpos - (kb0 + (i & 3) + 8 * (i >> 2)); if (dlt > 128 || dlt < -128) st[i] = -1e30f; } }
                    float tmax = fmaxf(st[0], st[1]);
#pragma unroll
                    for (int i = 2; i < 16; i += 2) tmax = fmaxf(fmaxf(tmax, st[i]), st[i + 1]);
                    { auto rr = __builtin_amdgcn_permlane32_swap(__float_as_uint(tmax), __float_as_uint(tmax), false, false); tmax = fmaxf(__uint_as_float(rr[0]), __uint_as_float(rr[1])); }
                    if (__any(tmax > 8.0f)) { const float dl = fmaxf(tmax, 0.f); mrun[gr] += dl; const float alpha = __builtin_amdgcn_exp2f(-dl); lrun[gr] *= alpha;
#pragma unroll
                        for (int i = 0; i < 16; ++i) st[i] -= dl;
#pragma unroll
                        for (int d0 = 0; d0 < 2; ++d0)
#pragma unroll
                            for (int i = 0; i < 16; ++i) o[gr][d0][i] *= alpha; }
#pragma unroll
                    for (int i = 0; i < 16; ++i) st[i] = __builtin_amdgcn_exp2f(st[i]);
                    f32x2 ps2 = (f32x2){st[0], st[1]};
#pragma unroll
                    for (int i = 2; i < 16; i += 2) ps2 += (f32x2){st[i], st[i + 1]};
                    lrun[gr] += ps2.x + ps2.y;
                    const bf16x8 p0 = pack8(st, 0), p1 = pack8(st, 1);
#pragma unroll
                    for (int d0 = 0; d0 < 2; ++d0) { o[gr][d0] = MFMA32(vf[d0][0], p0, o[gr][d0]); o[gr][d0] = MFMA32(vf[d0][1], p1, o[gr][d0]); }
                }
            }
            ATTT(1);
            if (ch + 1 < nch) ATT_STORE(buf ^ 1);
            __syncthreads();
            ATTT(2);
        }
        if (has_next) ATT_LOADQ(UN);
        { LAS unsigned char* OW = F.lds + wave * 9216;
#pragma unroll
        for (int gr = 0; gr < 2; ++gr) { float lt; { auto rr = __builtin_amdgcn_permlane32_swap(__float_as_uint(lrun[gr]), __float_as_uint(lrun[gr]), false, false); lt = __uint_as_float(rr[0]) + __uint_as_float(rr[1]); } const float inv = ATT_O_SCALE / lt;
#pragma unroll
            for (int d0 = 0; d0 < 2; ++d0)
#pragma unroll
                for (int i4 = 0; i4 < 4; ++i4) { int w = 0; w = __builtin_amdgcn_cvt_pk_fp8_f32(__builtin_amdgcn_fmed3f(o[gr][d0][4 * i4] * inv, -448.f, 448.f), __builtin_amdgcn_fmed3f(o[gr][d0][4 * i4 + 1] * inv, -448.f, 448.f), w, false);
                    w = __builtin_amdgcn_cvt_pk_fp8_f32(__builtin_amdgcn_fmed3f(o[gr][d0][4 * i4 + 2] * inv, -448.f, 448.f), __builtin_amdgcn_fmed3f(o[gr][d0][4 * i4 + 3] * inv, -448.f, 448.f), w, true);
                    *(LAS int*)(OW + (32 * gr + r32) * 80 + (32 * d0 + 8 * i4 + 4 * hi)) = w; } }
        asm volatile("s_waitcnt lgkmcnt(0)" ::: "memory");
#pragma unroll
        for (int it = 0; it < 4; ++it) { const int idx = lane + 64 * it; const int qr = idx >> 2, pc = idx & 3; const u32x4 w = *(const LAS u32x4*)(OW + qr * 80 + pc * 16);
            *(u32x4*)(O + (size_t)(qrow0 + 64 * (qr >> 5) + 32 * qh + (qr & 31)) * 1024 + hq * 64 + pc * 16) = w; } }
        UC = UN;
    }
    ATTT(3);
#undef ATTT
#undef ATT_DECODE
#undef ATT_LOADQ
#undef ATT_CHROW
#undef ATT_LOAD
#undef ATT_STORE
}

DI void gla_phase(Frame& F, int j, unsigned long long& pacc) {
    unsigned char* const ws = KWS; const bf16_t* QK = (const bf16_t*)(ws + WS_R2); const bf16_t* GV = (const bf16_t*)(ws + WS_R3); bf16_t* const OBp = (bf16_t*)KOUT;
    const float* wa2g = KIN(I_GWA2); const float* bag = KIN(I_GBA); const float* rbuf = (const float*)(ws + WS_R);
    const int lane = F.lane, wave = F.wave, tid = F.tid, r32 = lane & 31, hi = lane >> 5;
    const int i16 = lane & 15, tq = i16 >> 2, tp = i16 & 3, blk = (lane >> 4) & 1;
    LAS unsigned char* QD = F.lds; LAS unsigned char* KD = F.lds + 17408; LAS unsigned char* KZ = F.lds + 34816; LAS unsigned char* VT = F.lds + 52224; LAS unsigned char* PT = F.lds + 86016;
    LAS float* RR = (LAS float*)(F.lds + 95232); LAS float* SEG = (LAS float*)(F.lds + 99328); LAS float* DEC = (LAS float*)(F.lds + 103424);
    LAS float* WA2 = (LAS float*)(F.lds + 103936); LAS float* BA = (LAS float*)(F.lds + 112128);
    LAS unsigned char* OTW = F.lds + 114688 + wave * 4096;
    LAS float* XT = (LAS float*)(F.lds + 114688);
    static_assert(114688 + 8 * 4096 <= PHASE_LDS, "scan LDS map");
    const int kp = tid & 63, seg = tid >> 6;
    for (int u = blockIdx.x; u < 256; u += F.G) {
        const int b = u >> 3, hd = (u >> 1) & 3, dir = u & 1;
        bf16_t* OUT = dir ? OBp : (bf16_t*)(ws + WS_H);
        __syncthreads();
        { int t2 = tid; asm volatile("" : "+v"(t2));
          for (int idx = t2; idx < 16 * 128; idx += 512) WA2[idx] = wa2g[(((size_t)j * 2 + dir) * 16 + (idx >> 7)) * 512 + hd * 128 + (idx & 127)];
          if (t2 < 128) BA[t2] = bag[((size_t)j * 2 + dir) * 512 + hd * 128 + t2] * (-LOG2E); }
        f32x16 S[4];
#pragma unroll
        for (int kb = 0; kb < 4; ++kb)
#pragma unroll
            for (int i = 0; i < 16; ++i) S[kb][i] = 0.f;
        __syncthreads();
        bf16x8 wfh;
        { u32x4 bh;
#pragma unroll
          for (int q = 0; q < 4; ++q) bh[q] = cvt_pk_bf16(WA2[(8 * hi + 2 * q) * 128 + 32 * (wave & 3) + r32] * (-LOG2E), WA2[(8 * hi + 2 * q + 1) * 128 + 32 * (wave & 3) + r32] * (-LOG2E));
          wfh = __builtin_bit_cast(bf16x8, bh); }
        u32x4 vreg[4]; f32x4 rreg = (f32x4){0.f, 0.f, 0.f, 0.f}; unsigned q2[8], k2[8];
        const int sgn = dir ? -1 : 1;
        const unsigned vlo = (unsigned)((dir ? 63 - (tid >> 5) : (tid >> 5)) * 2048 + (tid & 31) * 16);
        const unsigned rlo = (unsigned)((dir ? 63 - (tid >> 2) : (tid >> 2)) * 128 + (tid & 3) * 16);
        const unsigned qlo = (unsigned)(4 * kp);
        const unsigned olo = (unsigned)((dir ? 63 - (lane >> 2) : (lane >> 2)) * 2048 + (lane & 3) * 16);
#define GLA_TLOW(cj_) ((cj_) < 4 ? (NL + b * CTX + (dir ? 192 - 64 * (cj_) : 64 * (cj_))) : (b * SEQ + (dir ? 1984 - 64 * ((cj_) - 4) : 64 * ((cj_) - 4))))
#define GLA_FETCH_V(cj_) do { const int tl_ = GLA_TLOW(cj_); \
            _Pragma("unroll") for (int i_ = 0; i_ < 4; ++i_) { const char* ub_ = (const char*)GV + ((size_t)(tl_ + sgn * 16 * i_)) * 2048 + hd * 512; vreg[i_] = *(const u32x4*)(ub_ + vlo); } \
            if (tid < 256) { const char* ub_ = (const char*)rbuf + (size_t)tl_ * 128 + dir * 64; rreg = *(const f32x4*)(ub_ + rlo); } } while (0)
#define GLA_FETCH_QK(cj_) do { const int tl_ = GLA_TLOW(cj_); \
            _Pragma("unroll") for (int e_ = 0; e_ < 8; ++e_) { const int ro_ = dir ? 63 - (8 * seg + e_) : 8 * seg + e_; const char* ub_ = (const char*)QK + ((size_t)(tl_ + ro_)) * 2048 + hd * 256; \
                q2[e_] = *(const unsigned*)(ub_ + qlo); k2[e_] = *(const unsigned*)(ub_ + 1024 + qlo); } } while (0)
        GLA_FETCH_V(0); GLA_FETCH_QK(0);
#if PROBE_SCAN
        unsigned long long tprev_ = __builtin_amdgcn_s_memrealtime();
#define SCANT(k) do { const unsigned long long tn_ = __builtin_amdgcn_s_memrealtime(); if (PROBE_SCAN == (k)) pacc += tn_ - tprev_; tprev_ = tn_; } while (0)
#else
#define SCANT(k) do { } while (0)
#endif
        for (int cj = 0; cj < 36; ++cj) {
            const int tlow = GLA_TLOW(cj);
            LDS_BAR();
#pragma unroll
            for (int i = 0; i < 4; ++i) { const int p = tid + 512 * i; *(LAS u32x4*)(VT + (p >> 5) * 528 + (p & 31) * 16) = vreg[i]; }
            if (tid < 256) *(LAS f32x4*)(RR + (tid >> 2) * 16 + (tid & 3) * 4) = rreg;
            LDS_BAR();
            SCANT(1);
            { const LAS float* rp = RR + (32 * (wave >> 2) + r32) * 16 + 8 * hi; const f32x4 ra = *(const LAS f32x4*)rp, rb4 = *(const LAS f32x4*)(rp + 4);
              const float rv[8] = {ra[0], ra[1], ra[2], ra[3], rb4[0], rb4[1], rb4[2], rb4[3]};
              u32x4 ah, al;
#pragma unroll
              for (int q = 0; q < 4; ++q) { const unsigned hh2 = cvt_pk_bf16(rv[2 * q], rv[2 * q + 1]); ah[q] = hh2; al[q] = cvt_pk_bf16(rv[2 * q] - bf_lo(hh2), rv[2 * q + 1] - bf_hi(hh2)); }
              f32x16 xt;
#pragma unroll
              for (int i = 0; i < 16; ++i) xt[i] = 0.f;
              xt = MFMA32(__builtin_bit_cast(bf16x8, ah), wfh, xt); xt = MFMA32(__builtin_bit_cast(bf16x8, al), wfh, xt);
              LAS float* xo = XT + (32 * (wave >> 2) + 4 * hi) * 128 + 32 * (wave & 3) + r32;
#pragma unroll
              for (int i = 0; i < 16; ++i) xo[((i & 3) + 8 * (i >> 2)) * 128] = xt[i]; }
            LDS_BAR();
            float bl[8][2];
            { const f32x2 ba2 = *(const LAS f32x2*)(BA + 2 * kp);
              float run0 = 0.f, run1 = 0.f;
#pragma unroll
              for (int e = 0; e < 8; ++e) { const f32x2 x2 = *(const LAS f32x2*)(XT + (8 * seg + e) * 128 + 2 * kp); const float t0 = fminf(x2[0] + ba2[0], 100.f), t1 = fminf(x2[1] + ba2[1], 100.f);
                  run0 = __builtin_fmaf(__builtin_amdgcn_logf(1.0f + __builtin_amdgcn_exp2f(t0)), -0.0625f, run0); run1 = __builtin_fmaf(__builtin_amdgcn_logf(1.0f + __builtin_amdgcn_exp2f(t1)), -0.0625f, run1); bl[e][0] = run0; bl[e][1] = run1; }
              *(LAS f32x2*)(SEG + seg * 128 + 2 * kp) = (f32x2){run0, run1}; }
            LDS_BAR();
            SCANT(2);
            { float off0 = 0.f, off1 = 0.f, tot0 = 0.f, tot1 = 0.f;
#pragma unroll
              for (int s2 = 0; s2 < 8; ++s2) { const f32x2 t2 = *(const LAS f32x2*)(SEG + s2 * 128 + 2 * kp); tot0 += t2[0]; tot1 += t2[1]; }
#pragma unroll 1
              for (int s2 = 0; s2 < seg; ++s2) { const f32x2 t2 = *(const LAS f32x2*)(SEG + s2 * 128 + 2 * kp); off0 += t2[0]; off1 += t2[1]; }
              const float et0 = __builtin_amdgcn_exp2f(tot0), et1 = __builtin_amdgcn_exp2f(tot1);
              if (seg == 0) *(LAS f32x2*)(DEC + 2 * kp) = (f32x2){et0, et1};
#pragma unroll
              for (int e = 0; e < 8; ++e) { const float b0 = bl[e][0] + off0, b1 = bl[e][1] + off1; const float q0 = bf_lo(q2[e]), q1 = bf_hi(q2[e]), k0 = bf_lo(k2[e]), k1 = bf_hi(k2[e]);
                  const float e0 = __builtin_amdgcn_exp2f(b0), e1 = __builtin_amdgcn_exp2f(b1), n0 = __builtin_amdgcn_exp2f(fminf(-b0, 86.f)), n1 = __builtin_amdgcn_exp2f(fminf(-b1, 86.f)), z0 = et0 * n0, z1 = et1 * n1;
                  const int ro = (8 * seg + e) * 272 + 4 * kp;
                  *(LAS unsigned*)(QD + ro) = cvt_pk_bf16(q0 * e0, q1 * e1); *(LAS unsigned*)(KD + ro) = cvt_pk_bf16(k0 * n0, k1 * n1); *(LAS unsigned*)(KZ + ro) = cvt_pk_bf16(k0 * z0, k1 * z1); } }
            LDS_BAR();
            SCANT(3);
            if (cj + 1 < 36) GLA_FETCH_V(cj + 1);
            { const int ti = wave >> 1;
#pragma unroll
              for (int uu = 0; uu < 2; ++uu) { const int sj = 2 * (wave & 1) + uu; f32x4 a4 = (f32x4){0.f, 0.f, 0.f, 0.f};
#pragma unroll
                  for (int kk = 0; kk < 4; ++kk) { const bf16x8 af = *(const LAS bf16x8*)(KD + (16 * sj + i16) * 272 + (32 * kk + 8 * (lane >> 4)) * 2), bfr = *(const LAS bf16x8*)(QD + (16 * ti + i16) * 272 + (32 * kk + 8 * (lane >> 4)) * 2);
                      a4 = MFMA16(af, bfr, a4); }
                  const int t = 16 * ti + i16, s0 = 16 * sj + 4 * (lane >> 4);
                  float pv[4];
#pragma unroll
                  for (int i = 0; i < 4; ++i) pv[i] = (s0 + i <= t) ? a4[i] : 0.f;
                  u32x2 w; w.x = cvt_pk_bf16(pv[0], pv[1]); w.y = cvt_pk_bf16(pv[2], pv[3]);
                  *(LAS u32x2*)(PT + t * 144 + s0 * 2) = w; } }
            LDS_BAR();
            SCANT(4);
#define SB_ asm volatile("" ::: "memory")
#define LD_INTER(Fx, kb_, s2_) do { _Pragma("unroll") for (int tb_ = 0; tb_ < 2; ++tb_) { const LAS unsigned char* qp_ = QD + (32 * tb_ + r32) * 272 + (32 * (kb_) + 16 * (s2_) + 4 * hi) * 2; \
                Fx[tb_] = cat4(*(const LAS s16x4*)qp_, *(const LAS s16x4*)(qp_ + 16)); } } while (0)
#define MM_INTER(Fx, kb_, s2_) do { const bf16x8 ap_ = pack8(S[kb_], s2_); oT[0] = MFMA32(ap_, Fx[0], oT[0]); oT[1] = MFMA32(ap_, Fx[1], oT[1]); } while (0)
#define LD_P(Fx, i_, tb_, ss_) Fx[i_] = *(const LAS bf16x8*)(PT + (32 * (tb_) + r32) * 144 + (16 * (ss_) + 8 * hi) * 2)
#define LD_STATE(Fx, kb_) do { _Pragma("unroll") for (int ss_ = 0; ss_ < 4; ++ss_) { const LAS unsigned char* zp_ = KZ + (16 * ss_ + 8 * hi + tq) * 272 + (32 * (kb_) + 16 * blk + 4 * tp) * 2; Fx[ss_] = cat4(tr_read(zp_), tr_read(zp_ + 4 * 272)); } } while (0)
#define LD_DEC(kb_) do { } while (0)
#define DECAY(kb_) do { _Pragma("unroll") for (int i4_ = 0; i4_ < 4; ++i4_) { const f32x4 dv_ = *(const LAS f32x4*)(DEC + 32 * (kb_) + 8 * i4_ + 4 * hi); _Pragma("unroll") for (int e_ = 0; e_ < 4; ++e_) S[kb_][4 * i4_ + e_] *= dv_[e_]; } } while (0)
#define MM_STATE(Fx, kb_) do { _Pragma("unroll") for (int ss_ = 0; ss_ < 4; ++ss_) S[kb_] = MFMA32(Fx[ss_], vfr[ss_], S[kb_]); } while (0)
            bf16x8 vfr[4], fa[4], fb[4];
#pragma unroll
            for (int ss = 0; ss < 4; ++ss) { const LAS unsigned char* vp = VT + (16 * ss + 8 * hi + tq) * 528 + (32 * wave + 16 * blk + 4 * tp) * 2; vfr[ss] = cat4(tr_read(vp), tr_read(vp + 4 * 528)); }
            f32x16 oT[2];
#pragma unroll
            for (int tb = 0; tb < 2; ++tb)
#pragma unroll
                for (int i = 0; i < 16; ++i) oT[tb][i] = 0.f;
            LD_INTER(fa, 0, 0); LD_INTER(fb, 0, 1); SB_;
            MM_INTER(fa, 0, 0); LD_INTER(fa, 1, 0); SB_; MM_INTER(fb, 0, 1); LD_INTER(fb, 1, 1); SB_;
            MM_INTER(fa, 1, 0); LD_INTER(fa, 2, 0); SB_; MM_INTER(fb, 1, 1); LD_INTER(fb, 2, 1); SB_;
            MM_INTER(fa, 2, 0); LD_INTER(fa, 3, 0); SB_; MM_INTER(fb, 2, 1); LD_INTER(fb, 3, 1); SB_;
            MM_INTER(fa, 3, 0); SB_;
            LD_P(fa, 0, 0, 0); LD_P(fa, 1, 0, 1); LD_P(fa, 2, 1, 0); LD_P(fa, 3, 1, 1); SB_; MM_INTER(fb, 3, 1); SB_;
            LD_P(fb, 0, 1, 2); LD_P(fb, 1, 1, 3); LD_DEC(0); SB_;
            oT[0] = MFMA32(vfr[0], fa[0], oT[0]); oT[1] = MFMA32(vfr[0], fa[2], oT[1]); oT[0] = MFMA32(vfr[1], fa[1], oT[0]); oT[1] = MFMA32(vfr[1], fa[3], oT[1]); SB_;
            LD_STATE(fa, 0); SB_;
            oT[1] = MFMA32(vfr[2], fb[0], oT[1]); oT[1] = MFMA32(vfr[3], fb[1], oT[1]); SB_;
#pragma unroll
            for (int tb = 0; tb < 2; ++tb)
#pragma unroll
                for (int i4 = 0; i4 < 4; ++i4) { u32x2 w; w.x = cvt_pk_bf16(oT[tb][4 * i4], oT[tb][4 * i4 + 1]); w.y = cvt_pk_bf16(oT[tb][4 * i4 + 2], oT[tb][4 * i4 + 3]);
                    *(LAS u32x2*)(OTW + (32 * tb + r32) * 64 + (8 * i4 + 4 * hi) * 2) = w; }
            SB_;
            if (cj + 1 < 36) GLA_FETCH_QK(cj + 1);
            DECAY(0); LD_DEC(1); LD_STATE(fb, 1); SB_; MM_STATE(fa, 0); SB_;
#pragma unroll
            for (int it = 0; it < 4; ++it) { const int idx = lane + 64 * it; const int trow = idx >> 2, pc = idx & 3; const u32x4 w = *(const LAS u32x4*)(OTW + trow * 64 + pc * 16);
                char* ub = (char*)OUT + ((size_t)(tlow + sgn * 16 * it)) * 2048 + hd * 512 + 64 * wave; *(u32x4*)(ub + olo) = w; }
            SB_;
            DECAY(1); LD_DEC(2); LD_STATE(fa, 2); SB_; MM_STATE(fb, 1); SB_;
            DECAY(2); LD_DEC(3); LD_STATE(fb, 3); SB_; MM_STATE(fa, 2); SB_;
            DECAY(3); SB_; MM_STATE(fb, 3);
#undef SB_
#undef LD_INTER
#undef MM_INTER
#undef LD_P
#undef LD_STATE
#undef LD_DEC
#undef DECAY
#undef MM_STATE
            SCANT(5);
        }
    }
}
#undef SCANT

#undef GLA_TLOW
#undef GLA_FETCH_V
#undef GLA_FETCH_QK
DI void gla_norm_phase(Frame& F, int j, int nrows) {
    unsigned char* const ws = KWS; const bf16_t* OFW = (const bf16_t*)(ws + WS_H); const bf16_t* OBW = (const bf16_t*)KOUT; const bf16_t* GB = (const bf16_t*)(ws + WS_R2) + (size_t)MT * 1024; signed char* A2 = (signed char*)(ws + WS_R2); float* sap = (float*)(ws + WS_SA);
    const int gw = blockIdx.x * NWAVES + F.wave, NGW = F.G * NWAVES;
    const float* ngp = KIN(I_GNORM) + j * 256 + 8 * (F.lane & 31);
    const f32x4 ng0 = *(const f32x4*)ngp, ng1 = *(const f32x4*)(ngp + 4);
    const float ng[8] = {ng0[0], ng0[1], ng0[2], ng0[3], ng1[0], ng1[1], ng1[2], ng1[3]};
    for (int rowb = 2 * gw; rowb < nrows; rowb += 2 * NGW) {
        u32x4 a[2][2], bq[2][2], gg[2][2];
#pragma unroll
        for (int u = 0; u < 2; ++u)
#pragma unroll
            for (int it = 0; it < 2; ++it) { const size_t off = (size_t)(rowb + u) * 1024 + (size_t)(F.lane + 64 * it) * 8; a[u][it] = *(const u32x4*)(OFW + off); bq[u][it] = *(const u32x4*)(OBW + off); gg[u][it] = *(const u32x4*)(GB + off); }
#pragma unroll
        for (int u = 0; u < 2; ++u) { float v16[16];
#pragma unroll
            for (int it = 0; it < 2; ++it) {
                const unsigned aw[4] = {a[u][it].x, a[u][it].y, a[u][it].z, a[u][it].w}, bw[4] = {bq[u][it].x, bq[u][it].y, bq[u][it].z, bq[u][it].w}, gw4[4] = {gg[u][it].x, gg[u][it].y, gg[u][it].z, gg[u][it].w};
                float ov[8], gv[8]; float ss = 0.f;
#pragma unroll
                for (int q = 0; q < 4; ++q) { ov[2 * q] = bf_lo(aw[q]) + bf_lo(bw[q]); ov[2 * q + 1] = bf_hi(aw[q]) + bf_hi(bw[q]); gv[2 * q] = bf_lo(gw4[q]); gv[2 * q + 1] = bf_hi(gw4[q]); }
#pragma unroll
                for (int e = 0; e < 8; ++e) ss += ov[e] * ov[e];
                ss = half_sum32(ss, F.lane);
                const float rstd = 1.0f / sqrtf(ss * (1.0f / 256.0f) + RMS_EPS);
#pragma unroll
                for (int e = 0; e < 8; ++e) v16[8 * it + e] = ov[e] * rstd * ng[e] * silu_fast(gv[e]); }
            const float sc_ = quant_row_i8(v16, A2 + (size_t)(rowb + u) * 1024, 8 * F.lane, F.lane); if (F.lane == 0) sap[rowb + u] = sc_; }
    }
}

DI void final_phase(Frame& F) {
    unsigned char* const ws = KWS; const bf16_t* XRp = (const bf16_t*)(ws + WS_XR); const unsigned char* Yp = ws + WS_R3; float* outp = KOUT; const float* fg = KIN(I_FINALG);
    const float* gatel = (const float*)(ws + WS_MOD) + (size_t)(DEPTH - 1) * 33 * 6144 + 5 * 1024; const int* tokpos = (const int*)(ws + WS_TOKPOS);
    (void)moe_table(F, DEPTH - 1); const LAS int* bs = (const LAS int*)(F.lds + MOE_TAB_OFF);
    const int c0 = 8 * F.lane;
    const int RPB = (NL + F.G - 1) / F.G, RPW = (RPB + 7) / 8;
    const int brow0 = blockIdx.x * RPB; int bend = brow0 + RPB; if (bend > NL) bend = NL;
    const int row0 = brow0 + F.wave * RPW; int rend = row0 + RPW; if (rend > bend) rend = bend;
    float gn[16], gy[16]; int mb = -1;
#pragma unroll
    for (int hh = 0; hh < 2; ++hh)
#pragma unroll
        for (int q = 0; q < 2; ++q) { const f32x4 g4 = *(const f32x4*)(fg + hh * 512 + c0 + 4 * q);
#pragma unroll
            for (int e = 0; e < 4; ++e) gn[hh * 8 + q * 4 + e] = g4[e]; }
    for (int rowb = row0; rowb < rend; rowb += 4) {
        u32x4 xa[4], xb[4], ya[4], yb[4];
#pragma unroll
        for (int u = 0; u < 4; ++u) { const int rr = rowb + u < rend ? rowb + u : rend - 1; const bf16_t* xr = XRp + (size_t)rr * 1024; xa[u] = *(const u32x4*)(xr + c0); xb[u] = *(const u32x4*)(xr + 512 + c0);
            const int tp = tokpos[rr]; const unsigned char* yr = Yp + ((size_t)bs[tp & 0xff] * 256 + (size_t)(tp >> 8)) * 1024; const u32x2 ta_ = *(const u32x2*)(yr + c0), tb_ = *(const u32x2*)(yr + 512 + c0); ya[u].x = ta_.x; ya[u].y = ta_.y; yb[u].x = tb_.x; yb[u].y = tb_.y; }
#pragma unroll
        for (int u = 0; u < 4; ++u) { const int row = rowb + u; if (row < rend) {
            const int mbn = row >> 11;
            if (mbn != mb) { mb = mbn; const float* gp = gatel + (size_t)mb * 6144;
#pragma unroll
                for (int hh = 0; hh < 2; ++hh)
#pragma unroll
                    for (int q = 0; q < 2; ++q) { const f32x4 y4 = *(const f32x4*)(gp + hh * 512 + c0 + 4 * q);
#pragma unroll
                        for (int e = 0; e < 4; ++e) gy[hh * 8 + q * 4 + e] = y4[e] * (1.0f / Y_SCALE); } }
            float v[16], yv[16]; unpack16(xa[u], xb[u], v); unpack16_f8(ya[u].x, ya[u].y, yb[u].x, yb[u].y, yv);
            float ss = 0.f;
#pragma unroll
            for (int e = 0; e < 16; ++e) { v[e] += gy[e] * yv[e]; ss += v[e] * v[e]; }
            ss = wave_sum(ss, F.lane);
            const float rstd = 1.0f / sqrtf(ss * (1.0f / 1024.0f) + RMS_EPS);
            float* op = outp + (size_t)row * 1024;
#pragma unroll
            for (int hh = 0; hh < 2; ++hh)
#pragma unroll
                for (int q = 0; q < 2; ++q) { f32x4 o4;
#pragma unroll
                    for (int e = 0; e < 4; ++e) o4[e] = v[hh * 8 + q * 4 + e] * rstd * gn[hh * 8 + q * 4 + e];
                    *(f32x4*)(op + hh * 512 + c0 + 4 * q) = o4; }
        } }
    }
}

struct Args { const float* in[23]; float* out; unsigned char* ws; int ph_lo, ph_hi; };
constexpr int PH_PER_LAYER = 8, N_PHASES = 1 + DEPTH * PH_PER_LAYER + 1;

__global__ void __launch_bounds__(NWAVES * 64, 2) fwd_kernel(Args args) {
    extern __shared__ __attribute__((aligned(16))) unsigned char lds[];
    LAS unsigned char* const ldsb = (LAS unsigned char*)lds;
    const int wv0 = __builtin_amdgcn_readfirstlane((int)threadIdx.x >> 6);
    for (int u = wv0 * 64 + (int)lane_id_(); u < (LDS_BYTES - MISC_OFF) / 4; u += NWAVES * 64) ((LAS unsigned*)(ldsb + MISC_OFF))[u] = 0u;
    __syncthreads();
    const int lo = args.ph_lo, hi = args.ph_hi;
    XcdBarrier bar; bar.bar = nullptr; bar.x = 0; bar.st = (volatile LAS unsigned*)(ldsb + MISC_OFF) + 8; bar.w = (unsigned)wv0;
    if (hi - lo > 1) bar = xcd_barrier_post((unsigned*)KWS + CW_BAR, (volatile LAS unsigned*)(ldsb + MISC_OFF) + 8, (unsigned)wv0);
#define IN(k) (lo <= (k) && (k) < hi)
#if PROBE_MASK
    unsigned long long pr_prev = __builtin_amdgcn_s_memrealtime(), pr_acc = 0;
#define PSTAMP(slot) do { const unsigned long long tn_ = __builtin_amdgcn_s_memrealtime(); if ((PROBE_MASK >> (slot)) & 1) pr_acc += tn_ - pr_prev; pr_prev = tn_; } while (0)
#else
    unsigned long long pr_acc = 0;
#define PSTAMP(slot) do { } while (0)
#endif
#define SEAM(k, slot) do { if (IN(k) && IN((k) + 1)) { bar.bar = (unsigned*)KWS + CW_BAR; xcd_barrier(bar); } PSTAMP(slot); } while (0)

    if (PHE(0) && IN(0)) { Frame F = mkframe(ldsb, wv0); p0_prologue(F); }
    SEAM(0, 0);
#pragma unroll 1
    for (int layer = 0; layer < DEPTH; ++layer) {
        const int pb = 1 + layer * PH_PER_LAYER; const int j = layer >> 1; const bool gla = layer & 1;
        if (PHE(1) && IN(pb + 0)) { Frame F = mkframe(ldsb, wv0); norm_phase<false>(F, layer); }
        SEAM(pb + 0, 1);
        if (IN(pb + 1)) { Frame F = mkframe(ldsb, wv0);
            if (PHE(2) && !gla) { unsigned char* const ws = KWS;
                LAS float* ropeL = (LAS float*)(F.lds + RING_BYTES);
                { const float* rg = (const float*)(ws + WS_ROPE); for (int idx = F.tid; idx < 64 * 32; idx += 512) ropeL[idx] = rg[idx]; }
                __syncthreads();
                DenseOrder S{MT / 256, NQKV / 256, F.G, (int)blockIdx.x, 1024u, (const char*)(ws + WS_WQKV) + (size_t)j * NQKV * 1024, 1024u, (const float*)(ws + WS_SA), (const float*)(ws + WS_SBQKV) + j * NQKV}; EpiQKV E{(bf16_t*)(ws + WS_R2), ropeL};
                pg8::gemm_phase<EpiQKV, DenseOrder, 1>(F.lds, F.tid, (const char*)(ws + WS_H), 1024, 1024u, S, E, pr_acc); }
            else if (PHE(3) && gla) { unsigned char* const ws = KWS;
                DenseOrder S{MT / 256, NGIN / 256, F.G, (int)blockIdx.x, 1024u, (const char*)(ws + WS_WIN) + (size_t)j * NGIN * 1024, 1024u, (const float*)(ws + WS_SA), (const float*)(ws + WS_SBIN) + j * NGIN};
                EpiGLA E{(bf16_t*)(ws + WS_R2), (float*)(ws + WS_R)};
                pg8::gemm_phase<EpiGLA, DenseOrder, 1>(F.lds, F.tid, (const char*)(ws + WS_H), 1024, 1024u, S, E, pr_acc); }
        }
        SEAM(pb + 1, gla ? 3 : 2);
        if (IN(pb + 2)) { if (PHE(4) && !gla) { Frame F = mkframe(ldsb, wv0); attn_phase(F, j, pr_acc); } else if (PHE(5) && gla) { Frame F = mkframe(ldsb, wv0); gla_phase(F, j, pr_acc); } }
        SEAM(pb + 2, gla ? 5 : 4);
        if (PHE(6) && IN(pb + 3)) { Frame F = mkframe(ldsb, wv0); if (gla) gla_norm_phase(F, j, layer == DEPTH - 1 ? NL : MT); }
        if (gla) SEAM(pb + 3, 6);
        if (PHE(7) && IN(pb + 4)) { Frame F = mkframe(ldsb, wv0); unsigned char* const ws = KWS;
            const int nMp = layer == DEPTH - 1 ? NL / 256 : MT / 256;
            EpiY E{ws + WS_H};
            if (gla) { DenseOrder S{nMp, 4, F.G, (int)blockIdx.x, 1024u, (const char*)(ws + WS_WGO) + (size_t)j * 1024 * 1024, 1024u, (const float*)(ws + WS_SA), (const float*)(ws + WS_SBGO) + j * 1024};
                pg8::gemm_phase<EpiY, DenseOrder, 1>(F.lds, F.tid, (const char*)(ws + WS_R2), 1024, 1024u, S, E, pr_acc); }
            else { DenseOrder S{nMp, 4, F.G, (int)blockIdx.x, 1024u, (const char*)(ws + WS_WO) + (size_t)j * 1024 * 1024, 1024u, nullptr, (const float*)(ws + WS_SBO) + j * 1024, 1.0f / ATT_O_SCALE};
                pg8::gemm_phase<EpiY, DenseOrder, 2>(F.lds, F.tid, (const char*)(ws + WS_R3), 1024, 1024u, S, E, pr_acc); }
        }
        SEAM(pb + 4, 7);
        if (PHE(8) && IN(pb + 5)) { Frame F = mkframe(ldsb, wv0); n2_phase(F, layer); }
        SEAM(pb + 5, 8);
        if (PHE(9) && IN(pb + 6)) { Frame F = mkframe(ldsb, wv0);
            const int nblk = moe_table(F, layer); const LAS int* bs = (const LAS int*)(F.lds + MOE_TAB_OFF); unsigned char* const ws = KWS;
            MoeUpOrder S{nblk, F.G, (int)blockIdx.x, bs, bs + 32, (const int*)(ws + WS_LIST), (const char*)(ws + WS_WGU) + (size_t)layer * 16 * 1024 * 1024, (const float*)(ws + WS_SLIST), (const float*)(ws + WS_SBGU) + layer * 16 * 1024};
            EpiSwiGLU E{(unsigned char*)(ws + WS_R2), (const f32x2*)(ws + WS_GLIST)};
            pg8::gemm_phase<EpiSwiGLU, MoeUpOrder, 1>(F.lds, F.tid, (const char*)(ws + WS_R3), 1024, 1024u, S, E, pr_acc);
        }
        SEAM(pb + 6, 9);
        if (PHE(10) && IN(pb + 7)) { Frame F = mkframe(ldsb, wv0);
            const int nblk = moe_table(F, layer); const LAS int* bs = (const LAS int*)(F.lds + MOE_TAB_OFF); unsigned char* const ws = KWS;
            MoeDownOrder S{nblk, F.G, (int)blockIdx.x, bs, (const char*)(ws + WS_WD) + (size_t)layer * 16 * 1024 * 512, (const float*)(ws + WS_SBD) + layer * 4 * 1024}; EpiY E{ws + WS_R3};
            pg8::gemm_phase<EpiY, MoeDownOrder, 2>(F.lds, F.tid, (const char*)(ws + WS_R2), 1024, 512u, S, E, pr_acc);
        }
        SEAM(pb + 7, 10);
    }
    if (PHE(11) && IN(N_PHASES - 1)) { Frame F = mkframe(ldsb, wv0); final_phase(F); }
#if PROBE_MASK
    PSTAMP(11);
    if (blockIdx.x == 0 && wv0 == 0 && lane_id_() == 0u) { const unsigned long long t0_ = __builtin_amdgcn_s_memrealtime(); while (__builtin_amdgcn_s_memrealtime() - t0_ < (unsigned long long)PROBE_AMP * pr_acc) __builtin_amdgcn_s_sleep(8); }
#endif
#undef IN
#undef SEAM
}

extern "C" void kernel_launch(void* const* d_in, const int* in_sizes, int n_in, void* d_out, int out_size, void* d_ws, size_t ws_size, hipStream_t stream) {
    static int grid = 0;
    if (grid == 0) {
        if (n_in != 23 || out_size != NL * D || ws_size < WS_END) { fprintf(stderr, "kernel_launch: unexpected shapes (n_in %d, out %d, ws %zu; need ws >= %zu)\n", n_in, out_size, ws_size, (size_t)WS_END); grid = -1; return; }
        int dev = 0, cus = 0, per_cu = 0;
        if (hipGetDevice(&dev) != hipSuccess || hipDeviceGetAttribute(&cus, hipDeviceAttributeMultiprocessorCount, dev) != hipSuccess) { grid = -1; return; }
        if (hipFuncSetAttribute((const void*)fwd_kernel, hipFuncAttributeMaxDynamicSharedMemorySize, LDS_BYTES) != hipSuccess) { fprintf(stderr, "kernel_launch: hipFuncSetAttribute failed\n"); grid = -1; return; }
        if (hipOccupancyMaxActiveBlocksPerMultiprocessor(&per_cu, (const void*)fwd_kernel, NWAVES * 64, LDS_BYTES) != hipSuccess || per_cu < 1) { fprintf(stderr, "kernel_launch: occupancy query reports %d blocks per CU\n", per_cu); }
        (void)hipGetLastError();
        grid = cus;
        if (grid < 128) { fprintf(stderr, "kernel_launch: too few CUs (%d)\n", grid); grid = -1; return; }
    }
    if (grid < 0) return;
    (void)in_sizes;
    if (hipMemsetAsync((char*)d_ws + WS_CTL, 0, CTL_ZERO_BYTES, stream) != hipSuccess) return;
    Args a{};
    for (int i = 0; i < 23; ++i) a.in[i] = (const float*)d_in[i];
    a.out = (float*)d_out; a.ws = (unsigned char*)d_ws;
#if MK_N_LAUNCHES == 1
    a.ph_lo = 0; a.ph_hi = N_PHASES;
    hipLaunchKernelGGL(fwd_kernel, dim3(grid), dim3(NWAVES * 64), LDS_BYTES, stream, a);
#else
    for (int p = 0; p < N_PHASES; ++p) {
        if (p >= 1 && p < N_PHASES - 1) { const int s = (p - 1) % PH_PER_LAYER, layer = (p - 1) / PH_PER_LAYER; if (s == 3 && !(layer & 1)) continue; }
        a.ph_lo = p; a.ph_hi = p + 1;
        hipLaunchKernelGGL(fwd_kernel, dim3(grid), dim3(NWAVES * 64), LDS_BYTES, stream, a);
    }
#endif
}
```

```cpp
#include <hip/hip_runtime.h>
#include <cstdio>
#include <cstdint>

#ifndef PROBE_MASK
#define PROBE_MASK 0
#endif
#define PROBE_AMP 4
#ifndef PROBE_GEMM
#define PROBE_GEMM 0
#endif
#ifndef PROBE_ATT
#define PROBE_ATT 0
#endif
#ifndef PROBE_SCAN
#define PROBE_SCAN 0
#endif
#ifndef GEMM_STAGGER_TICKS
#define GEMM_STAGGER_TICKS 0
#endif
#ifndef MK_N_LAUNCHES
#define MK_N_LAUNCHES 1
#endif

#ifndef PH_SEL
#define PH_SEL -1
#endif
#define PHE(k) (PH_SEL < 0 || PH_SEL == (k))
#define LAS __attribute__((address_space(3)))
#define GAS __attribute__((address_space(1)))
#define LDS_BAR() asm volatile("s_waitcnt lgkmcnt(0)\n\ts_barrier" ::: "memory")
typedef unsigned short bf16_t;
typedef short bf16x8 __attribute__((ext_vector_type(8)));
typedef short s16x4 __attribute__((ext_vector_type(4)));
typedef float f32x4 __attribute__((ext_vector_type(4)));
typedef float f32x2 __attribute__((ext_vector_type(2)));
typedef float f32x16 __attribute__((ext_vector_type(16)));
typedef unsigned u32x4 __attribute__((ext_vector_type(4)));
typedef unsigned u32x2 __attribute__((ext_vector_type(2)));
typedef int i32x4 __attribute__((ext_vector_type(4)));
typedef int i32x8 __attribute__((ext_vector_type(8)));
#define DI __device__ __forceinline__

constexpr int D = 1024, NB = 32, SEQ = 2048, CTX = 256, DEPTH = 4;
constexpr int NL = NB * SEQ, NC = NB * CTX, MT = NL + NC;
constexpr int NQKV = 1536, NGIN = 3328;
constexpr int NCLS = 24;
constexpr float RMS_EPS = 1e-6f;
constexpr float QSCALE = 0.125f * 1.4426950408889634f;
constexpr float LOG2E = 1.4426950408889634f;

constexpr size_t MiB = (size_t)1 << 20;
constexpr size_t WS_CTL = 0, CTL_ZERO_BYTES = 1 * MiB;
constexpr size_t WS_MOD = 1 * MiB;
constexpr size_t WS_ROPE = 5 * MiB;
constexpr size_t WS_TOKPOS = 5 * MiB + 256 * 1024;
constexpr size_t WS_LIST = 6 * MiB;
constexpr size_t WS_GLIST = 13 * MiB;
constexpr size_t WS_R = 27 * MiB;
constexpr size_t WS_WQKV = 36 * MiB, WS_WO = 42 * MiB, WS_WIN = 46 * MiB, WS_WGO = 59 * MiB, WS_WGU = 63 * MiB, WS_WD = 191 * MiB;
constexpr size_t WS_XR = 256 * MiB;
constexpr size_t WS_H = 400 * MiB;
constexpr size_t WS_R2 = 544 * MiB;
static_assert(544 * MiB + 2 * ((size_t)73728 * 1024 * 2) == 832 * MiB, "R3 = R2 + 2 activations");
constexpr size_t WS_R3 = 832 * MiB;
constexpr size_t WS_SA = 992 * MiB;
constexpr size_t WS_SLIST = 993 * MiB;
constexpr size_t WS_SBQKV = 1000 * MiB, WS_SBIN = 1000 * MiB + 65536, WS_SBGU = 1000 * MiB + 131072;
constexpr size_t WS_SBGO = 1000 * MiB + 131072 + 262144;
constexpr size_t WS_SBD = 1000 * MiB + 131072 + 262144 + 65536;
constexpr size_t WS_SBO = 1000 * MiB + 524288;
constexpr float ATT_O_SCALE = 32.0f;
constexpr float Y_SCALE = 16.0f;
constexpr float HID_SCALE = 16.0f;
constexpr size_t WS_END = 1001 * MiB;
constexpr size_t ACT_BYTES = (size_t)MT * 1024 * 2;
constexpr int CW_BAR = 4096;
constexpr int CW_MOE = 16384;

constexpr int RING_BYTES = 131072;
constexpr int LDS_BYTES = 163840;
constexpr int MISC_OFF = LDS_BYTES - 2048;
constexpr int MOE_TAB_OFF = MISC_OFF + 256;
constexpr int PHASE_LDS = MISC_OFF;
static_assert(RING_BYTES + 8192 <= MISC_OFF, "rope table above the ring");
constexpr int TAB_OFF = RING_BYTES + 8192, TAB_STRIDE = 5120;
static_assert(TAB_OFF + 2 * TAB_STRIDE <= MISC_OFF, "unit tables above the rope table");
constexpr int NWAVES = 8;

typedef __bf16 bf16x2_t __attribute__((ext_vector_type(2)));
DI unsigned cvt_pk_bf16(float lo, float hi) { f32x2 v = {lo, hi}; bf16x2_t b = __builtin_convertvector(v, bf16x2_t); return __builtin_bit_cast(unsigned, b); }
DI float bf_lo(unsigned w) { return __uint_as_float(w << 16); }
DI float bf_hi(unsigned w) { return __uint_as_float(w & 0xffff0000u); }
DI float shx(float v, int o, int lane) { return __int_as_float(__builtin_amdgcn_ds_bpermute((lane ^ o) << 2, __float_as_int(v))); }
#define DPPF(v, ctrl) __int_as_float(__builtin_amdgcn_update_dpp(0, __float_as_int(v), (ctrl), 0xF, 0xF, false))
DI float wave_sum(float v, int lane) {
    v += DPPF(v, 0xB1); v += DPPF(v, 0x4E); v += DPPF(v, 0x141); v += DPPF(v, 0x140);
    v += shx(v, 16, lane); v += shx(v, 32, lane);
    return v;
}
DI float wave_max(float v, int lane) {
    v = fmaxf(v, DPPF(v, 0xB1)); v = fmaxf(v, DPPF(v, 0x4E)); v = fmaxf(v, DPPF(v, 0x141)); v = fmaxf(v, DPPF(v, 0x140));
    v = fmaxf(v, shx(v, 16, lane)); v = fmaxf(v, shx(v, 32, lane));
    return v;
}
DI float half_sum32(float v, int lane) {
    v += DPPF(v, 0xB1); v += DPPF(v, 0x4E); v += DPPF(v, 0x141); v += DPPF(v, 0x140);
    v += shx(v, 16, lane);
    return v;
}
DI float sigmoidf_(float x) { return 1.0f / (1.0f + __expf(-x)); }
DI float siluf_(float x) { return x / (1.0f + __expf(-x)); }
#define MFMA32(a, b, c) __builtin_amdgcn_mfma_f32_32x32x16_bf16((a), (b), (c), 0, 0, 0)
#define MFMA16(a, b, c) __builtin_amdgcn_mfma_f32_16x16x32_bf16((a), (b), (c), 0, 0, 0)
DI int crow(int r, int hi) { return (r & 3) + 8 * (r >> 2) + 4 * hi; }
DI bf16x8 pack8(const f32x16& x, int s) {
    u32x4 p; p[0] = cvt_pk_bf16(x[8 * s + 0], x[8 * s + 1]); p[1] = cvt_pk_bf16(x[8 * s + 2], x[8 * s + 3]); p[2] = cvt_pk_bf16(x[8 * s + 4], x[8 * s + 5]); p[3] = cvt_pk_bf16(x[8 * s + 6], x[8 * s + 7]);
    return __builtin_bit_cast(bf16x8, p);
}
DI s16x4 tr_read(const LAS unsigned char* p) { return __builtin_bit_cast(s16x4, __builtin_amdgcn_ds_read_tr16_b64_v4i16((LAS s16x4*)p)); }
DI bf16x8 cat4(s16x4 lo, s16x4 hi) { return __builtin_shufflevector(lo, hi, 0, 1, 2, 3, 4, 5, 6, 7); }

DI unsigned lane_id_() { unsigned l; asm volatile("v_mbcnt_lo_u32_b32 %0, -1, 0\n\tv_mbcnt_hi_u32_b32 %0, -1, %0" : "=v"(l)); return l; }
#define XB_TMO      128
#define XB_XCNT(j)  (256  + 64 * (j))
#define XB_XSUB(j)  (1280 + 64 * (j))
#define XB_XGEN(j)  (2304 + 64 * (j))
#define XB_TOP      3328
#define XB_TOPGEN   3392
#define XCD_BAR_WORDS 3456
#define XB_SPIN_CAP (1u << 18)
__device__ __forceinline__ unsigned xb_ld(unsigned* p)              { return __hip_atomic_load(p, __ATOMIC_RELAXED, __HIP_MEMORY_SCOPE_AGENT); }
__device__ __forceinline__ unsigned xb_add(unsigned* p, unsigned v) { return __hip_atomic_fetch_add(p, v, __ATOMIC_RELAXED, __HIP_MEMORY_SCOPE_AGENT); }
__device__ __forceinline__ unsigned xb_xcc_id() { return (unsigned)__builtin_amdgcn_s_getreg((3 << 11) | 20) & 0xFu; }
#define XB_SPIN(cond, bar) do { unsigned _sp = 0; while (cond) { __builtin_amdgcn_s_sleep(1); \
    if ((++_sp & 255u) == 0u) { if (xb_ld(&(bar)[XB_TMO])) break; if (_sp > XB_SPIN_CAP) { atomicAdd(&(bar)[XB_TMO], 1u); break; } } } } while (0)
struct XcdBarrier { unsigned* bar; unsigned x; volatile LAS unsigned* st; unsigned w; };
__device__ __forceinline__ XcdBarrier xcd_barrier_post(unsigned* bar, volatile LAS unsigned* st, unsigned w) {
    XcdBarrier b; b.bar = bar; b.x = xb_xcc_id(); b.st = st; b.w = w;
    if (w == 0u && lane_id_() == 0u) (void)xb_add(&bar[XB_XCNT(b.x)], 1u);
    return b;
}
__device__ __forceinline__ void xcd_barrier_complete(unsigned* bar, unsigned x, unsigned& nloc, unsigned& nx) {
    const unsigned G = gridDim.x * gridDim.y * gridDim.z;
    unsigned sum, cnt, mine, sp = 0u;
    for (;;) {
        sum = 0u; cnt = 0u; mine = 0u;
#pragma unroll
        for (unsigned j = 0; j < 16; ++j) { const unsigned c = xb_ld(&bar[XB_XCNT(j)]); sum += c; cnt += (c > 0u) ? 1u : 0u; mine = (j == x) ? c : mine; }
        if (sum == G) break;
        __builtin_amdgcn_s_sleep(1);
        if ((++sp & 255u) == 0u) { if (xb_ld(&bar[XB_TMO])) break; if (sp > XB_SPIN_CAP) { atomicAdd(&bar[XB_TMO], 1u); break; } }
    }
    nloc = mine > 0u ? mine : 1u; nx = cnt > 0u ? cnt : 1u;
}
__device__ __forceinline__ void xcd_barrier(const XcdBarrier& b) {
    asm volatile("s_waitcnt vmcnt(0)" ::: "memory");
    __syncthreads();
    if (b.w == 0u && lane_id_() == 0u) {
        unsigned* bar = b.bar;
        __builtin_amdgcn_s_waitcnt(0);
        unsigned nloc = b.st[0], nx = b.st[1];
        if (nloc == 0u) { xcd_barrier_complete(bar, b.x, nloc, nx); b.st[0] = nloc; b.st[1] = nx; }
        const unsigned old = xb_add(&bar[XB_XSUB(b.x)], 1u);
        const unsigned gen = old / nloc;
        if (old + 1u == (gen + 1u) * nloc) {
            __builtin_amdgcn_fence(__ATOMIC_RELEASE, "agent");
            asm volatile("s_waitcnt vmcnt(0)" ::: "memory");
            const unsigned og = xb_add(&bar[XB_TOP], 1u);
            const unsigned tg = og / nx;
            if (og + 1u == (tg + 1u) * nx) xb_add(&bar[XB_TOPGEN], 1u);
            else XB_SPIN(xb_ld(&bar[XB_TOPGEN]) == tg, bar);
            __builtin_amdgcn_fence(__ATOMIC_ACQUIRE, "agent");
            xb_add(&bar[XB_XGEN(b.x)], 1u);
            asm volatile("s_waitcnt vmcnt(0)" ::: "memory");
        } else {
            XB_SPIN(xb_ld(&bar[XB_XGEN(b.x)]) == gen, bar);
            __builtin_amdgcn_fence(__ATOMIC_ACQUIRE, "agent");
            asm volatile("s_waitcnt vmcnt(0)" ::: "memory");
        }
    }
    __syncthreads();
}

struct Frame {
    LAS unsigned char* lds;
    int tid, lane, wave, G;
};
DI Frame mkframe(LAS unsigned char* lds, int wv) { Frame F; int l = (int)lane_id_(); asm volatile("" : "+v"(l)); F.lane = l; F.wave = wv; F.tid = wv * 64 + l; F.G = gridDim.x; F.lds = lds; return F; }
DI const void* karg(int slot) {
    const volatile __attribute__((address_space(4))) unsigned long long* ka = (const volatile __attribute__((address_space(4))) unsigned long long*)__builtin_amdgcn_kernarg_segment_ptr();
    return (const void*)(const GAS void*)ka[slot];
}
#define KIN(i) ((const float*)karg(i))
#define KOUT ((float*)karg(23))
#define KWS ((unsigned char*)karg(24))
enum { I_X = 0, I_C, I_CTX, I_CCTX, I_ADAW, I_ADAB, I_NMIX, I_NFFN, I_FINALG, I_WQKV, I_WO, I_SINKS, I_GWIN, I_GWA1, I_GWA2, I_GBA, I_GNORM, I_GWO, I_RW, I_RB, I_MG, I_MU, I_MD };

namespace pg8 {
constexpr int BM = 256, BK = 64, HALF = 128, HTB = HALF * BK * 2, STAGE_BYTES = 8 * HTB, NXCD = 8, WGM = 8;
__host__ __device__ __forceinline__ int lds_byte(int r, int c) { const int st = (r >> 4) * 2 + (c >> 5), rr = r & 15, cc = c & 31, ob = rr * 64 + cc * 2; return st * 1024 + (ob ^ (((ob >> 9) & 1) << 5)); }
__host__ __device__ __forceinline__ void stage_rc(int b, int& R, int& C) { const int st = b / 1024, sb = b % 1024, swz = sb ^ (((sb >> 9) & 1) << 5); R = (st >> 1) * 16 + swz / 64; C = (st & 1) * 32 + (swz % 64) / 2; }
__host__ __device__ __forceinline__ int perm32(int rho) { const int n = rho >> 4, i = rho & 15; return 8 * (i >> 2) + 4 * n + (i & 3); }
struct Unit { int pm, pn; const char* bA; const char* bB; int cl, slot0, n; const float* bsc; };
DI bool static_next(int i, int G, int c, int nM, int nN, Unit& u) {
    const int nwg = nM * nN; const long L = (long)i * G + c; if (L >= nwg) return false;
    int wgid = (int)L; { const int q = nwg / NXCD, r = nwg % NXCD, xcd = wgid % NXCD, off = wgid / NXCD; wgid = (xcd < r ? xcd * (q + 1) : r * (q + 1) + (xcd - r) * q) + off; }
    const int nig = WGM * nN, gid = wgid / nig, fm = gid * WGM, gsz = (nM - fm) < WGM ? (nM - fm) : WGM;
    u.pm = fm + ((wgid % nig) % gsz); u.pn = (wgid % nig) / gsz; return true;
}
template <class Epi, class Sched, int MODE = 0>
__device__ __forceinline__ void gemm_phase(LAS unsigned char* lds, const int tid_in, const char* Abase, const int Kbytes, const unsigned ldb, const Sched& S, const Epi& E, unsigned long long& pacc) {
    constexpr bool I8 = MODE == 1, F8 = MODE == 2;
    int tid_ = tid_in; asm volatile("" : "+v"(tid_));
    const int tid = tid_, wid = __builtin_amdgcn_readfirstlane(tid >> 6), lane = tid & 63, wr = wid >> 2, wc = wid & 3, fr = lane & 15, fq = lane >> 4;
    const int nt = Kbytes / 128;
    int Rr[2], Cc[2]; unsigned voffB[2];
#pragma unroll
    for (int i = 0; i < 2; ++i) { int R, C; stage_rc(tid * 16 + i * 8192, R, C); Rr[i] = R; Cc[i] = C; const int Rb = Epi::PERM ? ((R & ~31) + perm32(R & 31)) : R; voffB[i] = (unsigned)Rb * ldb + (unsigned)C * 2u; }
    const size_t kstep = (size_t)(BK * 2);
    const size_t hstepB = (size_t)HALF * ldb;
    const unsigned ldsw = (unsigned)wid * 1024u;
    const int aoff = lds_byte(wr * 64 + fr, fq * 8), boff = lds_byte(wc * 32 + fr, fq * 8);
#define PG8_SA(b, h) (((b) * 2 + (h)) * HTB)
#define PG8_SB(b, h) ((4 + (b) * 2 + (h)) * HTB)
#define PG8_STAGE_B(bufoff, gbase) do { _Pragma("unroll") for (int _i = 0; _i < 2; ++_i) \
        __builtin_amdgcn_global_load_lds((const unsigned*)((const char*)(gbase) + voffB[_i]), (LAS unsigned*)(lds + (bufoff) + ldsw + _i * 8192), 16, 0, 0); } while (0)
#define PG8_STAGE_A(bufoff, koff, offs) do { _Pragma("unroll") for (int _i = 0; _i < 2; ++_i) \
        __builtin_amdgcn_global_load_lds((const unsigned*)(Abase + (koff) + (offs)[_i]), (LAS unsigned*)(lds + (bufoff) + ldsw + _i * 8192), 16, 0, 0); } while (0)
#define PG8_CAT8(p_) __builtin_shufflevector(*(const LAS i32x4*)(p_), *(const LAS i32x4*)((p_) + 1024), 0, 1, 2, 3, 4, 5, 6, 7)
#define PG8_LDA(dst, b, h) do { if constexpr (F8) { _Pragma("unroll") for (int m = 0; m < 4; ++m) dst##8[m] = PG8_CAT8(lds + PG8_SA(b, h) + aoff + m * 2048); } \
        else { _Pragma("unroll") for (int m = 0; m < 4; ++m) _Pragma("unroll") for (int k = 0; k < 2; ++k) dst[m][k] = *(const LAS bf16x8*)(lds + PG8_SA(b, h) + aoff + m * 2048 + k * 1024); } } while (0)
#define PG8_LDB(dst, b, h) do { if constexpr (F8) { _Pragma("unroll") for (int n = 0; n < 2; ++n) dst##8[n] = PG8_CAT8(lds + PG8_SB(b, h) + boff + n * 2048); } \
        else { _Pragma("unroll") for (int n = 0; n < 2; ++n) _Pragma("unroll") for (int k = 0; k < 2; ++k) dst[n][k] = *(const LAS bf16x8*)(lds + PG8_SB(b, h) + boff + n * 2048 + k * 1024); } } while (0)
#define PG8_MMA(ai, bj, At, Bt) do { __builtin_amdgcn_s_setprio(1); _Pragma("unroll") for (int m = 0; m < 4; ++m) _Pragma("unroll") for (int n = 0; n < 2; ++n) _Pragma("unroll") for (int k = 0; k < 2; ++k) { \
        if constexpr (F8) { if (k == 0) asm volatile("v_mfma_scale_f32_16x16x128_f8f6f4 %0, %1, %2, %0, %3, %3 op_sel_hi:[0,0,0]" : "+v"(acc[ai][bj][m][n]) : "v"(Bt##8[n]), "v"(At##8[m]), "v"(f8one)); } \
        else if constexpr (I8) acc[ai][bj][m][n] = __builtin_bit_cast(f32x4, __builtin_amdgcn_mfma_i32_16x16x64_i8(__builtin_bit_cast(i32x4, Bt[n][k]), __builtin_bit_cast(i32x4, At[m][k]), __builtin_bit_cast(i32x4, acc[ai][bj][m][n]), 0, 0, 0)); \
        else acc[ai][bj][m][n] = __builtin_amdgcn_mfma_f32_16x16x32_bf16(Bt[n][k], At[m][k], acc[ai][bj][m][n], 0, 0, 0); } __builtin_amdgcn_s_setprio(0); } while (0)
#define PG8_WAIT_V(n) asm volatile("s_waitcnt vmcnt(" #n ")" ::: "memory")
#define PG8_WAIT_L(n) asm volatile("s_waitcnt lgkmcnt(" #n ")" ::: "memory")
#define PG8_BAR __builtin_amdgcn_s_barrier()
#define PG8_SCHED __builtin_amdgcn_sched_barrier(0)
#if PROBE_GEMM
    unsigned long long gtp_ = __builtin_amdgcn_s_memrealtime();
#define GEMT(k) do { const unsigned long long tn_ = __builtin_amdgcn_s_memrealtime(); if (PROBE_GEMM == (k)) pacc += tn_ - gtp_; gtp_ = tn_; } while (0)
#else
#define GEMT(k) do { } while (0)
#endif
    Unit cur, nxt; int ui = 0;
    if (!S.next(0, cur)) return;
#if GEMM_STAGGER_TICKS
    { const int nwg_ = S.total(), G_ = (int)gridDim.x, c_ = (int)blockIdx.x; const int nmax_ = (nwg_ + G_ - 1) / G_, mine_ = (nwg_ - 1 - c_) / G_ + 1;
      if (mine_ < nmax_) { const unsigned long long t0_ = __builtin_amdgcn_s_memrealtime(); while (__builtin_amdgcn_s_memrealtime() - t0_ < (unsigned long long)GEMM_STAGGER_TICKS) __builtin_amdgcn_s_sleep(16); } }
#endif
    f32x4 acc[2][2][4][2];
#pragma unroll
    for (int a = 0; a < 2; ++a)
#pragma unroll
        for (int b = 0; b < 2; ++b)
#pragma unroll
            for (int m = 0; m < 4; ++m)
#pragma unroll
                for (int n = 0; n < 2; ++n) acc[a][b][m][n] = (f32x4){0.f, 0.f, 0.f, 0.f};
    int f8one = 0x7F7F7F7F; asm volatile("" : "+v"(f8one));
    bf16x8 At[4][2], B0[2][2], B1[2][2]; i32x8 At8[4], B08[2], B18[2];
    unsigned oC[2][2], oN[2][2];
#pragma unroll
    for (int h = 0; h < 2; ++h)
#pragma unroll
        for (int i = 0; i < 2; ++i) { oC[h][i] = S.a_off(cur, h * HALF + Rr[i]) + (unsigned)Cc[i] * 2u; asm volatile("" : "+v"(oC[h][i])); }
#define PG8_BPTR(u, t) (((t) < Sched::KSPLIT ? (u).bA : (u).bB) + (size_t)((t) & (Sched::KSPLIT - 1)) * 128)
    const char* cB = PG8_BPTR(cur, 0);
    PG8_STAGE_B(PG8_SB(0, 0), cB); PG8_STAGE_B(PG8_SB(0, 1), cB + hstepB); PG8_STAGE_A(PG8_SA(0, 0), 0, oC[0]); PG8_STAGE_A(PG8_SA(0, 1), 0, oC[1]);
    if (wr == 1) PG8_BAR;
    PG8_WAIT_V(2); PG8_BAR;
    { const char* cB1 = PG8_BPTR(cur, 1); PG8_STAGE_B(PG8_SB(1, 0), cB1); PG8_STAGE_A(PG8_SA(1, 0), kstep, oC[0]); PG8_STAGE_B(PG8_SB(1, 1), cB1 + hstepB); }
    PG8_WAIT_V(6); PG8_BAR;
    for (;;) {
        const bool has_next = S.next(ui + 1, nxt);
        if (!has_next) nxt = cur;
        if constexpr (!Sched::GATHER) {
#pragma unroll
            for (int h = 0; h < 2; ++h)
#pragma unroll
                for (int i = 0; i < 2; ++i) { oN[h][i] = S.a_off(nxt, h * HALF + Rr[i]) + (unsigned)Cc[i] * 2u; asm volatile("" : "+v"(oN[h][i])); }
        }
        if constexpr (I8 || F8 || Sched::GATHER || Epi::HAS_GL) {
            int t8 = tid; asm volatile("" : "+v"(t8)); const int wid8 = __builtin_amdgcn_readfirstlane(t8 >> 6); const unsigned l8 = (unsigned)(t8 & 63) * 4u;
            LAS unsigned char* tbc = lds + TAB_OFF + (ui & 1) * TAB_STRIDE;
            if constexpr (F8) { if (wid8 >= 4) __builtin_amdgcn_global_load_lds((const unsigned*)((const char*)S.b_scale(cur) + (wid8 - 4) * 256 + l8), (LAS unsigned*)(tbc + wid8 * 256), 4, 0, 0); }
            if constexpr (I8) { const char* g8 = wid8 < 4 ? (const char*)S.sa_ptr(cur) + wid8 * 256 : (const char*)S.b_scale(cur) + (wid8 - 4) * 256;
                __builtin_amdgcn_global_load_lds((const unsigned*)(g8 + l8), (LAS unsigned*)(tbc + wid8 * 256), 4, 0, 0); }
            if constexpr (Epi::HAS_GL) __builtin_amdgcn_global_load_lds((const unsigned*)((const char*)E.gl_ptr(cur) + wid8 * 256 + l8), (LAS unsigned*)(tbc + 2048 + wid8 * 256), 4, 0, 0);
            if constexpr (Sched::GATHER) { if (wid8 < 4) __builtin_amdgcn_global_load_lds((const unsigned*)((const char*)S.list_ptr(nxt) + wid8 * 256 + l8), (LAS unsigned*)(lds + TAB_OFF + ((ui + 1) & 1) * TAB_STRIDE + 4096 + wid8 * 256), 4, 0, 0); }
        }
        GEMT(3);
        for (int t = 0; t < nt; t += 2) {
            const bool last = (t == nt - 2);
            const size_t a1k = (size_t)(t + 1) * kstep;
            const size_t a2k = last ? 0 : (size_t)(t + 2) * kstep, a3k = a2k + kstep;
            const char* b2 = last ? PG8_BPTR(nxt, 0) : PG8_BPTR(cur, t + 2);
            const char* b3 = last ? PG8_BPTR(nxt, 1) : PG8_BPTR(cur, t + 3);
            if constexpr (Sched::GATHER) {
                const LAS int* Ln = (const LAS int*)(lds + TAB_OFF + ((ui + 1) & 1) * TAB_STRIDE + 4096);
#pragma unroll
                for (int h = 0; h < 2; ++h)
#pragma unroll
                    for (int i = 0; i < 2; ++i) { const int row = h * HALF + Rr[i]; int tok = Ln[row]; tok = S.row_valid(nxt, row) ? tok : 0; oN[h][i] = (unsigned)tok * 1024u + (unsigned)Cc[i] * 2u; }
            }
            unsigned o2[2][2];
            { const unsigned c00 = oC[0][0], c01 = oC[0][1], c10 = oC[1][0], c11 = oC[1][1], n00 = oN[0][0], n01 = oN[0][1], n10 = oN[1][0], n11 = oN[1][1];
              o2[0][0] = last ? n00 : c00; o2[0][1] = last ? n01 : c01; o2[1][0] = last ? n10 : c10; o2[1][1] = last ? n11 : c11; }
            PG8_LDB(B0, 0, 0); PG8_LDB(B1, 0, 1); PG8_SCHED; PG8_LDA(At, 0, 0); PG8_STAGE_A(PG8_SA(1, 1), a1k, oC[1]);
            PG8_WAIT_V(8); PG8_WAIT_L(0); PG8_BAR; PG8_MMA(0, 0, At, B0); PG8_MMA(0, 1, At, B1); PG8_BAR; PG8_SCHED;
            PG8_LDA(At, 0, 1); PG8_STAGE_B(PG8_SB(0, 0), b2); PG8_STAGE_B(PG8_SB(0, 1), b2 + hstepB); PG8_STAGE_A(PG8_SA(0, 0), a2k, o2[0]);
            PG8_WAIT_V(8); PG8_WAIT_L(0); PG8_BAR; PG8_MMA(1, 0, At, B0); PG8_MMA(1, 1, At, B1); PG8_BAR; PG8_SCHED;
            PG8_LDB(B0, 1, 0); PG8_LDB(B1, 1, 1); PG8_SCHED; PG8_LDA(At, 1, 0); PG8_STAGE_A(PG8_SA(0, 1), a2k, o2[1]);
            PG8_WAIT_V(8); PG8_WAIT_L(0); PG8_BAR; PG8_MMA(0, 0, At, B0); PG8_MMA(0, 1, At, B1); PG8_BAR; PG8_SCHED;
            PG8_LDA(At, 1, 1); PG8_STAGE_B(PG8_SB(1, 0), b3); PG8_STAGE_B(PG8_SB(1, 1), b3 + hstepB); PG8_STAGE_A(PG8_SA(1, 0), a3k, o2[0]);
            PG8_WAIT_V(8); PG8_WAIT_L(0); PG8_BAR; PG8_MMA(1, 0, At, B0); PG8_MMA(1, 1, At, B1); PG8_BAR; PG8_SCHED;
        }
        GEMT(1);
        if constexpr (F8) asm volatile("s_nop 15\n\ts_nop 15" ::: "memory");
        if (wr == 0) PG8_BAR;
        if constexpr (I8) {
            int t7 = tid; asm volatile("" : "+v"(t7)); const int wid7 = __builtin_amdgcn_readfirstlane(t7 >> 6), l7 = t7 & 63, wr7 = wid7 >> 2, wc7 = wid7 & 3, fr7 = l7 & 15, fq7 = l7 >> 4;
            const LAS float* sap = (const LAS float*)(lds + TAB_OFF + (ui & 1) * TAB_STRIDE); const LAS float* sbp = sap + 256 + wc7 * 32 + (Epi::PERM ? 8 * fq7 : 4 * fq7);
#pragma unroll
            for (int a = 0; a < 2; ++a)
#pragma unroll
                for (int m = 0; m < 4; ++m) { const int row7 = a * HALF + wr7 * 64 + m * 16 + fr7; float sa_ = sap[row7]; sa_ = S.row_valid(cur, row7) ? sa_ : 0.f;
#pragma unroll
                    for (int b = 0; b < 2; ++b)
#pragma unroll
                        for (int n = 0; n < 2; ++n) { const f32x4 sb_ = *(const LAS f32x4*)(sbp + b * HALF + (Epi::PERM ? 4 * n : 16 * n)); const i32x4 v = __builtin_bit_cast(i32x4, acc[a][b][m][n]);
                            acc[a][b][m][n] = (f32x4){(float)v[0], (float)v[1], (float)v[2], (float)v[3]} * sa_ * sb_; } }
        }
        if constexpr (F8) {
            int t7 = tid; asm volatile("" : "+v"(t7)); const int wid7 = __builtin_amdgcn_readfirstlane(t7 >> 6), l7 = t7 & 63, wc7 = wid7 & 3, fq7 = l7 >> 4;
            const LAS float* sbp = (const LAS float*)(lds + TAB_OFF + (ui & 1) * TAB_STRIDE) + 256 + wc7 * 32 + (Epi::PERM ? 8 * fq7 : 4 * fq7); const float ac_ = S.a_const();
#pragma unroll
            for (int b = 0; b < 2; ++b)
#pragma unroll
                for (int n = 0; n < 2; ++n) { const f32x4 sb_ = *(const LAS f32x4*)(sbp + b * HALF + (Epi::PERM ? 4 * n : 16 * n)) * ac_;
#pragma unroll
                    for (int a = 0; a < 2; ++a)
#pragma unroll
                        for (int m = 0; m < 4; ++m) acc[a][b][m][n] = acc[a][b][m][n] * sb_; }
        }
        E(acc, cur, wr, wc, fr, fq, (const LAS unsigned char*)(lds + TAB_OFF + (ui & 1) * TAB_STRIDE));
        GEMT(2);
        if (!has_next) break;
#pragma unroll
        for (int a = 0; a < 2; ++a)
#pragma unroll
            for (int b = 0; b < 2; ++b)
#pragma unroll
                for (int m = 0; m < 4; ++m)
#pragma unroll
                    for (int n = 0; n < 2; ++n) acc[a][b][m][n] = (f32x4){0.f, 0.f, 0.f, 0.f};
        cur = nxt; ++ui;
#pragma unroll
        for (int h = 0; h < 2; ++h)
#pragma unroll
            for (int i = 0; i < 2; ++i) oC[h][i] = oN[h][i];
        if (wr == 1) PG8_BAR;
    }
    PG8_WAIT_V(0);
    PG8_BAR;
    GEMT(3);
#undef GEMT
#undef PG8_BPTR
#undef PG8_SA
#undef PG8_SB
#undef PG8_STAGE_A
#undef PG8_STAGE_B
#undef PG8_LDA
#undef PG8_LDB
#undef PG8_MMA
#undef PG8_WAIT_V
#undef PG8_WAIT_L
#undef PG8_BAR
#undef PG8_SCHED
}
}
using pg8::Unit;

struct DenseOrder {
    int nM, nN, G, c; unsigned lda; const char* Bt; unsigned ldb; const float* sa; const float* sb; float ac = 1.f;
    DI float a_const() const { return ac; }
    DI bool next(int i, Unit& u) const { if (!pg8::static_next(i, G, c, nM, nN, u)) return false; u.bA = Bt + (size_t)u.pn * 256 * ldb; u.bB = u.bA + 1024; u.cl = 0; u.slot0 = 0; u.n = 0; u.bsc = sb + u.pn * 256; return true; }
    static constexpr bool GATHER = false; static constexpr int KSPLIT = 8;
    DI const float* sa_ptr(const Unit& u) const { return sa + u.pm * 256; }
    DI const float* b_scale(const Unit& u) const { return u.bsc; }
    DI bool row_valid(const Unit&, int) const { return true; }
    DI const int* list_ptr(const Unit&) const { return nullptr; }
    DI unsigned a_off(const Unit& u, int row) const { return (unsigned)(u.pm * 256 + row) * lda; }
    DI int total() const { return nM * nN; }
};
DI int moe_class(const LAS int* bs, int pm) { int c = 0;
#pragma unroll
    for (int k = 1; k < NCLS; ++k) c += (bs[k] <= pm) ? 1 : 0;
    return c; }
DI void moe_experts(int c, int& elo, int& ehi) { const int g = c / 6, p = c - 6 * g; const int lo = p < 3 ? 0 : (p < 5 ? 1 : 2), hi = p < 3 ? p + 1 : (p < 5 ? p - 1 : 3); elo = 4 * g + lo; ehi = 4 * g + hi; }
struct MoeUpOrder {
    int nM, G, c; const LAS int* bs; const LAS int* cnt; const int* list; const char* Wgu; const float* slist; const float* sbgu;
    DI bool next(int i, Unit& u) const { if (!pg8::static_next(i, G, c, nM, 8, u)) return false;
        const int cl = __builtin_amdgcn_readfirstlane(moe_class(bs, u.pm)); int elo, ehi; moe_experts(cl, elo, ehi); const int e = u.pn < 4 ? elo : ehi;
        u.bA = Wgu + (size_t)e * (1024 * 1024) + (size_t)(u.pn & 3) * 256 * 1024; u.bB = u.bA + 1024; u.cl = cl; u.slot0 = (u.pm - __builtin_amdgcn_readfirstlane(bs[cl])) * 256; u.n = __builtin_amdgcn_readfirstlane(cnt[cl]); u.bsc = sbgu + e * 1024 + (u.pn & 3) * 256; return true; }
    DI unsigned a_off(const Unit& u, int row) const { const int slot = u.slot0 + row; int tok = 0; if (slot < u.n) tok = list[(size_t)u.cl * MT + slot]; return (unsigned)tok * 1024u; }
    static constexpr int KSPLIT = 8;
    static constexpr bool GATHER = true;
    DI const float* sa_ptr(const Unit& u) const { return slist + (size_t)u.cl * MT + u.slot0; }
    DI const int* list_ptr(const Unit& u) const { return list + (size_t)u.cl * MT + u.slot0; }
    DI bool row_valid(const Unit& u, int row) const { return u.slot0 + row < u.n; }
    DI const float* b_scale(const Unit& u) const { return u.bsc; }
};
struct MoeDownOrder {
    int nM, G, c; const LAS int* bs; const char* Wd; const float* sbd;
    static constexpr bool GATHER = false; static constexpr int KSPLIT = 4;
    DI bool next(int i, Unit& u) const { if (!pg8::static_next(i, G, c, nM, 4, u)) return false;
        const int cl = __builtin_amdgcn_readfirstlane(moe_class(bs, u.pm)); int elo, ehi; moe_experts(cl, elo, ehi);
        u.bA = Wd + (size_t)elo * (1024 * 512) + (size_t)u.pn * 256 * 512; u.bB = Wd + (size_t)ehi * (1024 * 512) + (size_t)u.pn * 256 * 512; u.cl = cl; u.slot0 = 0; u.n = 0; u.bsc = sbd + (cl / 6) * 1024 + u.pn * 256; return true; }
    DI unsigned a_off(const Unit& u, int row) const { return (unsigned)(u.pm * 256 + row) * 1024u; }
    DI const float* sa_ptr(const Unit&) const { return nullptr; }
    DI const float* b_scale(const Unit& u) const { return u.bsc; }
    DI float a_const() const { return 1.0f / HID_SCALE; }
    DI bool row_valid(const Unit&, int) const { return true; }
    DI const int* list_ptr(const Unit&) const { return nullptr; }
    DI int total() const { return nM * 4; }
};

struct EpiQKV {
    static constexpr bool PERM = false, HAS_GL = false;
    bf16_t* P; const LAS float* rope;
    DI void operator()(const f32x4 (&acc)[2][2][4][2], const Unit& u, int wr, int wc, int fr, int fq, const LAS unsigned char* tb) const {
        const int row0 = u.pm * 256 + wr * 64 + fr; const bool lat = u.pm < 256; const bool dorope = lat && u.pn < 5; const float sc = u.pn < 4 ? QSCALE : 1.0f;
#pragma unroll
        for (int ai = 0; ai < 2; ++ai)
#pragma unroll
            for (int m = 0; m < 4; ++m) { const int row = row0 + ai * 128 + m * 16; const int t = row & 2047; const int pos = (wc & 1) ? (t & 63) : (t >> 6);
                f32x4 cs = (f32x4){1.f, 1.f, 1.f, 1.f}, sn = (f32x4){0.f, 0.f, 0.f, 0.f};
                if (dorope) { cs = *(const LAS f32x4*)(rope + pos * 32 + 4 * fq); sn = *(const LAS f32x4*)(rope + pos * 32 + 16 + 4 * fq); }
                bf16_t* rowp = P + (size_t)row * NQKV + u.pn * 256 + wc * 32 + 4 * fq;
#pragma unroll
                for (int bj = 0; bj < 2; ++bj) { const f32x4 y1 = acc[ai][bj][m][0], y2 = acc[ai][bj][m][1];
                    const f32x4 o1 = (y1 * cs - y2 * sn) * sc, o2 = (y2 * cs + y1 * sn) * sc;
                    u32x2 w1, w2; w1.x = cvt_pk_bf16(o1[0], o1[1]); w1.y = cvt_pk_bf16(o1[2], o1[3]); w2.x = cvt_pk_bf16(o2[0], o2[1]); w2.y = cvt_pk_bf16(o2[2], o2[3]);
                    *(u32x2*)(rowp + bj * 128) = w1; *(u32x2*)(rowp + bj * 128 + 16) = w2; } }
    }
};
struct EpiGLA {
    static constexpr bool PERM = true, HAS_GL = false;
    bf16_t* R2b; float* R;
    DI void operator()(const f32x4 (&acc)[2][2][4][2], const Unit& u, int wr, int wc, int fr, int fq, const LAS unsigned char* tb) const {
        const int row0 = u.pm * 256 + wr * 64 + fr;
        if (u.pn == 12) { if (wc == 0) {
#pragma unroll
            for (int ai = 0; ai < 2; ++ai)
#pragma unroll
                for (int m = 0; m < 4; ++m) { float* rp = R + (size_t)(row0 + ai * 128 + m * 16) * 32 + 8 * fq; *(f32x4*)rp = acc[ai][0][m][0]; *(f32x4*)(rp + 4) = acc[ai][0][m][1]; } }
            return; }
        const int tsel = u.pn < 4 ? 0 : (u.pn < 8 ? 2 : 1);
        bf16_t* base = R2b + (size_t)tsel * ((size_t)MT * 1024); const int colt = (u.pn & 3) * 256; const float sc = u.pn < 2 ? 0.08838834764831845f : 1.0f;
#pragma unroll
        for (int ai = 0; ai < 2; ++ai)
#pragma unroll
            for (int m = 0; m < 4; ++m) { bf16_t* rowp = base + (size_t)(row0 + ai * 128 + m * 16) * 1024 + colt + wc * 32 + 8 * fq;
#pragma unroll
                for (int bj = 0; bj < 2; ++bj) { const f32x4 v0 = acc[ai][bj][m][0] * sc, v1 = acc[ai][bj][m][1] * sc;
                    u32x4 w; w.x = cvt_pk_bf16(v0[0], v0[1]); w.y = cvt_pk_bf16(v0[2], v0[3]); w.z = cvt_pk_bf16(v1[0], v1[1]); w.w = cvt_pk_bf16(v1[2], v1[3]);
                    *(u32x4*)(rowp + bj * 128) = w; } }
    }
};
struct EpiY {
    static constexpr bool PERM = true, HAS_GL = false;
    unsigned char* Y;
    DI void operator()(const f32x4 (&acc)[2][2][4][2], const Unit& u, int wr, int wc, int fr, int fq, const LAS unsigned char* tb) const {
        const int row0 = u.pm * 256 + wr * 64 + fr; const int col0 = u.pn * 256 + wc * 32 + 8 * fq;
#pragma unroll
        for (int ai = 0; ai < 2; ++ai)
#pragma unroll
            for (int m = 0; m < 4; ++m) { unsigned char* rowp = Y + (size_t)(row0 + ai * 128 + m * 16) * 1024 + col0;
#pragma unroll
                for (int bj = 0; bj < 2; ++bj) { const f32x4 v0 = acc[ai][bj][m][0] * Y_SCALE, v1 = acc[ai][bj][m][1] * Y_SCALE;
                    int w0 = 0, w1 = 0;
                    w0 = __builtin_amdgcn_cvt_pk_fp8_f32(__builtin_amdgcn_fmed3f(v0[0], -448.f, 448.f), __builtin_amdgcn_fmed3f(v0[1], -448.f, 448.f), w0, false); w0 = __builtin_amdgcn_cvt_pk_fp8_f32(__builtin_amdgcn_fmed3f(v0[2], -448.f, 448.f), __builtin_amdgcn_fmed3f(v0[3], -448.f, 448.f), w0, true);
                    w1 = __builtin_amdgcn_cvt_pk_fp8_f32(__builtin_amdgcn_fmed3f(v1[0], -448.f, 448.f), __builtin_amdgcn_fmed3f(v1[1], -448.f, 448.f), w1, false); w1 = __builtin_amdgcn_cvt_pk_fp8_f32(__builtin_amdgcn_fmed3f(v1[2], -448.f, 448.f), __builtin_amdgcn_fmed3f(v1[3], -448.f, 448.f), w1, true);
                    *(u32x2*)(rowp + bj * 128) = (u32x2){(unsigned)w0, (unsigned)w1}; } }
    }
};
DI float silu_fast(float a) { return a * __builtin_amdgcn_rcpf(1.0f + __builtin_amdgcn_exp2f(-a * LOG2E)); }
struct EpiSwiGLU {
    static constexpr bool PERM = true, HAS_GL = true;
    unsigned char* HID; const f32x2* glist;
    DI const f32x2* gl_ptr(const Unit& u) const { return glist + (size_t)u.cl * MT + u.slot0; }
    DI void operator()(const f32x4 (&acc)[2][2][4][2], const Unit& u, int wr, int wc, int fr, int fq, const LAS unsigned char* tb) const {
        const int sel = u.pn >> 2, hb = u.pn & 3; const int r0 = wr * 64 + fr; const LAS f32x2* gl = (const LAS f32x2*)(tb + 2048);
#pragma unroll
        for (int ai = 0; ai < 2; ++ai) {
            float gwv[4];
#pragma unroll
            for (int m = 0; m < 4; ++m) { const int rr_ = r0 + ai * 128 + m * 16; const f32x2 gg = gl[rr_]; const float g = (sel ? gg.y : gg.x) * HID_SCALE; gwv[m] = (u.slot0 + rr_ < u.n) ? g : 0.f; }
#pragma unroll
            for (int m = 0; m < 4; ++m) { const int r = r0 + ai * 128 + m * 16; const float gw = gwv[m];
                const f32x4 a0 = acc[ai][0][m][0], a1 = acc[ai][0][m][1], b0 = acc[ai][1][m][0], b1 = acc[ai][1][m][1];
                float h[8];
#pragma unroll
                for (int e = 0; e < 4; ++e) { h[e] = __builtin_amdgcn_fmed3f(silu_fast(a0[e]) * b0[e] * gw, -448.f, 448.f); h[4 + e] = __builtin_amdgcn_fmed3f(silu_fast(a1[e]) * b1[e] * gw, -448.f, 448.f); }
                int w0 = 0, w1 = 0; w0 = __builtin_amdgcn_cvt_pk_fp8_f32(h[0], h[1], w0, false); w0 = __builtin_amdgcn_cvt_pk_fp8_f32(h[2], h[3], w0, true); w1 = __builtin_amdgcn_cvt_pk_fp8_f32(h[4], h[5], w1, false); w1 = __builtin_amdgcn_cvt_pk_fp8_f32(h[6], h[7], w1, true);
                *(u32x2*)(HID + (size_t)(u.pm * 256 + r) * 1024 + sel * 512 + hb * 128 + wc * 32 + 8 * fq) = (u32x2){(unsigned)w0, (unsigned)w1}; } }
    }
};

struct TItem { const float* W; int ldw; bf16_t* WT; int Kd, k0, n0, drow0; };
DI void titem_load(const TItem& I, f32x4 (&t)[8], int lane) {
#pragma unroll
    for (int i = 0; i < 8; ++i) { const int idx = lane + 64 * i; t[i] = *(const f32x4*)(I.W + (size_t)(I.k0 + (idx >> 3)) * I.ldw + I.n0 + 4 * (idx & 7)); }
}
DI void titem_store(const TItem& I, const f32x4 (&t)[8], LAS float* scr, int lane) {
#pragma unroll
    for (int i = 0; i < 8; ++i) { const int idx = lane + 64 * i; LAS float* d = scr + (idx >> 3) * 33 + 4 * (idx & 7); d[0] = t[i][0]; d[1] = t[i][1]; d[2] = t[i][2]; d[3] = t[i][3]; }
    asm volatile("s_waitcnt lgkmcnt(0)" ::: "memory");
    const int c = lane & 7;
#pragma unroll
    for (int j = 0; j < 4; ++j) { const int n = (lane >> 3) + 8 * j; const LAS float* s = scr + (8 * c) * 33 + n;
        u32x4 o; o.x = cvt_pk_bf16(s[0 * 33], s[1 * 33]); o.y = cvt_pk_bf16(s[2 * 33], s[3 * 33]); o.z = cvt_pk_bf16(s[4 * 33], s[5 * 33]); o.w = cvt_pk_bf16(s[6 * 33], s[7 * 33]);
        *(u32x4*)(I.WT + (size_t)(I.drow0 + n) * I.Kd + I.k0 + 8 * c) = o; }
    asm volatile("s_waitcnt lgkmcnt(0)" ::: "memory");
}
template <bool F8>
DI void wstrip_q(const float* W, int ldw, int nkb, int kbsh, size_t estride, int rowlen, signed char* W8, int n0, int drow0, float* sb, LAS float* scr, int lane) {
    constexpr float QMAX = F8 ? 224.0f : 127.0f;
    const int kmask = (1 << kbsh) - 1;
    float m4[4] = {0.f, 0.f, 0.f, 0.f};
    for (int kb = 0; kb < nkb; ++kb) { f32x4 t[8];
#pragma unroll
        for (int i = 0; i < 8; ++i) { const int idx = lane + 64 * i; t[i] = *(const f32x4*)(W + (size_t)(64 * kb + (idx >> 3)) * ldw + n0 + 4 * (idx & 7)); }
#pragma unroll
        for (int i = 0; i < 8; ++i)
#pragma unroll
            for (int e = 0; e < 4; ++e) m4[e] = fmaxf(m4[e], fabsf(t[i][e])); }
#pragma unroll
    for (int o = 8; o < 64; o <<= 1)
#pragma unroll
        for (int e = 0; e < 4; ++e) m4[e] = fmaxf(m4[e], shx(m4[e], o, lane));
    LAS float* inv = scr + 64 * 33;
    if (lane < 8) {
#pragma unroll
        for (int e = 0; e < 4; ++e) { const float am = m4[e]; sb[drow0 + 4 * lane + e] = am > 0.f ? am * (1.0f / QMAX) : 1.0f; inv[4 * lane + e] = am > 0.f ? QMAX / am : 0.f; } }
    asm volatile("s_waitcnt lgkmcnt(0)" ::: "memory");
    for (int kb = 0; kb < nkb; ++kb) { f32x4 t[8];
#pragma unroll
        for (int i = 0; i < 8; ++i) { const int idx = lane + 64 * i; t[i] = *(const f32x4*)(W + (size_t)(64 * kb + (idx >> 3)) * ldw + n0 + 4 * (idx & 7)); }
#pragma unroll
        for (int i = 0; i < 8; ++i) { const int idx = lane + 64 * i; LAS float* d = scr + (idx >> 3) * 33 + 4 * (idx & 7); d[0] = t[i][0]; d[1] = t[i][1]; d[2] = t[i][2]; d[3] = t[i][3]; }
        asm volatile("s_waitcnt lgkmcnt(0)" ::: "memory");
#pragma unroll
        for (int j = 0; j < 2; ++j) { const int p = lane + 64 * j; const int n = p >> 2, c = p & 3; const float iv = inv[n]; const LAS float* sp = scr + (16 * c) * 33 + n; unsigned w[4];
#pragma unroll
            for (int q = 0; q < 4; ++q) {
                if constexpr (F8) { int pk = 0; pk = __builtin_amdgcn_cvt_pk_fp8_f32(sp[(4 * q) * 33] * iv, sp[(4 * q + 1) * 33] * iv, pk, false); pk = __builtin_amdgcn_cvt_pk_fp8_f32(sp[(4 * q + 2) * 33] * iv, sp[(4 * q + 3) * 33] * iv, pk, true); w[q] = (unsigned)pk; }
                else { unsigned pk = 0u;
#pragma unroll
                    for (int e = 0; e < 4; ++e) { const int qi = (int)__builtin_rintf(sp[(4 * q + e) * 33] * iv); pk |= ((unsigned)qi & 0xffu) << (8 * e); }
                    w[q] = pk; } }
            *(u32x4*)(W8 + (size_t)(kb >> kbsh) * estride + (size_t)(drow0 + n) * rowlen + 64 * (kb & kmask) + 16 * c) = (u32x4){w[0], w[1], w[2], w[3]}; }
        asm volatile("s_waitcnt lgkmcnt(0)" ::: "memory"); }
}
DI void wstrip_i8(const float* W, int ldw, signed char* W8, int n0, int drow0, float* sb, LAS float* scr, int lane) { wstrip_q<false>(W, ldw, 16, 4, 0, 1024, W8, n0, drow0, sb, scr, lane); }
template <bool F8, int NB>
DI void wstrip_blk(LAS unsigned char* lds, int wave, int lane_in, const float* W, int ldw, int kbsh, size_t estride, int rowlen, signed char* W8, int n0, int drow0, float* sb, int par) {
    constexpr float QMAX = F8 ? 224.0f : 127.0f;
    int lane = lane_in; asm volatile("" : "+v"(lane));
    const int kmask = (1 << kbsh) - 1;
    LAS float* scr = (LAS float*)(lds + wave * 16384);
    LAS float* amx = (LAS float*)(lds + 131072 + par * 1024);
    f32x4 t[NB][8];
    const GAS char* wb = (const GAS char*)(W + (size_t)(64 * NB * wave) * ldw + n0); const unsigned lo = (unsigned)(((lane >> 3) * ldw + 4 * (lane & 7)) * 4);
#pragma unroll
    for (int b = 0; b < NB; ++b)
#pragma unroll
        for (int i = 0; i < 8; ++i) t[b][i] = *(const GAS f32x4*)(wb + (size_t)(64 * b + 8 * i) * ldw * 4 + lo);
    float m4[4] = {0.f, 0.f, 0.f, 0.f};
#pragma unroll
    for (int b = 0; b < NB; ++b)
#pragma unroll
        for (int i = 0; i < 8; ++i)
#pragma unroll
            for (int e = 0; e < 4; ++e) m4[e] = fmaxf(m4[e], fabsf(t[b][i][e]));
#pragma unroll
    for (int o = 8; o < 64; o <<= 1)
#pragma unroll
        for (int e = 0; e < 4; ++e) m4[e] = fmaxf(m4[e], shx(m4[e], o, lane));
    if (lane < 8) *(LAS f32x4*)(amx + wave * 32 + 4 * lane) = (f32x4){m4[0], m4[1], m4[2], m4[3]};
    __syncthreads();
    LAS float* inv = scr + 64 * 33;
    if (lane < 32) { float am = 0.f;
#pragma unroll
        for (int w = 0; w < 8; ++w) am = fmaxf(am, amx[w * 32 + lane]);
        inv[lane] = am > 0.f ? QMAX / am : 0.f; if (wave == 0) sb[drow0 + lane] = am > 0.f ? am * (1.0f / QMAX) : 1.0f; }
    asm volatile("s_waitcnt lgkmcnt(0)" ::: "memory");
#pragma unroll
    for (int b = 0; b < NB; ++b) { const int kb = NB * wave + b;
#pragma unroll
        for (int i = 0; i < 8; ++i) { const int idx = lane + 64 * i; LAS float* d = scr + (idx >> 3) * 33 + 4 * (idx & 7); d[0] = t[b][i][0]; d[1] = t[b][i][1]; d[2] = t[b][i][2]; d[3] = t[b][i][3]; }
        asm volatile("s_waitcnt lgkmcnt(0)" ::: "memory");
#pragma unroll
        for (int j = 0; j < 2; ++j) { const int p = lane + 64 * j; const int n = p >> 2, c = p & 3; const float iv = inv[n]; const LAS float* sp = scr + (16 * c) * 33 + n; unsigned w[4];
#pragma unroll
            for (int q = 0; q < 4; ++q) {
                if constexpr (F8) { int pk = 0; pk = __builtin_amdgcn_cvt_pk_fp8_f32(sp[(4 * q) * 33] * iv, sp[(4 * q + 1) * 33] * iv, pk, false); pk = __builtin_amdgcn_cvt_pk_fp8_f32(sp[(4 * q + 2) * 33] * iv, sp[(4 * q + 3) * 33] * iv, pk, true); w[q] = (unsigned)pk; }
                else { unsigned pk = 0u;
#pragma unroll
                    for (int e = 0; e < 4; ++e) { const int qi = (int)__builtin_rintf(sp[(4 * q + e) * 33] * iv); pk |= ((unsigned)qi & 0xffu) << (8 * e); }
                    w[q] = pk; } }
            GAS char* db = (GAS char*)W8 + (size_t)(kb >> kbsh) * estride + (size_t)(drow0 + 16 * j) * rowlen + 64 * (kb & kmask);
            *(GAS u32x4*)(db + (unsigned)((lane >> 2) * rowlen + 16 * c)) = (u32x4){w[0], w[1], w[2], w[3]}; }
        asm volatile("s_waitcnt lgkmcnt(0)" ::: "memory"); }
}
DI void p0_prologue(Frame& F) {
    unsigned char* const ws = KWS;
    const int gw = blockIdx.x * NWAVES + F.wave, NGW = F.G * NWAVES;
    const int gtid = blockIdx.x * 512 + F.tid, NT = F.G * 512;
    {
        LAS float* scr = (LAS float*)(F.lds + F.wave * 16384);
        constexpr int I_O = 16 * 32, I_D = 8 * 32;
        constexpr int S_QKV = 2 * 48, S_IN = 2 * 96, S_GO = 2 * 32, S_AO = 2 * 32, S_GU = 64 * 32, N_STRIPS = S_QKV + S_IN + S_GO + S_AO + S_GU;
        { int cnt = 0;
          for (int it = blockIdx.x; it < 512 + N_STRIPS; it += F.G, ++cnt) { const int par = cnt & 1;
            if (it < 512) { const int lg = it >> 5, nb = it & 31;
                wstrip_blk<true, 4>(F.lds, F.wave, F.lane, KIN(I_MD) + (size_t)lg * 4 * 512 * 1024, 1024, 3, (size_t)1024 * 512, 512, (signed char*)(ws + WS_WD) + (size_t)lg * 4 * 1024 * 512, 32 * nb, 32 * nb, (float*)(ws + WS_SBD) + lg * 1024, par); continue; }
            int r = it - 512;
            if (r < S_QKV) { const int j = r / 48, nb = r % 48; wstrip_blk<false, 2>(F.lds, F.wave, F.lane, KIN(I_WQKV) + (size_t)j * 1024 * NQKV, NQKV, 4, 0, 1024, (signed char*)(ws + WS_WQKV) + (size_t)j * NQKV * 1024, 32 * nb, 32 * nb, (float*)(ws + WS_SBQKV) + j * NQKV, par); continue; } r -= S_QKV;
            if (r < S_IN) { const int j = r / 96, nb = r % 96; wstrip_blk<false, 2>(F.lds, F.wave, F.lane, KIN(I_GWIN) + (size_t)j * 1024 * 3072, 3072, 4, 0, 1024, (signed char*)(ws + WS_WIN) + (size_t)j * NGIN * 1024, 32 * nb, 32 * nb, (float*)(ws + WS_SBIN) + j * NGIN, par); continue; } r -= S_IN;
            if (r < S_GO) { const int j = r / 32, nb = r % 32; wstrip_blk<false, 2>(F.lds, F.wave, F.lane, KIN(I_GWO) + (size_t)j * 1024 * 1024, 1024, 4, 0, 1024, (signed char*)(ws + WS_WGO) + (size_t)j * 1024 * 1024, 32 * nb, 32 * nb, (float*)(ws + WS_SBGO) + j * 1024, par); continue; } r -= S_GO;
            if (r < S_AO) { const int j = r / 32, nb = r % 32; wstrip_blk<true, 2>(F.lds, F.wave, F.lane, KIN(I_WO) + (size_t)j * 1024 * 1024, 1024, 4, 0, 1024, (signed char*)(ws + WS_WO) + (size_t)j * 1024 * 1024, 32 * nb, 32 * nb, (float*)(ws + WS_SBO) + j * 1024, par); continue; } r -= S_AO;
            { const int le = r >> 5, q = r & 31, up = q >> 4, nb = q & 15; const int n0 = 32 * nb;
              wstrip_blk<false, 2>(F.lds, F.wave, F.lane, (up ? KIN(I_MU) : KIN(I_MG)) + (size_t)le * 1024 * 512, 512, 4, 0, 1024, (signed char*)(ws + WS_WGU) + (size_t)le * 1024 * 1024, n0, (n0 >> 7) * 256 + up * 128 + (n0 & 127), (float*)(ws + WS_SBGU) + le * 1024, par); } } }
        { const float* wa1 = KIN(I_GWA1); signed char* Win8 = (signed char*)(ws + WS_WIN); float* sbin = (float*)(ws + WS_SBIN);
          for (int rw = gw; rw < 2 * 256; rw += NGW) { const int j = rw >> 8, rr = rw & 255; float v[16]; float am = 0.f;
#pragma unroll
              for (int e = 0; e < 16; ++e) { v[e] = rr < 32 ? wa1[(((size_t)j * 2 + (rr >> 4)) * 1024 + 16 * F.lane + e) * 16 + (rr & 15)] : 0.f; am = fmaxf(am, fabsf(v[e])); }
#pragma unroll
              for (int o = 1; o < 64; o <<= 1) am = fmaxf(am, shx(am, o, F.lane));
              const float iv = am > 0.f ? 127.0f / am : 0.f; unsigned w[4];
#pragma unroll
              for (int q = 0; q < 4; ++q) { unsigned pk = 0u;
#pragma unroll
                  for (int e = 0; e < 4; ++e) { const int qi = (int)__builtin_rintf(v[4 * q + e] * iv); pk |= ((unsigned)qi & 0xffu) << (8 * e); }
                  w[q] = pk; }
              *(u32x4*)(Win8 + ((size_t)j * NGIN + 3072 + rr) * 1024 + 16 * F.lane) = (u32x4){w[0], w[1], w[2], w[3]};
              if (F.lane == 0) sbin[j * NGIN + 3072 + rr] = am > 0.f ? am * (1.0f / 127.0f) : 1.0f; } }
    }
    __syncthreads();
    {
        LAS float* sl = (LAS float*)F.lds;
        LAS float* red = (LAS float*)(F.lds + 40960);
        float* modp = ((float*)(ws + WS_MOD));
        const int kq = F.wave & 3, chh = F.wave >> 2;
        for (int it = blockIdx.x; it < 4 * 48; it += F.G) {
            const int l = it / 48, n0 = (it % 48) * 128;
            const float* W = KIN(I_ADAW) + (size_t)l * 1024 * 6144 + n0 + 64 * chh + F.lane; const float* cin = KIN(I_C); const float* ccin = KIN(I_CCTX); const float* adab = KIN(I_ADAB);
            float acc[33];
#pragma unroll
            for (int i = 0; i < 33; ++i) acc[i] = 0.f;
            for (int kc = 0; kc < 4; ++kc) {
                __syncthreads();
                for (int idx = F.tid; idx < 33 * 256; idx += 512) { const int mb = idx >> 8, k = idx & 255; const float cv = mb < 32 ? cin[mb * 1024 + kc * 256 + k] : ccin[kc * 256 + k]; sl[k * 36 + mb] = siluf_(cv); }
                __syncthreads();
                for (int kk0 = 0; kk0 < 64; kk0 += 16) { float wv[16];
#pragma unroll
                    for (int i = 0; i < 16; ++i) wv[i] = W[(size_t)(kc * 256 + kq * 64 + kk0 + i) * 6144];
#pragma unroll
                    for (int i = 0; i < 16; ++i) { const int k = kq * 64 + kk0 + i; const LAS f32x4* sp = (const LAS f32x4*)(sl + k * 36);
#pragma unroll
                        for (int q = 0; q < 8; ++q) { const f32x4 s4 = sp[q]; acc[4 * q] += s4[0] * wv[i]; acc[4 * q + 1] += s4[1] * wv[i]; acc[4 * q + 2] += s4[2] * wv[i]; acc[4 * q + 3] += s4[3] * wv[i]; }
                        acc[32] += sl[k * 36 + 32] * wv[i]; } }
            }
#pragma unroll
            for (int i = 0; i < 33; ++i) red[(kq * 33 + i) * 128 + 64 * chh + F.lane] = acc[i];
            __syncthreads();
            for (int idx = F.tid; idx < 33 * 128; idx += 512) { const int mb = idx >> 7, nn = idx & 127; float sm = 0.f;
#pragma unroll
                for (int q = 0; q < 4; ++q) sm += red[(q * 33 + mb) * 128 + nn];
                modp[((size_t)l * 33 + mb) * 6144 + n0 + nn] = sm + adab[l * 6144 + n0 + nn]; }
            __syncthreads();
        }
    }
    if (blockIdx.x == 0) { float* ropep = ((float*)(ws + WS_ROPE)); for (int idx = F.tid; idx < 64 * 16; idx += 512) { const int pos = idx >> 4, j = idx & 15;
        const float inv = __builtin_amdgcn_exp2f(-(float)j * 0.8304820237218406f); const float ang = (float)pos * inv;
        const float kq = rintf(ang * 0.15915494309189535f); float r = fmaf(-kq, 6.28318548202514648f, ang); r = fmaf(-kq, -1.7484556000744883e-7f, r);
        ropep[pos * 32 + j] = cosf(r); ropep[pos * 32 + 16 + j] = sinf(r); } }
}

DI int moe_table(Frame& F, int layer) {
    LAS int* bs = (LAS int*)(F.lds + MOE_TAB_OFF); LAS int* cnt = bs + 32;
    __syncthreads();
    if (F.tid < NCLS) cnt[F.tid] = (int)__hip_atomic_load((unsigned*)KWS + CW_MOE + 32 * layer + F.tid, __ATOMIC_RELAXED, __HIP_MEMORY_SCOPE_AGENT);
    __syncthreads();
    if (F.tid == 0) { int a = 0; for (int k = 0; k < NCLS; ++k) { bs[k] = a; a += (cnt[k] + 255) >> 8; } bs[NCLS] = a; }
    __syncthreads();
    return __builtin_amdgcn_readfirstlane(bs[NCLS]);
}
DI void unpack16(const u32x4& a, const u32x4& b, float (&v)[16]) {
    v[0] = bf_lo(a.x); v[1] = bf_hi(a.x); v[2] = bf_lo(a.y); v[3] = bf_hi(a.y); v[4] = bf_lo(a.z); v[5] = bf_hi(a.z); v[6] = bf_lo(a.w); v[7] = bf_hi(a.w);
    v[8] = bf_lo(b.x); v[9] = bf_hi(b.x); v[10] = bf_lo(b.y); v[11] = bf_hi(b.y); v[12] = bf_lo(b.z); v[13] = bf_hi(b.z); v[14] = bf_lo(b.w); v[15] = bf_hi(b.w);
}
DI void unpack16_f8(unsigned a0, unsigned a1, unsigned b0, unsigned b1, float (&v)[16]) {
    f32x2 t;
    t = __builtin_amdgcn_cvt_pk_f32_fp8((int)a0, false); v[0] = t.x; v[1] = t.y; t = __builtin_amdgcn_cvt_pk_f32_fp8((int)a0, true); v[2] = t.x; v[3] = t.y;
    t = __builtin_amdgcn_cvt_pk_f32_fp8((int)a1, false); v[4] = t.x; v[5] = t.y; t = __builtin_amdgcn_cvt_pk_f32_fp8((int)a1, true); v[6] = t.x; v[7] = t.y;
    t = __builtin_amdgcn_cvt_pk_f32_fp8((int)b0, false); v[8] = t.x; v[9] = t.y; t = __builtin_amdgcn_cvt_pk_f32_fp8((int)b0, true); v[10] = t.x; v[11] = t.y;
    t = __builtin_amdgcn_cvt_pk_f32_fp8((int)b1, false); v[12] = t.x; v[13] = t.y; t = __builtin_amdgcn_cvt_pk_f32_fp8((int)b1, true); v[14] = t.x; v[15] = t.y;
}
DI void pack16(const float (&v)[16], u32x4& a, u32x4& b) {
    a.x = cvt_pk_bf16(v[0], v[1]); a.y = cvt_pk_bf16(v[2], v[3]); a.z = cvt_pk_bf16(v[4], v[5]); a.w = cvt_pk_bf16(v[6], v[7]);
    b.x = cvt_pk_bf16(v[8], v[9]); b.y = cvt_pk_bf16(v[10], v[11]); b.z = cvt_pk_bf16(v[12], v[13]); b.w = cvt_pk_bf16(v[14], v[15]);
}
DI float quant_row_i8(const float (&v)[16], signed char* dst_row, int c0, int lane) {
    float am = 0.f;
#pragma unroll
    for (int e = 0; e < 16; ++e) am = fmaxf(am, fabsf(v[e]));
    am = wave_max(am, lane);
    const float inv = am > 0.f ? 127.0f / am : 0.f;
    unsigned w[4];
#pragma unroll
    for (int q = 0; q < 4; ++q) { unsigned p = 0u;
#pragma unroll
        for (int e = 0; e < 4; ++e) { const int qi = (int)__builtin_rintf(v[4 * q + e] * inv); p |= ((unsigned)qi & 0xffu) << (8 * e); }
        w[q] = p; }
    *(u32x2*)(dst_row + c0) = (u32x2){w[0], w[1]}; *(u32x2*)(dst_row + 512 + c0) = (u32x2){w[2], w[3]};
    return am * (1.0f / 127.0f);
}
template <bool ROUTER>
DI void norm_phase(Frame& F, int layer) {
    unsigned char* const ws = KWS;
    const float* gain = (ROUTER ? KIN(I_NFFN) : KIN(I_NMIX)) + layer * 1024;
    const float* modl = (const float*)(ws + WS_MOD) + (size_t)layer * 33 * 6144 + (ROUTER ? 3 * 1024 : 0);
    const float* gatel = ROUTER ? (const float*)(ws + WS_MOD) + (size_t)layer * 33 * 6144 + 2 * 1024 : (const float*)(ws + WS_MOD) + (size_t)(layer > 0 ? layer - 1 : 0) * 33 * 6144 + 5 * 1024;
    const int ymode = ROUTER ? 1 : (layer > 0 ? 2 : 0);
    const bool src32 = !ROUTER && layer == 0;
    bf16_t* XRp = (bf16_t*)(ws + WS_XR); bf16_t* Hp = (bf16_t*)(ws + WS_H);
    const unsigned char* Yp = ROUTER ? (const unsigned char*)(ws + WS_H) : (const unsigned char*)(ws + WS_R3);
    const int* tokpos = (const int*)(ws + WS_TOKPOS);
    const float* xin = nullptr; const float* cxin = nullptr;
    if (!ROUTER) { xin = KIN(I_X); cxin = KIN(I_CTX); if (ymode == 2) (void)moe_table(F, layer - 1); }
    const LAS int* bs = (const LAS int*)(F.lds + MOE_TAB_OFF);
    const int NROWS = (ROUTER && layer == DEPTH - 1) ? NL : MT;
    const int RPB = (NROWS + F.G - 1) / F.G, RPW = (RPB + 7) / 8;
    const int brow0 = blockIdx.x * RPB; int bend = brow0 + RPB; if (bend > NROWS) bend = NROWS;
    const int row0 = brow0 + F.wave * RPW; int rend = row0 + RPW; if (rend > bend) rend = bend;
    LAS float* RW = (LAS float*)F.lds;
    LAS float* WL = (LAS float*)(F.lds + 67584) + F.wave * 64;
    LAS int* lcnt = (LAS int*)(F.lds + 69632); LAS int* lbase = (LAS int*)(F.lds + 69760);
    LAS int* rec = (LAS int*)(F.lds + 69888); LAS f32x2* recg = (LAS f32x2*)(F.lds + 73984);
    float rb[16];
    if (ROUTER) {
        const float* rwp = KIN(I_RW); const float* rbp = KIN(I_RB);
        for (int idx = F.tid; idx < 1024 * 16; idx += 512) { const int col = idx >> 4, e = idx & 15; RW[(col >> 3) * 132 + (col & 7) * 16 + e] = rwp[idx]; }
        if (F.tid < 32) lcnt[F.tid] = 0;
#pragma unroll
        for (int e = 0; e < 16; ++e) rb[e] = rbp[e];
        __syncthreads();
    }
    float gs[16], sh[16], gy[16]; int mb = -1;
    const int c0 = 8 * F.lane;
    constexpr int NBR = ROUTER ? 2 : 4;
    u32x4 xa[NBR], xb[NBR], ya[NBR], yb[NBR]; f32x4 xs[NBR][4];
    u32x4 nxa[NBR], nxb[NBR], nya[NBR], nyb[NBR]; f32x4 nxs[NBR][4];
#define NORM_LOAD(XA, XB, YA, YB, XS, rowb_) do { _Pragma("unroll") for (int u = 0; u < NBR; ++u) { const int rr = (rowb_) + u < rend ? (rowb_) + u : rend - 1; \
            if (!ROUTER && src32) { const float* src = rr < NL ? xin + (size_t)rr * 1024 : cxin + (size_t)(rr - NL) * 1024; \
                XS[u][0] = *(const f32x4*)(src + c0); XS[u][1] = *(const f32x4*)(src + c0 + 4); XS[u][2] = *(const f32x4*)(src + 512 + c0); XS[u][3] = *(const f32x4*)(src + 512 + c0 + 4); } \
            else { const bf16_t* xr = XRp + (size_t)rr * 1024; XA[u] = *(const u32x4*)(xr + c0); XB[u] = *(const u32x4*)(xr + 512 + c0); } \
            if (ymode) { size_t yrow = (size_t)rr; if (!ROUTER) { const int tp = tokpos[rr]; yrow = (size_t)bs[tp & 0xff] * 256 + (size_t)(tp >> 8); } \
                const unsigned char* yr = Yp + yrow * 1024; const u32x2 ta_ = *(const u32x2*)(yr + c0), tb_ = *(const u32x2*)(yr + 512 + c0); YA[u].x = ta_.x; YA[u].y = ta_.y; YB[u].x = tb_.x; YB[u].y = tb_.y; } } } while (0)
    constexpr bool PF = ROUTER;
    if (PF) { if (row0 < rend) NORM_LOAD(xa, xb, ya, yb, xs, row0); }
    for (int rowb = row0; rowb < rend; rowb += NBR) {
        if (PF) { if (rowb + NBR < rend) NORM_LOAD(nxa, nxb, nya, nyb, nxs, rowb + NBR); } else NORM_LOAD(xa, xb, ya, yb, xs, rowb);
#pragma unroll
        for (int up = 0; up < NBR; up += 2) {
        float vv[2][16];
#pragma unroll
        for (int u2 = 0; u2 < 2; ++u2) { const int u = up + u2; const int row = rowb + u; float (&v)[16] = vv[u2];
        if (row < rend) {
        const int mbn = row < NL ? (row >> 11) : 32;
        if (mbn != mb) { mb = mbn; const float* mp = modl + (size_t)mb * 6144; const float* gp = gatel + (size_t)mb * 6144;
#pragma unroll
            for (int hh = 0; hh < 2; ++hh)
#pragma unroll
                for (int q = 0; q < 2; ++q) { const int cc = hh * 512 + c0 + 4 * q; const f32x4 g4 = *(const f32x4*)(gain + cc), s4 = *(const f32x4*)(mp + 1024 + cc), h4 = *(const f32x4*)(mp + cc), y4 = *(const f32x4*)(gp + cc);
#pragma unroll
                    for (int e = 0; e < 4; ++e) { gs[hh * 8 + q * 4 + e] = g4[e] * (1.0f + s4[e]); sh[hh * 8 + q * 4 + e] = h4[e]; gy[hh * 8 + q * 4 + e] = y4[e] * (1.0f / Y_SCALE); } } }
        if (!ROUTER && src32) {
#pragma unroll
            for (int q = 0; q < 4; ++q)
#pragma unroll
                for (int e = 0; e < 4; ++e) v[4 * q + e] = xs[u][q][e]; }
        else unpack16(xa[u], xb[u], v);
        if (ymode) { float yv[16]; unpack16_f8(ya[u].x, ya[u].y, yb[u].x, yb[u].y, yv);
#pragma unroll
            for (int e = 0; e < 16; ++e) v[e] += gy[e] * yv[e]; }
        if (ymode || src32) { u32x4 wa, wb; pack16(v, wa, wb); bf16_t* xw = XRp + (size_t)row * 1024; *(u32x4*)(xw + c0) = wa; *(u32x4*)(xw + 512 + c0) = wb; }
        float ss = 0.f;
#pragma unroll
        for (int e = 0; e < 16; ++e) ss += v[e] * v[e];
        ss = wave_sum(ss, F.lane);
        const float rstd = 1.0f / sqrtf(ss * (1.0f / 1024.0f) + RMS_EPS);
#pragma unroll
        for (int e = 0; e < 16; ++e) v[e] = v[e] * rstd * gs[e] + sh[e];
        if (ROUTER) { u32x4 oa, ob; pack16(v, oa, ob); bf16_t* hr = Hp + (size_t)row * 1024; *(u32x4*)(hr + c0) = oa; *(u32x4*)(hr + 512 + c0) = ob; }
        else { const float sc_ = quant_row_i8(v, (signed char*)Hp + (size_t)row * 1024, c0, F.lane); if (F.lane == 0) ((float*)(ws + WS_SA))[row] = sc_; }
        } else {
#pragma unroll
            for (int e = 0; e < 16; ++e) v[e] = 0.f; }
        }
        if (ROUTER) {
            float pl[2][16];
#pragma unroll
            for (int u = 0; u < 2; ++u)
#pragma unroll
                for (int e = 0; e < 16; ++e) pl[u][e] = 0.f;
#pragma unroll
            for (int jj = 0; jj < 16; ++jj) { const LAS f32x4* wp = (const LAS f32x4*)(RW + ((jj >> 3) * 64 + F.lane) * 132 + (jj & 7) * 16);
#pragma unroll
                for (int q = 0; q < 4; ++q) { const f32x4 w4 = wp[q];
#pragma unroll
                    for (int u = 0; u < 2; ++u) { const float x = vv[u][jj]; pl[u][4 * q] += x * w4[0]; pl[u][4 * q + 1] += x * w4[1]; pl[u][4 * q + 2] += x * w4[2]; pl[u][4 * q + 3] += x * w4[3]; } } }
#pragma unroll
            for (int u = 0; u < 2; ++u) {
                float v8[8], v4[4], v2[2], v1;
                { const bool bt = (F.lane >> 5) & 1;
#pragma unroll
                  for (int i = 0; i < 8; ++i) { const float mine = bt ? pl[u][8 + i] : pl[u][i], theirs = bt ? pl[u][i] : pl[u][8 + i]; v8[i] = mine + shx(theirs, 32, F.lane); } }
                { const bool bt = (F.lane >> 4) & 1;
#pragma unroll
                  for (int i = 0; i < 4; ++i) { const float mine = bt ? v8[4 + i] : v8[i], theirs = bt ? v8[i] : v8[4 + i]; v4[i] = mine + shx(theirs, 16, F.lane); } }
                { const bool bt = (F.lane >> 3) & 1;
#pragma unroll
                  for (int i = 0; i < 2; ++i) { const float mine = bt ? v4[2 + i] : v4[i], theirs = bt ? v4[i] : v4[2 + i]; v2[i] = mine + shx(theirs, 8, F.lane); } }
                { const bool bt = (F.lane >> 2) & 1; const float mine = bt ? v2[1] : v2[0], theirs = bt ? v2[0] : v2[1]; v1 = mine + shx(theirs, 4, F.lane); }
                v1 += shx(v1, 2, F.lane); v1 += shx(v1, 1, F.lane);
                { const int ei = ((F.lane >> 5) & 1) * 8 + ((F.lane >> 4) & 1) * 4 + ((F.lane >> 3) & 1) * 2 + ((F.lane >> 2) & 1); WL[(F.lane & 3) == 0 ? u * 16 + ei : 32 + (F.lane >> 1)] = v1; }
            }
            asm volatile("s_waitcnt lgkmcnt(0)" ::: "memory");
            const int ur = F.lane & 1;
            float sc[16], sel[16];
#pragma unroll
            for (int q = 0; q < 4; ++q) { const f32x4 l4 = ((const LAS f32x4*)(WL + ur * 16))[q];
#pragma unroll
                for (int e = 0; e < 4; ++e) { sc[4 * q + e] = sigmoidf_(l4[e]); sel[4 * q + e] = sc[4 * q + e] + rb[4 * q + e]; } }
            asm volatile("s_waitcnt lgkmcnt(0)" ::: "memory");
            int grp = 0; float best = -1e30f;
#pragma unroll
            for (int g = 0; g < 4; ++g) { const float a = sel[4 * g], b = sel[4 * g + 1], c = sel[4 * g + 2], d = sel[4 * g + 3];
                const float m1 = fmaxf(fmaxf(a, b), fmaxf(c, d)); const float lo1 = fminf(a, b), hi1 = fmaxf(a, b), lo2 = fminf(c, d), hi2 = fmaxf(c, d);
                const float m2 = fmaxf(fminf(hi1, hi2), fmaxf(lo1, lo2)); const float gsum = m1 + m2;
                if (gsum > best) { best = gsum; grp = g; } }
            float s4[4], c4[4];
#pragma unroll
            for (int e = 0; e < 4; ++e) { s4[e] = grp == 0 ? sel[e] : (grp == 1 ? sel[4 + e] : (grp == 2 ? sel[8 + e] : sel[12 + e])); c4[e] = grp == 0 ? sc[e] : (grp == 1 ? sc[4 + e] : (grp == 2 ? sc[8 + e] : sc[12 + e])); }
            int i1 = 0; float b1 = s4[0];
#pragma unroll
            for (int e = 1; e < 4; ++e) if (s4[e] > b1) { b1 = s4[e]; i1 = e; }
            int i2 = -1; float b2 = -1e30f;
#pragma unroll
            for (int e = 0; e < 4; ++e) if (e != i1 && s4[e] > b2) { b2 = s4[e]; i2 = e; }
            const float g1 = i1 == 0 ? c4[0] : (i1 == 1 ? c4[1] : (i1 == 2 ? c4[2] : c4[3])), g2 = i2 == 0 ? c4[0] : (i2 == 1 ? c4[1] : (i2 == 2 ? c4[2] : c4[3]));
            const float inv = 1.0f / (g1 + g2);
            const int lo = i1 < i2 ? i1 : i2, hi = i1 < i2 ? i2 : i1;
            const int pidx = lo == 0 ? hi - 1 : (lo == 1 ? hi + 1 : 5);
            const int cls = grp * 6 + pidx;
            const float glo = (i1 < i2 ? g1 : g2) * inv, ghi = (i1 < i2 ? g2 : g1) * inv;
            if (F.lane < 2 && rowb + up + F.lane < rend) { const int sl_ = __hip_atomic_fetch_add(lcnt + cls, 1, __ATOMIC_RELAXED, __HIP_MEMORY_SCOPE_WORKGROUP); const int rbi = rowb + up + F.lane - brow0; rec[rbi] = cls | (sl_ << 8); recg[rbi] = (f32x2){glo, ghi}; }
        }
        }
        if (PF) {
#pragma unroll
            for (int u = 0; u < NBR; ++u) { xa[u] = nxa[u]; xb[u] = nxb[u]; ya[u] = nya[u]; yb[u] = nyb[u]; } }
    }
#undef NORM_LOAD
    if (ROUTER) {
        __syncthreads();
        if (F.tid < NCLS) { const int n = lcnt[F.tid]; int base = 0; if (n > 0) base = (int)__hip_atomic_fetch_add((unsigned*)ws + CW_MOE + 32 * layer + F.tid, (unsigned)n, __ATOMIC_RELAXED, __HIP_MEMORY_SCOPE_AGENT); lbase[F.tid] = base; }
        __syncthreads();
        int* listp = (int*)(ws + WS_LIST); f32x2* glistp = (f32x2*)(ws + WS_GLIST); int* tpw = (int*)(ws + WS_TOKPOS);
        for (int rbi = F.tid; rbi < bend - brow0; rbi += 512) { const int rc = rec[rbi]; const int cls = rc & 0xff; const int slot = lbase[cls] + (rc >> 8);
            listp[(size_t)cls * MT + slot] = brow0 + rbi; glistp[(size_t)cls * MT + slot] = recg[rbi]; tpw[brow0 + rbi] = cls | (slot << 8); }
        __syncthreads();
    }
}

DI void route_decide(const float (&lg)[16], const float (&rb)[16], int& cls, float& glo, float& ghi) {
    float sc[16], sel[16];
#pragma unroll
    for (int e = 0; e < 16; ++e) { sc[e] = sigmoidf_(lg[e]); sel[e] = sc[e] + rb[e]; }
    int grp = 0; float best = -1e30f;
#pragma unroll
    for (int g = 0; g < 4; ++g) { const float a = sel[4 * g], b = sel[4 * g + 1], c = sel[4 * g + 2], d = sel[4 * g + 3];
        const float m1 = fmaxf(fmaxf(a, b), fmaxf(c, d)); const float lo1 = fminf(a, b), hi1 = fmaxf(a, b), lo2 = fminf(c, d), hi2 = fmaxf(c, d);
        const float m2 = fmaxf(fminf(hi1, hi2), fmaxf(lo1, lo2)); const float gsum = m1 + m2;
        if (gsum > best) { best = gsum; grp = g; } }
    float s4[4], c4[4];
#pragma unroll
    for (int e = 0; e < 4; ++e) { s4[e] = grp == 0 ? sel[e] : (grp == 1 ? sel[4 + e] : (grp == 2 ? sel[8 + e] : sel[12 + e])); c4[e] = grp == 0 ? sc[e] : (grp == 1 ? sc[4 + e] : (grp == 2 ? sc[8 + e] : sc[12 + e])); }
    int i1 = 0; float b1 = s4[0];
#pragma unroll
    for (int e = 1; e < 4; ++e) if (s4[e] > b1) { b1 = s4[e]; i1 = e; }
    int i2 = -1; float b2 = -1e30f;
#pragma unroll
    for (int e = 0; e < 4; ++e) if (e != i1 && s4[e] > b2) { b2 = s4[e]; i2 = e; }
    const float g1 = i1 == 0 ? c4[0] : (i1 == 1 ? c4[1] : (i1 == 2 ? c4[2] : c4[3])), g2 = i2 == 0 ? c4[0] : (i2 == 1 ? c4[1] : (i2 == 2 ? c4[2] : c4[3]));
    const float inv = 1.0f / (g1 + g2);
    const int lo = i1 < i2 ? i1 : i2, hi = i1 < i2 ? i2 : i1;
    const int pidx = lo == 0 ? hi - 1 : (lo == 1 ? hi + 1 : 5);
    cls = grp * 6 + pidx;
    glo = (i1 < i2 ? g1 : g2) * inv; ghi = (i1 < i2 ? g2 : g1) * inv;
}

DI void n2_phase(Frame& F, int layer) {
    unsigned char* const ws = KWS;
    const float* gain = KIN(I_NFFN) + layer * 1024;
    const float* modl = (const float*)(ws + WS_MOD) + (size_t)layer * 33 * 6144 + 3 * 1024;
    const float* gatel = (const float*)(ws + WS_MOD) + (size_t)layer * 33 * 6144 + 2 * 1024;
    bf16_t* XRp = (bf16_t*)(ws + WS_XR); const unsigned char* Hp = ws + WS_H;
    const int NROWS = (layer == DEPTH - 1) ? NL : MT;
    const int RPB = (NROWS + F.G - 1) / F.G;
    const int brow0 = blockIdx.x * RPB; int bend = brow0 + RPB; if (bend > NROWS) bend = NROWS;
    const int nsteps = (bend - brow0 + 31) >> 5;
    constexpr int AST = 2064;
    LAS unsigned char* AH = F.lds; LAS unsigned char* AL = F.lds + 32 * AST;
    LAS float* PART = (LAS float*)(F.lds + 64 * AST);
    LAS float* RB = (LAS float*)(F.lds + 64 * AST + 16384);
    LAS int* lcnt = (LAS int*)(F.lds + 64 * AST + 16384 + 128); LAS int* lbase = lcnt + 32;
    LAS int* rec = lbase + 32; LAS f32x2* recg = (LAS f32x2*)(rec + 512); LAS float* rsa = (LAS float*)(recg + 512);
    static_assert(64 * AST + 16384 + 128 + 256 + 2048 + 4096 + 2048 <= PHASE_LDS, "N2 LDS map");
    const int i16 = F.lane & 15, qd = F.lane >> 4;
    bf16x8 wfh[4], wfl[4];
    { const float* rwp = KIN(I_RW); const float* rbp = KIN(I_RB);
#pragma unroll
      for (int kk = 0; kk < 4; ++kk) { u32x4 hq, lq;
#pragma unroll
          for (int q = 0; q < 4; ++q) { const int k = 32 * (4 * F.wave + kk) + 8 * qd + 2 * q; const float w0 = rwp[k * 16 + i16], w1 = rwp[(k + 1) * 16 + i16];
              const unsigned hh = cvt_pk_bf16(w0, w1); hq[q] = hh; lq[q] = cvt_pk_bf16(w0 - bf_lo(hh), w1 - bf_hi(hh)); }
          wfh[kk] = __builtin_bit_cast(bf16x8, hq); wfl[kk] = __builtin_bit_cast(bf16x8, lq); }
      if (F.tid < 16) RB[F.tid] = rbp[F.tid];
      if (F.tid < 32) lcnt[F.tid] = 0; }
    __syncthreads();
    float gs[16], sh[16], gy[16]; int mb = -1;
    const int c0 = 8 * F.lane;
    u32x4 xa[4], xb[4], nxa[4], nxb[4]; u32x2 ya[4], yb[4], nya[4], nyb[4];
#define N2_LOAD(XA, XB, YA, YB, st_) do { _Pragma("unroll") for (int u = 0; u < 4; ++u) { int rr = brow0 + 32 * (st_) + 4 * F.wave + u; rr = rr < bend ? rr : bend - 1; \
            const bf16_t* xr = XRp + (size_t)rr * 1024; XA[u] = *(const u32x4*)(xr + c0); XB[u] = *(const u32x4*)(xr + 512 + c0); \
            const unsigned char* yr = Hp + (size_t)rr * 1024; YA[u] = *(const u32x2*)(yr + c0); YB[u] = *(const u32x2*)(yr + 512 + c0); } } while (0)
    if (nsteps > 0) N2_LOAD(xa, xb, ya, yb, 0);
    for (int st = 0; st < nsteps; ++st) {
#pragma unroll
        for (int u = 0; u < 4; ++u) { const int t = 4 * F.wave + u; const int row = brow0 + 32 * st + t;
            u32x4 oa = (u32x4){0u, 0u, 0u, 0u}, ob = oa, la = oa, lb = oa;
            if (row < bend) {
                const int mbn = row < NL ? (row >> 11) : 32;
                if (mbn != mb) { mb = mbn; const float* mp = modl + (size_t)mb * 6144; const float* gp = gatel + (size_t)mb * 6144;
#pragma unroll
                    for (int hh = 0; hh < 2; ++hh)
#pragma unroll
                        for (int q = 0; q < 2; ++q) { const int cc = hh * 512 + c0 + 4 * q; const f32x4 g4 = *(const f32x4*)(gain + cc), s4 = *(const f32x4*)(mp + 1024 + cc), h4 = *(const f32x4*)(mp + cc), y4 = *(const f32x4*)(gp + cc);
#pragma unroll
                            for (int e = 0; e < 4; ++e) { gs[hh * 8 + q * 4 + e] = g4[e] * (1.0f + s4[e]); sh[hh * 8 + q * 4 + e] = h4[e]; gy[hh * 8 + q * 4 + e] = y4[e] * (1.0f / Y_SCALE); } } }
                float v[16], yv[16]; unpack16(xa[u], xb[u], v); unpack16_f8(ya[u].x, ya[u].y, yb[u].x, yb[u].y, yv);
#pragma unroll
                for (int e = 0; e < 16; ++e) v[e] += gy[e] * yv[e];
                { u32x4 wa, wb; pack16(v, wa, wb); bf16_t* xw = XRp + (size_t)row * 1024; *(u32x4*)(xw + c0) = wa; *(u32x4*)(xw + 512 + c0) = wb; }
                float ss = 0.f;
#pragma unroll
                for (int e = 0; e < 16; ++e) ss += v[e] * v[e];
                ss = wave_sum(ss, F.lane);
                const float rstd = 1.0f / sqrtf(ss * (1.0f / 1024.0f) + RMS_EPS);
#pragma unroll
                for (int e = 0; e < 16; ++e) v[e] = v[e] * rstd * gs[e] + sh[e];
                pack16(v, oa, ob);
                { const float sc_ = quant_row_i8(v, (signed char*)(ws + WS_R3) + (size_t)row * 1024, c0, F.lane); if (F.lane == 0) rsa[row - brow0] = sc_; }
                float lo[16]; { float hv[16]; unpack16(oa, ob, hv);
#pragma unroll
                    for (int e = 0; e < 16; ++e) lo[e] = v[e] - hv[e]; }
                pack16(lo, la, lb);
            }
            *(LAS u32x4*)(AH + t * AST + 2 * c0) = oa; *(LAS u32x4*)(AH + t * AST + 1024 + 2 * c0) = ob;
            *(LAS u32x4*)(AL + t * AST + 2 * c0) = la; *(LAS u32x4*)(AL + t * AST + 1024 + 2 * c0) = lb; }
        if (st + 1 < nsteps) N2_LOAD(nxa, nxb, nya, nyb, st + 1);
        __syncthreads();
#pragma unroll
        for (int rt = 0; rt < 2; ++rt) { f32x4 acc = (f32x4){0.f, 0.f, 0.f, 0.f};
#pragma unroll
          for (int kk = 0; kk < 4; ++kk) { const int ko = (32 * (4 * F.wave + kk) + 8 * qd) * 2;
              const bf16x8 fh = *(const LAS bf16x8*)(AH + (16 * rt + i16) * AST + ko), fl = *(const LAS bf16x8*)(AL + (16 * rt + i16) * AST + ko);
              acc = MFMA16(wfh[kk], fh, acc); acc = MFMA16(wfh[kk], fl, acc); acc = MFMA16(wfl[kk], fh, acc); }
          *(LAS f32x4*)(PART + ((F.wave * 32 + 16 * rt + i16) * 16) + 4 * qd) = acc; }
        __syncthreads();
        if (F.wave == (st & 7)) { const int l32 = F.lane & 31;
            float lg[16], rb[16];
#pragma unroll
            for (int e = 0; e < 16; ++e) lg[e] = 0.f;
#pragma unroll
            for (int w = 0; w < 8; ++w)
#pragma unroll
                for (int q = 0; q < 4; ++q) { const f32x4 p4 = *(const LAS f32x4*)(PART + ((w * 32 + l32) * 16) + 4 * q); lg[4 * q] += p4[0]; lg[4 * q + 1] += p4[1]; lg[4 * q + 2] += p4[2]; lg[4 * q + 3] += p4[3]; }
#pragma unroll
            for (int q = 0; q < 4; ++q) { const f32x4 r4 = ((const LAS f32x4*)RB)[q]; rb[4 * q] = r4[0]; rb[4 * q + 1] = r4[1]; rb[4 * q + 2] = r4[2]; rb[4 * q + 3] = r4[3]; }
            int cls; float glo, ghi; route_decide(lg, rb, cls, glo, ghi);
            const int rbi = 32 * st + F.lane;
            if (F.lane < 32 && brow0 + rbi < bend) { const int sl_ = __hip_atomic_fetch_add(lcnt + cls, 1, __ATOMIC_RELAXED, __HIP_MEMORY_SCOPE_WORKGROUP); rec[rbi] = cls | (sl_ << 8); recg[rbi] = (f32x2){glo, ghi}; }
        }
#pragma unroll
        for (int u = 0; u < 4; ++u) { xa[u] = nxa[u]; xb[u] = nxb[u]; ya[u] = nya[u]; yb[u] = nyb[u]; }
    }
#undef N2_LOAD
    __syncthreads();
    if (F.tid < NCLS) { const int n = lcnt[F.tid]; int base = 0; if (n > 0) base = (int)__hip_atomic_fetch_add((unsigned*)ws + CW_MOE + 32 * layer + F.tid, (unsigned)n, __ATOMIC_RELAXED, __HIP_MEMORY_SCOPE_AGENT); lbase[F.tid] = base; }
    __syncthreads();
    int* listp = (int*)(ws + WS_LIST); f32x2* glistp = (f32x2*)(ws + WS_GLIST); int* tpw = (int*)(ws + WS_TOKPOS); float* slistp = (float*)(ws + WS_SLIST);
    for (int rbi = F.tid; rbi < bend - brow0; rbi += 512) { const int rc = rec[rbi]; const int cls = rc & 0xff; const int slot = lbase[cls] + (rc >> 8);
        listp[(size_t)cls * MT + slot] = brow0 + rbi; glistp[(size_t)cls * MT + slot] = recg[rbi]; slistp[(size_t)cls * MT + slot] = rsa[rbi]; tpw[brow0 + rbi] = cls | (slot << 8); }
    __syncthreads();
}

DI void attn_phase(Frame& F, int j, unsigned long long& pacc) {
    unsigned char* const ws = KWS; const bf16_t* P = (const bf16_t*)(ws + WS_R2); unsigned char* O = ws + WS_R3; const float* sinks = KIN(I_SINKS);
    const int lane = F.lane, wave = F.wave, tid = F.tid, r32 = lane & 31, hi = lane >> 5;
    const int g = wave & 3, qh = wave >> 2;
    LAS unsigned char* KB = F.lds; LAS unsigned char* VB = F.lds + 2 * 18432;
    const int i16 = lane & 15, tq = i16 >> 2, tp = i16 & 3, blk = (lane >> 4) & 1;
    const int nunits = 2048 + 256;
#if PROBE_ATT
    unsigned long long atp_ = __builtin_amdgcn_s_memrealtime();
#define ATTT(k) do { const unsigned long long tn_ = __builtin_amdgcn_s_memrealtime(); if (PROBE_ATT == (k)) pacc += tn_ - atp_; atp_ = tn_; } while (0)
#else
#define ATTT(k) do { } while (0)
#endif
    struct AU { int b, kvh, s, qrow0, klo, nwin; };
#define ATT_DECODE(U, u_) do { const int uu_ = (u_); if (uu_ < 2048) { U.b = uu_ >> 6; U.kvh = (uu_ >> 4) & 3; U.s = (uu_ & 15) * 128; U.qrow0 = U.b * SEQ + U.s; U.klo = U.s - 128 < 0 ? 0 : U.s - 128; \
            const int khi_ = U.s + 256 > SEQ ? SEQ : U.s + 256; U.nwin = (khi_ - U.klo) >> 7; } \
        else { const int v_ = uu_ - 2048; U.b = v_ >> 3; U.kvh = (v_ >> 1) & 3; U.s = (v_ & 1) * 128; U.qrow0 = NL + U.b * CTX + U.s; U.klo = 0; U.nwin = 0; } } while (0)
#define ATT_CHROW(U, ch) ((ch) < U.nwin ? (U.b * SEQ + U.klo + 128 * (ch)) : (NL + U.b * CTX + 128 * ((ch) - U.nwin)))
#define ATT_LOAD(U, ch) do { const int cr_ = ATT_CHROW(U, ch); _Pragma("unroll") for (int i_ = 0; i_ < 2; ++i_) { const int p_ = tid + 512 * i_; const bf16_t* src_ = P + (size_t)(cr_ + (p_ >> 3)) * NQKV + 1024 + U.kvh * 64 + (p_ & 7) * 8; \
            kst[i_] = *(const u32x4*)src_; vst[i_] = *(const u32x4*)(src_ + 256); } } while (0)
#define ATT_STORE(bufi) do { _Pragma("unroll") for (int i_ = 0; i_ < 2; ++i_) { const int p_ = tid + 512 * i_; const int off_ = (bufi) * 18432 + (p_ >> 3) * 144 + (p_ & 7) * 16; \
            *(LAS u32x4*)(KB + off_) = kst[i_]; *(LAS u32x4*)(VB + off_) = vst[i_]; } } while (0)
#define ATT_LOADQ(U) do { _Pragma("unroll") for (int gr = 0; gr < 2; ++gr) { const bf16_t* qp = P + (size_t)(U.qrow0 + 64 * gr + 32 * qh + r32) * NQKV + (U.kvh * 4 + g) * 64 + 8 * hi; \
            _Pragma("unroll") for (int ks = 0; ks < 4; ++ks) qf[gr][ks] = *(const bf16x8*)(qp + 16 * ks); } } while (0)
    float sk4[4];
#pragma unroll
    for (int kk = 0; kk < 4; ++kk) sk4[kk] = sinks[j * 16 + kk * 4 + g] * LOG2E;
    u32x4 kst[2], vst[2]; bf16x8 qf[2][4];
    AU UC, UN;
    if ((int)blockIdx.x < nunits) { ATT_DECODE(UC, (int)blockIdx.x); ATT_LOAD(UC, 0); ATT_LOADQ(UC); }
    for (int u = blockIdx.x; u < nunits; u += F.G) {
        const bool has_next = u + F.G < nunits;
        if (has_next) ATT_DECODE(UN, u + F.G); else UN = UC;
        const int s = UC.s, qrow0 = UC.qrow0, klo = UC.klo, nwin = UC.nwin, nch = UC.nwin + 2, hq = UC.kvh * 4 + g;
        const float sink2 = UC.kvh == 0 ? sk4[0] : (UC.kvh == 1 ? sk4[1] : (UC.kvh == 2 ? sk4[2] : sk4[3]));
        float mrun[2], lrun[2]; f32x16 o[2][2];
#pragma unroll
        for (int gr = 0; gr < 2; ++gr) { mrun[gr] = sink2; lrun[gr] = hi == 0 ? 1.0f : 0.0f;
#pragma unroll
            for (int d0 = 0; d0 < 2; ++d0)
#pragma unroll
                for (int i = 0; i < 16; ++i) o[gr][d0][i] = 0.f; }
        __syncthreads();
        ATT_STORE(0);
        __syncthreads();
        ATTT(3);
        for (int ch = 0; ch < nch; ++ch) {
            const int buf = ch & 1;
            if (ch + 1 < nch) ATT_LOAD(UC, ch + 1); else if (has_next) ATT_LOAD(UN, 0);
            ATTT(2);
            const bool masked = ch < nwin; const int kpos0 = klo + 128 * ch;
            const LAS unsigned char* kb = KB + buf * 18432; const LAS unsigned char* vb = VB + buf * 18432;
#pragma unroll 1
            for (int kt = 0; kt < 4; ++kt) {
                int tmode[2] = {0, 0};
                if (masked) {
#pragma unroll
                    for (int gr = 0; gr < 2; ++gr) { const int q0 = s + 64 * gr + 32 * qh; const int dmin = q0 - (kpos0 + 32 * kt + 31), dmax = (q0 + 31) - (kpos0 + 32 * kt);
                        tmode[gr] = (dmax < -128 || dmin > 128) ? 2 : ((dmin >= -128 && dmax <= 128) ? 0 : 1); } }
                if (tmode[0] == 2 && tmode[1] == 2) continue;
                bf16x8 kf[4];
#pragma unroll
                for (int ks = 0; ks < 4; ++ks) kf[ks] = *(const LAS bf16x8*)(kb + (32 * kt + r32) * 144 + (16 * ks + 8 * hi) * 2);
                bf16x8 vf[2][2];
#pragma unroll
                for (int d0 = 0; d0 < 2; ++d0)
#pragma unroll
                    for (int s2 = 0; s2 < 2; ++s2) { const LAS unsigned char* vp = vb + (32 * kt + 16 * s2 + 4 * hi + tq) * 144 + (32 * d0 + 16 * blk + 4 * tp) * 2;
                        vf[d0][s2] = cat4(tr_read(vp), tr_read(vp + 8 * 144)); }
#pragma unroll
                for (int gr = 0; gr < 2; ++gr) { if (tmode[gr] == 2) continue;
                    const float nm = -mrun[gr]; const f32x2 nm2 = (f32x2){nm, nm};
                    f32x16 st = __builtin_shufflevector(nm2, nm2, 0, 1, 0, 1, 0, 1, 0, 1, 0, 1, 0, 1, 0, 1, 0, 1);
#pragma unroll
                    for (int ks = 0; ks < 4; ++ks) st = MFMA32(kf[ks], qf[gr][ks], st);
                    if (tmode[gr] == 1) { const int qpos = s + 64 * gr + 32 * qh + r32; const int kb0 = kpos0 + 32 * kt + 4 * hi;
#pragma unroll
                        for (int i = 0; i < 16; ++i) { const int dlt = qpos - (kb0 + (i & 3) + 8 * (i >> 2)); if (dlt > 128 || dlt < -128) st[i] = -1e30f; } }
                    float tmax = fmaxf(st[0], st[1]);
#pragma unroll
                    for (int i = 2; i < 16; i += 2) tmax = fmaxf(fmaxf(tmax, st[i]), st[i + 1]);
                    { auto rr = __builtin_amdgcn_permlane32_swap(__float_as_uint(tmax), __float_as_uint(tmax), false, false); tmax = fmaxf(__uint_as_float(rr[0]), __uint_as_float(rr[1])); }
                    if (__any(tmax > 8.0f)) { const float dl = fmaxf(tmax, 0.f); mrun[gr] += dl; const float alpha = __builtin_amdgcn_exp2f(-dl); lrun[gr] *= alpha;
#pragma unroll
                        for (int i = 0; i < 16; ++i) st[i] -= dl;
#pragma unroll
                        for (int d0 = 0; d0 < 2; ++d0)
#pragma unroll
                            for (int i = 0; i < 16; ++i) o[gr][d0][i] *= alpha; }
#pragma unroll
                    for (int i = 0; i < 16; ++i) st[i] = __builtin_amdgcn_exp2f(st[i]);
                    f32x2 ps2 = (f32x2){st[0], st[1]};
#pragma unroll
                    for (int i = 2; i < 16; i += 2) ps2 += (f32x2){st[i], st[i + 1]};
                    lrun[gr] += ps2.x + ps2.y;
                    const bf16x8 p0 = pack8(st, 0), p1 = pack8(st, 1);
#pragma unroll
                    for (int d0 = 0; d0 < 2; ++d0) { o[gr][d0] = MFMA32(vf[d0][0], p0, o[gr][d0]); o[gr][d0] = MFMA32(vf[d0][1], p1, o[gr][d0]); }
                }
            }
            ATTT(1);
            if (ch + 1 < nch) ATT_STORE(buf ^ 1);
            __syncthreads();
            ATTT(2);
        }
        if (has_next) ATT_LOADQ(UN);
        { LAS unsigned char* OW = F.lds + wave * 9216;
#pragma unroll
        for (int gr = 0; gr < 2; ++gr) { float lt; { auto rr = __builtin_amdgcn_permlane32_swap(__float_as_uint(lrun[gr]), __float_as_uint(lrun[gr]), false, false); lt = __uint_as_float(rr[0]) + __uint_as_float(rr[1]); } const float inv = ATT_O_SCALE / lt;
#pragma unroll
            for (int d0 = 0; d0 < 2; ++d0)
#pragma unroll
                for (int i4 = 0; i4 < 4; ++i4) { int w = 0; w = __builtin_amdgcn_cvt_pk_fp8_f32(__builtin_amdgcn_fmed3f(o[gr][d0][4 * i4] * inv, -448.f, 448.f), __builtin_amdgcn_fmed3f(o[gr][d0][4 * i4 + 1] * inv, -448.f, 448.f), w, false);
                    w = __builtin_amdgcn_cvt_pk_fp8_f32(__builtin_amdgcn_fmed3f(o[gr][d0][4 * i4 + 2] * inv, -448.f, 448.f), __builtin_amdgcn_fmed3f(o[gr][d0][4 * i4 + 3] * inv, -448.f, 448.f), w, true);
                    *(LAS int*)(OW + (32 * gr + r32) * 80 + (32 * d0 + 8 * i4 + 4 * hi)) = w; } }
        asm volatile("s_waitcnt lgkmcnt(0)" ::: "memory");
#pragma unroll
        for (int it = 0; it < 4; ++it) { const int idx = lane + 64 * it; const int qr = idx >> 2, pc = idx & 3; const u32x4 w = *(const LAS u32x4*)(OW + qr * 80 + pc * 16);
            *(u32x4*)(O + (size_t)(qrow0 + 64 * (qr >> 5) + 32 * qh + (qr & 31)) * 1024 + hq * 64 + pc * 16) = w; } }
        UC = UN;
    }
    ATTT(3);
#undef ATTT
#undef ATT_DECODE
#undef ATT_LOADQ
#undef ATT_CHROW
#undef ATT_LOAD
#undef ATT_STORE
}

DI void gla_phase(Frame& F, int j, unsigned long long& pacc) {
    unsigned char* const ws = KWS; const bf16_t* QK = (const bf16_t*)(ws + WS_R2); const bf16_t* GV = (const bf16_t*)(ws + WS_R3); bf16_t* const OBp = (bf16_t*)KOUT;
    const float* wa2g = KIN(I_GWA2); const float* bag = KIN(I_GBA); const float* rbuf = (const float*)(ws + WS_R);
    const int lane = F.lane, wave = F.wave, tid = F.tid, r32 = lane & 31, hi = lane >> 5;
    const int i16 = lane & 15, tq = i16 >> 2, tp = i16 & 3, blk = (lane >> 4) & 1;
    LAS unsigned char* QD = F.lds; LAS unsigned char* KD = F.lds + 17408; LAS unsigned char* KZ = F.lds + 34816; LAS unsigned char* VT = F.lds + 52224; LAS unsigned char* PT = F.lds + 86016;
    LAS float* RR = (LAS float*)(F.lds + 95232); LAS float* SEG = (LAS float*)(F.lds + 99328); LAS float* DEC = (LAS float*)(F.lds + 103424);
    LAS float* WA2 = (LAS float*)(F.lds + 103936); LAS float* BA = (LAS float*)(F.lds + 112128);
    LAS unsigned char* OTW = F.lds + 114688 + wave * 4096;
    LAS float* XT = (LAS float*)(F.lds + 114688);
    static_assert(114688 + 8 * 4096 <= PHASE_LDS, "scan LDS map");
    const int kp = tid & 63, seg = tid >> 6;
    for (int u = blockIdx.x; u < 256; u += F.G) {
        const int b = u >> 3, hd = (u >> 1) & 3, dir = u & 1;
        bf16_t* OUT = dir ? OBp : (bf16_t*)(ws + WS_H);
        __syncthreads();
        { int t2 = tid; asm volatile("" : "+v"(t2));
          for (int idx = t2; idx < 16 * 128; idx += 512) WA2[idx] = wa2g[(((size_t)j * 2 + dir) * 16 + (idx >> 7)) * 512 + hd * 128 + (idx & 127)];
          if (t2 < 128) BA[t2] = bag[((size_t)j * 2 + dir) * 512 + hd * 128 + t2] * (-LOG2E); }
        f32x16 S[4];
#pragma unroll
        for (int kb = 0; kb < 4; ++kb)
#pragma unroll
            for (int i = 0; i < 16; ++i) S[kb][i] = 0.f;
        __syncthreads();
        bf16x8 wfh;
        { u32x4 bh;
#pragma unroll
          for (int q = 0; q < 4; ++q) bh[q] = cvt_pk_bf16(WA2[(8 * hi + 2 * q) * 128 + 32 * (wave & 3) + r32] * (-LOG2E), WA2[(8 * hi + 2 * q + 1) * 128 + 32 * (wave & 3) + r32] * (-LOG2E));
          wfh = __builtin_bit_cast(bf16x8, bh); }
        u32x4 vreg[4]; f32x4 rreg = (f32x4){0.f, 0.f, 0.f, 0.f}; unsigned q2[8], k2[8];
        const int sgn = dir ? -1 : 1;
        const unsigned vlo = (unsigned)((dir ? 63 - (tid >> 5) : (tid >> 5)) * 2048 + (tid & 31) * 16);
        const unsigned rlo = (unsigned)((dir ? 63 - (tid >> 2) : (tid >> 2)) * 128 + (tid & 3) * 16);
        const unsigned qlo = (unsigned)(4 * kp);
        const unsigned olo = (unsigned)((dir ? 63 - (lane >> 2) : (lane >> 2)) * 2048 + (lane & 3) * 16);
#define GLA_TLOW(cj_) ((cj_) < 4 ? (NL + b * CTX + (dir ? 192 - 64 * (cj_) : 64 * (cj_))) : (b * SEQ + (dir ? 1984 - 64 * ((cj_) - 4) : 64 * ((cj_) - 4))))
#define GLA_FETCH_V(cj_) do { const int tl_ = GLA_TLOW(cj_); \
            _Pragma("unroll") for (int i_ = 0; i_ < 4; ++i_) { const char* ub_ = (const char*)GV + ((size_t)(tl_ + sgn * 16 * i_)) * 2048 + hd * 512; vreg[i_] = *(const u32x4*)(ub_ + vlo); } \
            if (tid < 256) { const char* ub_ = (const char*)rbuf + (size_t)tl_ * 128 + dir * 64; rreg = *(const f32x4*)(ub_ + rlo); } } while (0)
#define GLA_FETCH_QK(cj_) do { const int tl_ = GLA_TLOW(cj_); \
            _Pragma("unroll") for (int e_ = 0; e_ < 8; ++e_) { const int ro_ = dir ? 63 - (8 * seg + e_) : 8 * seg + e_; const char* ub_ = (const char*)QK + ((size_t)(tl_ + ro_)) * 2048 + hd * 256; \
                q2[e_] = *(const unsigned*)(ub_ + qlo); k2[e_] = *(const unsigned*)(ub_ + 1024 + qlo); } } while (0)
        GLA_FETCH_V(0); GLA_FETCH_QK(0);
#if PROBE_SCAN
        unsigned long long tprev_ = __builtin_amdgcn_s_memrealtime();
#define SCANT(k) do { const unsigned long long tn_ = __builtin_amdgcn_s_memrealtime(); if (PROBE_SCAN == (k)) pacc += tn_ - tprev_; tprev_ = tn_; } while (0)
#else
#define SCANT(k) do { } while (0)
#endif
        for (int cj = 0; cj < 36; ++cj) {
            const int tlow = GLA_TLOW(cj);
            LDS_BAR();
#pragma unroll
            for (int i = 0; i < 4; ++i) { const int p = tid + 512 * i; *(LAS u32x4*)(VT + (p >> 5) * 528 + (p & 31) * 16) = vreg[i]; }
            if (tid < 256) *(LAS f32x4*)(RR + (tid >> 2) * 16 + (tid & 3) * 4) = rreg;
            LDS_BAR();
            SCANT(1);
            { const LAS float* rp = RR + (32 * (wave >> 2) + r32) * 16 + 8 * hi; const f32x4 ra = *(const LAS f32x4*)rp, rb4 = *(const LAS f32x4*)(rp + 4);
              const float rv[8] = {ra[0], ra[1], ra[2], ra[3], rb4[0], rb4[1], rb4[2], rb4[3]};
              u32x4 ah, al;
#pragma unroll
              for (int q = 0; q < 4; ++q) { const unsigned hh2 = cvt_pk_bf16(rv[2 * q], rv[2 * q + 1]); ah[q] = hh2; al[q] = cvt_pk_bf16(rv[2 * q] - bf_lo(hh2), rv[2 * q + 1] - bf_hi(hh2)); }
              f32x16 xt;
#pragma unroll
              for (int i = 0; i < 16; ++i) xt[i] = 0.f;
              xt = MFMA32(__builtin_bit_cast(bf16x8, ah), wfh, xt); xt = MFMA32(__builtin_bit_cast(bf16x8, al), wfh, xt);
              LAS float* xo = XT + (32 * (wave >> 2) + 4 * hi) * 128 + 32 * (wave & 3) + r32;
#pragma unroll
              for (int i = 0; i < 16; ++i) xo[((i & 3) + 8 * (i >> 2)) * 128] = xt[i]; }
            LDS_BAR();
            float bl[8][2];
            { const f32x2 ba2 = *(const LAS f32x2*)(BA + 2 * kp);
              float run0 = 0.f, run1 = 0.f;
#pragma unroll
              for (int e = 0; e < 8; ++e) { const f32x2 x2 = *(const LAS f32x2*)(XT + (8 * seg + e) * 128 + 2 * kp); const float t0 = fminf(x2[0] + ba2[0], 100.f), t1 = fminf(x2[1] + ba2[1], 100.f);
                  run0 = __builtin_fmaf(__builtin_amdgcn_logf(1.0f + __builtin_amdgcn_exp2f(t0)), -0.0625f, run0); run1 = __builtin_fmaf(__builtin_amdgcn_logf(1.0f + __builtin_amdgcn_exp2f(t1)), -0.0625f, run1); bl[e][0] = run0; bl[e][1] = run1; }
              *(LAS f32x2*)(SEG + seg * 128 + 2 * kp) = (f32x2){run0, run1}; }
            LDS_BAR();
            SCANT(2);
            { float off0 = 0.f, off1 = 0.f, tot0 = 0.f, tot1 = 0.f;
#pragma unroll
              for (int s2 = 0; s2 < 8; ++s2) { const f32x2 t2 = *(const LAS f32x2*)(SEG + s2 * 128 + 2 * kp); tot0 += t2[0]; tot1 += t2[1]; }
#pragma unroll 1
              for (int s2 = 0; s2 < seg; ++s2) { const f32x2 t2 = *(const LAS f32x2*)(SEG + s2 * 128 + 2 * kp); off0 += t2[0]; off1 += t2[1]; }
              const float et0 = __builtin_amdgcn_exp2f(tot0), et1 = __builtin_amdgcn_exp2f(tot1);
              if (seg == 0) *(LAS f32x2*)(DEC + 2 * kp) = (f32x2){et0, et1};
#pragma unroll
              for (int e = 0; e < 8; ++e) { const float b0 = bl[e][0] + off0, b1 = bl[e][1] + off1; const float q0 = bf_lo(q2[e]), q1 = bf_hi(q2[e]), k0 = bf_lo(k2[e]), k1 = bf_hi(k2[e]);
                  const float e0 = __builtin_amdgcn_exp2f(b0), e1 = __builtin_amdgcn_exp2f(b1), n0 = __builtin_amdgcn_exp2f(fminf(-b0, 86.f)), n1 = __builtin_amdgcn_exp2f(fminf(-b1, 86.f)), z0 = et0 * n0, z1 = et1 * n1;
                  const int ro = (8 * seg + e) * 272 + 4 * kp;
                  *(LAS unsigned*)(QD + ro) = cvt_pk_bf16(q0 * e0, q1 * e1); *(LAS unsigned*)(KD + ro) = cvt_pk_bf16(k0 * n0, k1 * n1); *(LAS unsigned*)(KZ + ro) = cvt_pk_bf16(k0 * z0, k1 * z1); } }
            LDS_BAR();
            SCANT(3);
            if (cj + 1 < 36) GLA_FETCH_V(cj + 1);
            { const int ti = wave >> 1;
#pragma unroll
              for (int uu = 0; uu < 2; ++uu) { const int sj = 2 * (wave & 1) + uu; f32x4 a4 = (f32x4){0.f, 0.f, 0.f, 0.f};
#pragma unroll
                  for (int kk = 0; kk < 4; ++kk) { const bf16x8 af = *(const LAS bf16x8*)(KD + (16 * sj + i16) * 272 + (32 * kk + 8 * (lane >> 4)) * 2), bfr = *(const LAS bf16x8*)(QD + (16 * ti + i16) * 272 + (32 * kk + 8 * (lane >> 4)) * 2);
                      a4 = MFMA16(af, bfr, a4); }
                  const int t = 16 * ti + i16, s0 = 16 * sj + 4 * (lane >> 4);
                  float pv[4];
#pragma unroll
                  for (int i = 0; i < 4; ++i) pv[i] = (s0 + i <= t) ? a4[i] : 0.f;
                  u32x2 w; w.x = cvt_pk_bf16(pv[0], pv[1]); w.y = cvt_pk_bf16(pv[2], pv[3]);
                  *(LAS u32x2*)(PT + t * 144 + s0 * 2) = w; } }
            LDS_BAR();
            SCANT(4);
#define SB_ asm volatile("" ::: "memory")
#define LD_INTER(Fx, kb_, s2_) do { _Pragma("unroll") for (int tb_ = 0; tb_ < 2; ++tb_) { const LAS unsigned char* qp_ = QD + (32 * tb_ + r32) * 272 + (32 * (kb_) + 16 * (s2_) + 4 * hi) * 2; \
                Fx[tb_] = cat4(*(const LAS s16x4*)qp_, *(const LAS s16x4*)(qp_ + 16)); } } while (0)
#define MM_INTER(Fx, kb_, s2_) do { const bf16x8 ap_ = pack8(S[kb_], s2_); oT[0] = MFMA32(ap_, Fx[0], oT[0]); oT[1] = MFMA32(ap_, Fx[1], oT[1]); } while (0)
#define LD_P(Fx, i_, tb_, ss_) Fx[i_] = *(const LAS bf16x8*)(PT + (32 * (tb_) + r32) * 144 + (16 * (ss_) + 8 * hi) * 2)
#define LD_STATE(Fx, kb_) do { _Pragma("unroll") for (int ss_ = 0; ss_ < 4; ++ss_) { const LAS unsigned char* zp_ = KZ + (16 * ss_ + 8 * hi + tq) * 272 + (32 * (kb_) + 16 * blk + 4 * tp) * 2; Fx[ss_] = cat4(tr_read(zp_), tr_read(zp_ + 4 * 272)); } } while (0)
#define LD_DEC(kb_) do { } while (0)
#define DECAY(kb_) do { _Pragma("unroll") for (int i4_ = 0; i4_ < 4; ++i4_) { const f32x4 dv_ = *(const LAS f32x4*)(DEC + 32 * (kb_) + 8 * i4_ + 4 * hi); _Pragma("unroll") for (int e_ = 0; e_ < 4; ++e_) S[kb_][4 * i4_ + e_] *= dv_[e_]; } } while (0)
#define MM_STATE(Fx, kb_) do { _Pragma("unroll") for (int ss_ = 0; ss_ < 4; ++ss_) S[kb_] = MFMA32(Fx[ss_], vfr[ss_], S[kb_]); } while (0)
            bf16x8 vfr[4], fa[4], fb[4];
#pragma unroll
            for (int ss = 0; ss < 4; ++ss) { const LAS unsigned char* vp = VT + (16 * ss + 8 * hi + tq) * 528 + (32 * wave + 16 * blk + 4 * tp) * 2; vfr[ss] = cat4(tr_read(vp), tr_read(vp + 4 * 528)); }
            f32x16 oT[2];
#pragma unroll
            for (int tb = 0; tb < 2; ++tb)
#pragma unroll
                for (int i = 0; i < 16; ++i) oT[tb][i] = 0.f;
            LD_INTER(fa, 0, 0); LD_INTER(fb, 0, 1); SB_;
            MM_INTER(fa, 0, 0); LD_INTER(fa, 1, 0); SB_; MM_INTER(fb, 0, 1); LD_INTER(fb, 1, 1); SB_;
            MM_INTER(fa, 1, 0); LD_INTER(fa, 2, 0); SB_; MM_INTER(fb, 1, 1); LD_INTER(fb, 2, 1); SB_;
            MM_INTER(fa, 2, 0); LD_INTER(fa, 3, 0); SB_; MM_INTER(fb, 2, 1); LD_INTER(fb, 3, 1); SB_;
            MM_INTER(fa, 3, 0); SB_;
            LD_P(fa, 0, 0, 0); LD_P(fa, 1, 0, 1); LD_P(fa, 2, 1, 0); LD_P(fa, 3, 1, 1); SB_; MM_INTER(fb, 3, 1); SB_;
            LD_P(fb, 0, 1, 2); LD_P(fb, 1, 1, 3); LD_DEC(0); SB_;
            oT[0] = MFMA32(vfr[0], fa[0], oT[0]); oT[1] = MFMA32(vfr[0], fa[2], oT[1]); oT[0] = MFMA32(vfr[1], fa[1], oT[0]); oT[1] = MFMA32(vfr[1], fa[3], oT[1]); SB_;
            LD_STATE(fa, 0); SB_;
            oT[1] = MFMA32(vfr[2], fb[0], oT[1]); oT[1] = MFMA32(vfr[3], fb[1], oT[1]); SB_;
#pragma unroll
            for (int tb = 0; tb < 2; ++tb)
#pragma unroll
                for (int i4 = 0; i4 < 4; ++i4) { u32x2 w; w.x = cvt_pk_bf16(oT[tb][4 * i4], oT[tb][4 * i4 + 1]); w.y = cvt_pk_bf16(oT[tb][4 * i4 + 2], oT[tb][4 * i4 + 3]);
                    *(LAS u32x2*)(OTW + (32 * tb + r32) * 64 + (8 * i4 + 4 * hi) * 2) = w; }
            SB_;
            if (cj + 1 < 36) GLA_FETCH_QK(cj + 1);
            DECAY(0); LD_DEC(1); LD_STATE(fb, 1); SB_; MM_STATE(fa, 0); SB_;
#pragma unroll
            for (int it = 0; it < 4; ++it) { const int idx = lane + 64 * it; const int trow = idx >> 2, pc = idx & 3; const u32x4 w = *(const LAS u32x4*)(OTW + trow * 64 + pc * 16);
                char* ub = (char*)OUT + ((size_t)(tlow + sgn * 16 * it)) * 2048 + hd * 512 + 64 * wave; *(u32x4*)(ub + olo) = w; }
            SB_;
            DECAY(1); LD_DEC(2); LD_STATE(fa, 2); SB_; MM_STATE(fb, 1); SB_;
            DECAY(2); LD_DEC(3); LD_STATE(fb, 3); SB_; MM_STATE(fa, 2); SB_;
            DECAY(3); SB_; MM_STATE(fb, 3);
#undef SB_
#undef LD_INTER
#undef MM_INTER
#undef LD_P
#undef LD_STATE
#undef LD_DEC
#undef DECAY
#undef MM_STATE
            SCANT(5);
        }
    }
}
#undef SCANT

#undef GLA_TLOW
#undef GLA_FETCH_V
#undef GLA_FETCH_QK
DI void gla_norm_phase(Frame& F, int j, int nrows) {
    unsigned char* const ws = KWS; const bf16_t* OFW = (const bf16_t*)(ws + WS_H); const bf16_t* OBW = (const bf16_t*)KOUT; const bf16_t* GB = (const bf16_t*)(ws + WS_R2) + (size_t)MT * 1024; signed char* A2 = (signed char*)(ws + WS_R2); float* sap = (float*)(ws + WS_SA);
    const int gw = blockIdx.x * NWAVES + F.wave, NGW = F.G * NWAVES;
    const float* ngp = KIN(I_GNORM) + j * 256 + 8 * (F.lane & 31);
    const f32x4 ng0 = *(const f32x4*)ngp, ng1 = *(const f32x4*)(ngp + 4);
    const float ng[8] = {ng0[0], ng0[1], ng0[2], ng0[3], ng1[0], ng1[1], ng1[2], ng1[3]};
    for (int rowb = 2 * gw; rowb < nrows; rowb += 2 * NGW) {
        u32x4 a[2][2], bq[2][2], gg[2][2];
#pragma unroll
        for (int u = 0; u < 2; ++u)
#pragma unroll
            for (int it = 0; it < 2; ++it) { const size_t off = (size_t)(rowb + u) * 1024 + (size_t)(F.lane + 64 * it) * 8; a[u][it] = *(const u32x4*)(OFW + off); bq[u][it] = *(const u32x4*)(OBW + off); gg[u][it] = *(const u32x4*)(GB + off); }
#pragma unroll
        for (int u = 0; u < 2; ++u) { float v16[16];
#pragma unroll
            for (int it = 0; it < 2; ++it) {
                const unsigned aw[4] = {a[u][it].x, a[u][it].y, a[u][it].z, a[u][it].w}, bw[4] = {bq[u][it].x, bq[u][it].y, bq[u][it].z, bq[u][it].w}, gw4[4] = {gg[u][it].x, gg[u][it].y, gg[u][it].z, gg[u][it].w};
                float ov[8], gv[8]; float ss = 0.f;
#pragma unroll
                for (int q = 0; q < 4; ++q) { ov[2 * q] = bf_lo(aw[q]) + bf_lo(bw[q]); ov[2 * q + 1] = bf_hi(aw[q]) + bf_hi(bw[q]); gv[2 * q] = bf_lo(gw4[q]); gv[2 * q + 1] = bf_hi(gw4[q]); }
#pragma unroll
                for (int e = 0; e < 8; ++e) ss += ov[e] * ov[e];
                ss = half_sum32(ss, F.lane);
                const float rstd = 1.0f / sqrtf(ss * (1.0f / 256.0f) + RMS_EPS);
#pragma unroll
                for (int e = 0; e < 8; ++e) v16[8 * it + e] = ov[e] * rstd * ng[e] * silu_fast(gv[e]); }
            const float sc_ = quant_row_i8(v16, A2 + (size_t)(rowb + u) * 1024, 8 * F.lane, F.lane); if (F.lane == 0) sap[rowb + u] = sc_; }
    }
}

DI void final_phase(Frame& F) {
    unsigned char* const ws = KWS; const bf16_t* XRp = (const bf16_t*)(ws + WS_XR); const unsigned char* Yp = ws + WS_R3; float* outp = KOUT; const float* fg = KIN(I_FINALG);
    const float* gatel = (const float*)(ws + WS_MOD) + (size_t)(DEPTH - 1) * 33 * 6144 + 5 * 1024; const int* tokpos = (const int*)(ws + WS_TOKPOS);
    (void)moe_table(F, DEPTH - 1); const LAS int* bs = (const LAS int*)(F.lds + MOE_TAB_OFF);
    const int c0 = 8 * F.lane;
    const int RPB = (NL + F.G - 1) / F.G, RPW = (RPB + 7) / 8;
    const int brow0 = blockIdx.x * RPB; int bend = brow0 + RPB; if (bend > NL) bend = NL;
    const int row0 = brow0 + F.wave * RPW; int rend = row0 + RPW; if (rend > bend) rend = bend;
    float gn[16], gy[16]; int mb = -1;
#pragma unroll
    for (int hh = 0; hh < 2; ++hh)
#pragma unroll
        for (int q = 0; q < 2; ++q) { const f32x4 g4 = *(const f32x4*)(fg + hh * 512 + c0 + 4 * q);
#pragma unroll
            for (int e = 0; e < 4; ++e) gn[hh * 8 + q * 4 + e] = g4[e]; }
    for (int rowb = row0; rowb < rend; rowb += 4) {
        u32x4 xa[4], xb[4], ya[4], yb[4];
#pragma unroll
        for (int u = 0; u < 4; ++u) { const int rr = rowb + u < rend ? rowb + u : rend - 1; const bf16_t* xr = XRp + (size_t)rr * 1024; xa[u] = *(const u32x4*)(xr + c0); xb[u] = *(const u32x4*)(xr + 512 + c0);
            const int tp = tokpos[rr]; const unsigned char* yr = Yp + ((size_t)bs[tp & 0xff] * 256 + (size_t)(tp >> 8)) * 1024; const u32x2 ta_ = *(const u32x2*)(yr + c0), tb_ = *(const u32x2*)(yr + 512 + c0); ya[u].x = ta_.x; ya[u].y = ta_.y; yb[u].x = tb_.x; yb[u].y = tb_.y; }
#pragma unroll
        for (int u = 0; u < 4; ++u) { const int row = rowb + u; if (row < rend) {
            const int mbn = row >> 11;
            if (mbn != mb) { mb = mbn; const float* gp = gatel + (size_t)mb * 6144;
#pragma unroll
                for (int hh = 0; hh < 2; ++hh)
#pragma unroll
                    for (int q = 0; q < 2; ++q) { const f32x4 y4 = *(const f32x4*)(gp + hh * 512 + c0 + 4 * q);
#pragma unroll
                        for (int e = 0; e < 4; ++e) gy[hh * 8 + q * 4 + e] = y4[e] * (1.0f / Y_SCALE); } }
            float v[16], yv[16]; unpack16(xa[u], xb[u], v); unpack16_f8(ya[u].x, ya[u].y, yb[u].x, yb[u].y, yv);
            float ss = 0.f;
#pragma unroll
            for (int e = 0; e < 16; ++e) { v[e] += gy[e] * yv[e]; ss += v[e] * v[e]; }
            ss = wave_sum(ss, F.lane);
            const float rstd = 1.0f / sqrtf(ss * (1.0f / 1024.0f) + RMS_EPS);
            float* op = outp + (size_t)row * 1024;
#pragma unroll
            for (int hh = 0; hh < 2; ++hh)
#pragma unroll
                for (int q = 0; q < 2; ++q) { f32x4 o4;
#pragma unroll
                    for (int e = 0; e < 4; ++e) o4[e] = v[hh * 8 + q * 4 + e] * rstd * gn[hh * 8 + q * 4 + e];
                    *(f32x4*)(op + hh * 512 + c0 + 4 * q) = o4; }
        } }
    }
}

struct Args { const float* in[23]; float* out; unsigned char* ws; int ph_lo, ph_hi; };
constexpr int PH_PER_LAYER = 8, N_PHASES = 1 + DEPTH * PH_PER_LAYER + 1;

__global__ void __launch_bounds__(NWAVES * 64, 2) fwd_kernel(Args args) {
    extern __shared__ __attribute__((aligned(16))) unsigned char lds[];
    LAS unsigned char* const ldsb = (LAS unsigned char*)lds;
    const int wv0 = __builtin_amdgcn_readfirstlane((int)threadIdx.x >> 6);
    for (int u = wv0 * 64 + (int)lane_id_(); u < (LDS_BYTES - MISC_OFF) / 4; u += NWAVES * 64) ((LAS unsigned*)(ldsb + MISC_OFF))[u] = 0u;
    __syncthreads();
    const int lo = args.ph_lo, hi = args.ph_hi;
    XcdBarrier bar; bar.bar = nullptr; bar.x = 0; bar.st = (volatile LAS unsigned*)(ldsb + MISC_OFF) + 8; bar.w = (unsigned)wv0;
    if (hi - lo > 1) bar = xcd_barrier_post((unsigned*)KWS + CW_BAR, (volatile LAS unsigned*)(ldsb + MISC_OFF) + 8, (unsigned)wv0);
#define IN(k) (lo <= (k) && (k) < hi)
#if PROBE_MASK
    unsigned long long pr_prev = __builtin_amdgcn_s_memrealtime(), pr_acc = 0;
#define PSTAMP(slot) do { const unsigned long long tn_ = __builtin_amdgcn_s_memrealtime(); if ((PROBE_MASK >> (slot)) & 1) pr_acc += tn_ - pr_prev; pr_prev = tn_; } while (0)
#else
    unsigned long long pr_acc = 0;
#define PSTAMP(slot) do { } while (0)
#endif
#define SEAM(k, slot) do { if (IN(k) && IN((k) + 1)) { bar.bar = (unsigned*)KWS + CW_BAR; xcd_barrier(bar); } PSTAMP(slot); } while (0)

    if (PHE(0) && IN(0)) { Frame F = mkframe(ldsb, wv0); p0_prologue(F); }
    SEAM(0, 0);
#pragma unroll 1
    for (int layer = 0; layer < DEPTH; ++layer) {
        const int pb = 1 + layer * PH_PER_LAYER; const int j = layer >> 1; const bool gla = layer & 1;
        if (PHE(1) && IN(pb + 0)) { Frame F = mkframe(ldsb, wv0); norm_phase<false>(F, layer); }
        SEAM(pb + 0, 1);
        if (IN(pb + 1)) { Frame F = mkframe(ldsb, wv0);
            if (PHE(2) && !gla) { unsigned char* const ws = KWS;
                LAS float* ropeL = (LAS float*)(F.lds + RING_BYTES);
                { const float* rg = (const float*)(ws + WS_ROPE); for (int idx = F.tid; idx < 64 * 32; idx += 512) ropeL[idx] = rg[idx]; }
                __syncthreads();
                DenseOrder S{MT / 256, NQKV / 256, F.G, (int)blockIdx.x, 1024u, (const char*)(ws + WS_WQKV) + (size_t)j * NQKV * 1024, 1024u, (const float*)(ws + WS_SA), (const float*)(ws + WS_SBQKV) + j * NQKV}; EpiQKV E{(bf16_t*)(ws + WS_R2), ropeL};
                pg8::gemm_phase<EpiQKV, DenseOrder, 1>(F.lds, F.tid, (const char*)(ws + WS_H), 1024, 1024u, S, E, pr_acc); }
            else if (PHE(3) && gla) { unsigned char* const ws = KWS;
                DenseOrder S{MT / 256, NGIN / 256, F.G, (int)blockIdx.x, 1024u, (const char*)(ws + WS_WIN) + (size_t)j * NGIN * 1024, 1024u, (const float*)(ws + WS_SA), (const float*)(ws + WS_SBIN) + j * NGIN};
                EpiGLA E{(bf16_t*)(ws + WS_R2), (float*)(ws + WS_R)};
                pg8::gemm_phase<EpiGLA, DenseOrder, 1>(F.lds, F.tid, (const char*)(ws + WS_H), 1024, 1024u, S, E, pr_acc); }
        }
        SEAM(pb + 1, gla ? 3 : 2);
        if (IN(pb + 2)) { if (PHE(4) && !gla) { Frame F = mkframe(ldsb, wv0); attn_phase(F, j, pr_acc); } else if (PHE(5) && gla) { Frame F = mkframe(ldsb, wv0); gla_phase(F, j, pr_acc); } }
        SEAM(pb + 2, gla ? 5 : 4);
        if (PHE(6) && IN(pb + 3)) { Frame F = mkframe(ldsb, wv0); if (gla) gla_norm_phase(F, j, layer == DEPTH - 1 ? NL : MT); }
        if (gla) SEAM(pb + 3, 6);
        if (PHE(7) && IN(pb + 4)) { Frame F = mkframe(ldsb, wv0); unsigned char* const ws = KWS;
            const int nMp = layer == DEPTH - 1 ? NL / 256 : MT / 256;
            EpiY E{ws + WS_H};
            if (gla) { DenseOrder S{nMp, 4, F.G, (int)blockIdx.x, 1024u, (const char*)(ws + WS_WGO) + (size_t)j * 1024 * 1024, 1024u, (const float*)(ws + WS_SA), (const float*)(ws + WS_SBGO) + j * 1024};
                pg8::gemm_phase<EpiY, DenseOrder, 1>(F.lds, F.tid, (const char*)(ws + WS_R2), 1024, 1024u, S, E, pr_acc); }
            else { DenseOrder S{nMp, 4, F.G, (int)blockIdx.x, 1024u, (const char*)(ws + WS_WO) + (size_t)j * 1024 * 1024, 1024u, nullptr, (const float*)(ws + WS_SBO) + j * 1024, 1.0f / ATT_O_SCALE};
                pg8::gemm_phase<EpiY, DenseOrder, 2>(F.lds, F.tid, (const char*)(ws + WS_R3), 1024, 1024u, S, E, pr_acc); }
        }
        SEAM(pb + 4, 7);
        if (PHE(8) && IN(pb + 5)) { Frame F = mkframe(ldsb, wv0); n2_phase(F, layer); }
        SEAM(pb + 5, 8);
        if (PHE(9) && IN(pb + 6)) { Frame F = mkframe(ldsb, wv0);
            const int nblk = moe_table(F, layer); const LAS int* bs = (const LAS int*)(F.lds + MOE_TAB_OFF); unsigned char* const ws = KWS;
            MoeUpOrder S{nblk, F.G, (int)blockIdx.x, bs, bs + 32, (const int*)(ws + WS_LIST), (const char*)(ws + WS_WGU) + (size_t)layer * 16 * 1024 * 1024, (const float*)(ws + WS_SLIST), (const float*)(ws + WS_SBGU) + layer * 16 * 1024};
            EpiSwiGLU E{(unsigned char*)(ws + WS_R2), (const f32x2*)(ws + WS_GLIST)};
            pg8::gemm_phase<EpiSwiGLU, MoeUpOrder, 1>(F.lds, F.tid, (const char*)(ws + WS_R3), 1024, 1024u, S, E, pr_acc);
        }
        SEAM(pb + 6, 9);
        if (PHE(10) && IN(pb + 7)) { Frame F = mkframe(ldsb, wv0);
            const int nblk = moe_table(F, layer); const LAS int* bs = (const LAS int*)(F.lds + MOE_TAB_OFF); unsigned char* const ws = KWS;
            MoeDownOrder S{nblk, F.G, (int)blockIdx.x, bs, (const char*)(ws + WS_WD) + (size_t)layer * 16 * 1024 * 512, (const float*)(ws + WS_SBD) + layer * 4 * 1024}; EpiY E{ws + WS_R3};
            pg8::gemm_phase<EpiY, MoeDownOrder, 2>(F.lds, F.tid, (const char*)(ws + WS_R2), 1024, 512u, S, E, pr_acc);
        }
        SEAM(pb + 7, 10);
    }
    if (PHE(11) && IN(N_PHASES - 1)) { Frame F = mkframe(ldsb, wv0); final_phase(F); }
#if PROBE_MASK
    PSTAMP(11);
    if (blockIdx.x == 0 && wv0 == 0 && lane_id_() == 0u) { const unsigned long long t0_ = __builtin_amdgcn_s_memrealtime(); while (__builtin_amdgcn_s_memrealtime() - t0_ < (unsigned long long)PROBE_AMP * pr_acc) __builtin_amdgcn_s_sleep(8); }
#endif
#undef IN
#undef SEAM
}

extern "C" void kernel_launch(void* const* d_in, const int* in_sizes, int n_in, void* d_out, int out_size, void* d_ws, size_t ws_size, hipStream_t stream) {
    static int grid = 0;
    if (grid == 0) {
        if (n_in != 23 || out_size != NL * D || ws_size < WS_END) { fprintf(stderr, "kernel_launch: unexpected shapes (n_in %d, out %d, ws %zu; need ws >= %zu)\n", n_in, out_size, ws_size, (size_t)WS_END); grid = -1; return; }
        int dev = 0, cus = 0, per_cu = 0;
        if (hipGetDevice(&dev) != hipSuccess || hipDeviceGetAttribute(&cus, hipDeviceAttributeMultiprocessorCount, dev) != hipSuccess) { grid = -1; return; }
        if (hipFuncSetAttribute((const void*)fwd_kernel, hipFuncAttributeMaxDynamicSharedMemorySize, LDS_BYTES) != hipSuccess) { fprintf(stderr, "kernel_launch: hipFuncSetAttribute failed\n"); grid = -1; return; }
        if (hipOccupancyMaxActiveBlocksPerMultiprocessor(&per_cu, (const void*)fwd_kernel, NWAVES * 64, LDS_BYTES) != hipSuccess || per_cu < 1) { fprintf(stderr, "kernel_launch: occupancy query reports %d blocks per CU\n", per_cu); }
        (void)hipGetLastError();
        grid = cus;
        if (grid < 128) { fprintf(stderr, "kernel_launch: too few CUs (%d)\n", grid); grid = -1; return; }
    }
    if (grid < 0) return;
    (void)in_sizes;
    if (hipMemsetAsync((char*)d_ws + WS_CTL, 0, CTL_ZERO_BYTES, stream) != hipSuccess) return;
    Args a{};
    for (int i = 0; i < 23; ++i) a.in[i] = (const float*)d_in[i];
    a.out = (float*)d_out; a.ws = (unsigned char*)d_ws;
#if MK_N_LAUNCHES == 1
    a.ph_lo = 0; a.ph_hi = N_PHASES;
    hipLaunchKernelGGL(fwd_kernel, dim3(grid), dim3(NWAVES * 64), LDS_BYTES, stream, a);
#else
    for (int p = 0; p < N_PHASES; ++p) {
        if (p >= 1 && p < N_PHASES - 1) { const int s = (p - 1) % PH_PER_LAYER, layer = (p - 1) / PH_PER_LAYER; if (s == 3 && !(layer & 1)) continue; }
        a.ph_lo = p; a.ph_hi = p + 1;
        hipLaunchKernelGGL(fwd_kernel, dim3(grid), dim3(NWAVES * 64), LDS_BYTES, stream, a);
    }
#endif
}
```

```cpp
#include <hip/hip_runtime.h>
#include <cstdio>
#include <cstdint>

#ifndef PROBE_MASK
#define PROBE_MASK 0
#endif
#define PROBE_AMP 4
#ifndef PROBE_GEMM
#define PROBE_GEMM 0
#endif
#ifndef PROBE_ATT
#define PROBE_ATT 0
#endif
#ifndef PROBE_SCAN
#define PROBE_SCAN 0
#endif
#ifndef GEMM_STAGGER_TICKS
#define GEMM_STAGGER_TICKS 0
#endif
#ifndef MK_N_LAUNCHES
#define MK_N_LAUNCHES 1
#endif

#ifndef PH_SEL
#define PH_SEL -1
#endif
#define PHE(k) (PH_SEL < 0 || PH_SEL == (k))
#define LAS __attribute__((address_space(3)))
#define GAS __attribute__((address_space(1)))
#define LDS_BAR() asm volatile("s_waitcnt lgkmcnt(0)\n\ts_barrier" ::: "memory")
typedef unsigned short bf16_t;
typedef short bf16x8 __attribute__((ext_vector_type(8)));
typedef short s16x4 __attribute__((ext_vector_type(4)));
typedef float f32x4 __attribute__((ext_vector_type(4)));
typedef float f32x2 __attribute__((ext_vector_type(2)));
typedef float f32x16 __attribute__((ext_vector_type(16)));
typedef unsigned u32x4 __attribute__((ext_vector_type(4)));
typedef unsigned u32x2 __attribute__((ext_vector_type(2)));
typedef int i32x4 __attribute__((ext_vector_type(4)));
typedef int i32x8 __attribute__((ext_vector_type(8)));
#define DI __device__ __forceinline__

constexpr int D = 1024, NB = 32, SEQ = 2048, CTX = 256, DEPTH = 4;
constexpr int NL = NB * SEQ, NC = NB * CTX, MT = NL + NC;
constexpr int NQKV = 1536, NGIN = 3328;
constexpr int NCLS = 24;
constexpr float RMS_EPS = 1e-6f;
constexpr float QSCALE = 0.125f * 1.4426950408889634f;
constexpr float LOG2E = 1.4426950408889634f;

constexpr size_t MiB = (size_t)1 << 20;
constexpr size_t WS_CTL = 0, CTL_ZERO_BYTES = 1 * MiB;
constexpr size_t WS_MOD = 1 * MiB;
constexpr size_t WS_ROPE = 5 * MiB;
constexpr size_t WS_TOKPOS = 5 * MiB + 256 * 1024;
constexpr size_t WS_LIST = 6 * MiB;
constexpr size_t WS_GLIST = 13 * MiB;
constexpr size_t WS_R = 27 * MiB;
constexpr size_t WS_WQKV = 36 * MiB, WS_WO = 42 * MiB, WS_WIN = 46 * MiB, WS_WGO = 59 * MiB, WS_WGU = 63 * MiB, WS_WD = 191 * MiB;
constexpr size_t WS_XR = 256 * MiB;
constexpr size_t WS_H = 400 * MiB;
constexpr size_t WS_R2 = 544 * MiB;
static_assert(544 * MiB + 2 * ((size_t)73728 * 1024 * 2) == 832 * MiB, "R3 = R2 + 2 activations");
constexpr size_t WS_R3 = 832 * MiB;
constexpr size_t WS_SA = 992 * MiB;
constexpr size_t WS_SLIST = 993 * MiB;
constexpr size_t WS_SBQKV = 1000 * MiB, WS_SBIN = 1000 * MiB + 65536, WS_SBGU = 1000 * MiB + 131072;
constexpr size_t WS_SBGO = 1000 * MiB + 131072 + 262144;
constexpr size_t WS_SBD = 1000 * MiB + 131072 + 262144 + 65536;
constexpr size_t WS_SBO = 1000 * MiB + 524288;
constexpr float ATT_O_SCALE = 32.0f;
constexpr float Y_SCALE = 16.0f;
constexpr float HID_SCALE = 16.0f;
constexpr size_t WS_END = 1001 * MiB;
constexpr size_t ACT_BYTES = (size_t)MT * 1024 * 2;
constexpr int CW_BAR = 4096;
constexpr int CW_STRIPQ = 20000;
constexpr int CW_MOE = 16384;

constexpr int RING_BYTES = 131072;
constexpr int LDS_BYTES = 163840;
constexpr int MISC_OFF = LDS_BYTES - 2048;
constexpr int MOE_TAB_OFF = MISC_OFF + 256;
constexpr int PHASE_LDS = MISC_OFF;
static_assert(RING_BYTES + 8192 <= MISC_OFF, "rope table above the ring");
constexpr int TAB_OFF = RING_BYTES + 8192, TAB_STRIDE = 5120;
static_assert(TAB_OFF + 2 * TAB_STRIDE <= MISC_OFF, "unit tables above the rope table");
constexpr int NWAVES = 8;

typedef __bf16 bf16x2_t __attribute__((ext_vector_type(2)));
DI unsigned cvt_pk_bf16(float lo, float hi) { f32x2 v = {lo, hi}; bf16x2_t b = __builtin_convertvector(v, bf16x2_t); return __builtin_bit_cast(unsigned, b); }
DI float bf_lo(unsigned w) { return __uint_as_float(w << 16); }
DI float bf_hi(unsigned w) { return __uint_as_float(w & 0xffff0000u); }
DI float shx(float v, int o, int lane) { return __int_as_float(__builtin_amdgcn_ds_bpermute((lane ^ o) << 2, __float_as_int(v))); }
#define DPPF(v, ctrl) __int_as_float(__builtin_amdgcn_update_dpp(0, __float_as_int(v), (ctrl), 0xF, 0xF, false))
DI float wave_sum(float v, int lane) {
    v += DPPF(v, 0xB1); v += DPPF(v, 0x4E); v += DPPF(v, 0x141); v += DPPF(v, 0x140);
    v += shx(v, 16, lane); v += shx(v, 32, lane);
    return v;
}
DI float wave_max(float v, int lane) {
    v = fmaxf(v, DPPF(v, 0xB1)); v = fmaxf(v, DPPF(v, 0x4E)); v = fmaxf(v, DPPF(v, 0x141)); v = fmaxf(v, DPPF(v, 0x140));
    v = fmaxf(v, shx(v, 16, lane)); v = fmaxf(v, shx(v, 32, lane));
    return v;
}
DI float half_sum32(float v, int lane) {
    v += DPPF(v, 0xB1); v += DPPF(v, 0x4E); v += DPPF(v, 0x141); v += DPPF(v, 0x140);
    v += shx(v, 16, lane);
    return v;
}
DI float sigmoidf_(float x) { return 1.0f / (1.0f + __expf(-x)); }
DI float siluf_(float x) { return x / (1.0f + __expf(-x)); }
#define MFMA32(a, b, c) __builtin_amdgcn_mfma_f32_32x32x16_bf16((a), (b), (c), 0, 0, 0)
#define MFMA16(a, b, c) __builtin_amdgcn_mfma_f32_16x16x32_bf16((a), (b), (c), 0, 0, 0)
DI int crow(int r, int hi) { return (r & 3) + 8 * (r >> 2) + 4 * hi; }
DI bf16x8 pack8(const f32x16& x, int s) {
    u32x4 p; p[0] = cvt_pk_bf16(x[8 * s + 0], x[8 * s + 1]); p[1] = cvt_pk_bf16(x[8 * s + 2], x[8 * s + 3]); p[2] = cvt_pk_bf16(x[8 * s + 4], x[8 * s + 5]); p[3] = cvt_pk_bf16(x[8 * s + 6], x[8 * s + 7]);
    return __builtin_bit_cast(bf16x8, p);
}
DI s16x4 tr_read(const LAS unsigned char* p) { return __builtin_bit_cast(s16x4, __builtin_amdgcn_ds_read_tr16_b64_v4i16((LAS s16x4*)p)); }
DI bf16x8 cat4(s16x4 lo, s16x4 hi) { return __builtin_shufflevector(lo, hi, 0, 1, 2, 3, 4, 5, 6, 7); }

DI unsigned lane_id_() { unsigned l; asm volatile("v_mbcnt_lo_u32_b32 %0, -1, 0\n\tv_mbcnt_hi_u32_b32 %0, -1, %0" : "=v"(l)); return l; }
#define XB_TMO      128
#define XB_XCNT(j)  (256  + 64 * (j))
#define XB_XSUB(j)  (1280 + 64 * (j))
#define XB_XGEN(j)  (2304 + 64 * (j))
#define XB_TOP      3328
#define XB_TOPGEN   3392
#define XCD_BAR_WORDS 3456
#define XB_SPIN_CAP (1u << 18)
__device__ __forceinline__ unsigned xb_ld(unsigned* p)              { return __hip_atomic_load(p, __ATOMIC_RELAXED, __HIP_MEMORY_SCOPE_AGENT); }
__device__ __forceinline__ unsigned xb_add(unsigned* p, unsigned v) { return __hip_atomic_fetch_add(p, v, __ATOMIC_RELAXED, __HIP_MEMORY_SCOPE_AGENT); }
__device__ __forceinline__ unsigned xb_xcc_id() { return (unsigned)__builtin_amdgcn_s_getreg((3 << 11) | 20) & 0xFu; }
#define XB_SPIN(cond, bar) do { unsigned _sp = 0; while (cond) { __builtin_amdgcn_s_sleep(1); \
    if ((++_sp & 255u) == 0u) { if (xb_ld(&(bar)[XB_TMO])) break; if (_sp > XB_SPIN_CAP) { atomicAdd(&(bar)[XB_TMO], 1u); break; } } } } while (0)
struct XcdBarrier { unsigned* bar; unsigned x; volatile LAS unsigned* st; unsigned w; };
__device__ __forceinline__ XcdBarrier xcd_barrier_post(unsigned* bar, volatile LAS unsigned* st, unsigned w) {
    XcdBarrier b; b.bar = bar; b.x = xb_xcc_id(); b.st = st; b.w = w;
    if (w == 0u && lane_id_() == 0u) (void)xb_add(&bar[XB_XCNT(b.x)], 1u);
    return b;
}
__device__ __forceinline__ void xcd_barrier_complete(unsigned* bar, unsigned x, unsigned& nloc, unsigned& nx) {
    const unsigned G = gridDim.x * gridDim.y * gridDim.z;
    unsigned sum, cnt, mine, sp = 0u;
    for (;;) {
        sum = 0u; cnt = 0u; mine = 0u;
#pragma unroll
        for (unsigned j = 0; j < 16; ++j) { const unsigned c = xb_ld(&bar[XB_XCNT(j)]); sum += c; cnt += (c > 0u) ? 1u : 0u; mine = (j == x) ? c : mine; }
        if (sum == G) break;
        __builtin_amdgcn_s_sleep(1);
        if ((++sp & 255u) == 0u) { if (xb_ld(&bar[XB_TMO])) break; if (sp > XB_SPIN_CAP) { atomicAdd(&bar[XB_TMO], 1u); break; } }
    }
    nloc = mine > 0u ? mine : 1u; nx = cnt > 0u ? cnt : 1u;
}
__device__ __forceinline__ void xcd_barrier(const XcdBarrier& b) {
    asm volatile("s_waitcnt vmcnt(0)" ::: "memory");
    __syncthreads();
    if (b.w == 0u && lane_id_() == 0u) {
        unsigned* bar = b.bar;
        __builtin_amdgcn_s_waitcnt(0);
        unsigned nloc = b.st[0], nx = b.st[1];
        if (nloc == 0u) { xcd_barrier_complete(bar, b.x, nloc, nx); b.st[0] = nloc; b.st[1] = nx; }
        const unsigned old = xb_add(&bar[XB_XSUB(b.x)], 1u);
        const unsigned gen = old / nloc;
        if (old + 1u == (gen + 1u) * nloc) {
            __builtin_amdgcn_fence(__ATOMIC_RELEASE, "agent");
            asm volatile("s_waitcnt vmcnt(0)" ::: "memory");
            const unsigned og = xb_add(&bar[XB_TOP], 1u);
            const unsigned tg = og / nx;
            if (og + 1u == (tg + 1u) * nx) xb_add(&bar[XB_TOPGEN], 1u);
            else XB_SPIN(xb_ld(&bar[XB_TOPGEN]) == tg, bar);
            __builtin_amdgcn_fence(__ATOMIC_ACQUIRE, "agent");
            xb_add(&bar[XB_XGEN(b.x)], 1u);
            asm volatile("s_waitcnt vmcnt(0)" ::: "memory");
        } else {
            XB_SPIN(xb_ld(&bar[XB_XGEN(b.x)]) == gen, bar);
            __builtin_amdgcn_fence(__ATOMIC_ACQUIRE, "agent");
            asm volatile("s_waitcnt vmcnt(0)" ::: "memory");
        }
    }
    __syncthreads();
}

struct Frame {
    LAS unsigned char* lds;
    int tid, lane, wave, G;
};
DI Frame mkframe(LAS unsigned char* lds, int wv) { Frame F; int l = (int)lane_id_(); asm volatile("" : "+v"(l)); F.lane = l; F.wave = wv; F.tid = wv * 64 + l; F.G = gridDim.x; F.lds = lds; return F; }
DI const void* karg(int slot) {
    const volatile __attribute__((address_space(4))) unsigned long long* ka = (const volatile __attribute__((address_space(4))) unsigned long long*)__builtin_amdgcn_kernarg_segment_ptr();
    return (const void*)(const GAS void*)ka[slot];
}
#define KIN(i) ((const float*)karg(i))
#define KOUT ((float*)karg(23))
#define KWS ((unsigned char*)karg(24))
enum { I_X = 0, I_C, I_CTX, I_CCTX, I_ADAW, I_ADAB, I_NMIX, I_NFFN, I_FINALG, I_WQKV, I_WO, I_SINKS, I_GWIN, I_GWA1, I_GWA2, I_GBA, I_GNORM, I_GWO, I_RW, I_RB, I_MG, I_MU, I_MD };

namespace pg8 {
constexpr int BM = 256, BK = 64, HALF = 128, HTB = HALF * BK * 2, STAGE_BYTES = 8 * HTB, NXCD = 8, WGM = 8;
__host__ __device__ __forceinline__ int lds_byte(int r, int c) { const int st = (r >> 4) * 2 + (c >> 5), rr = r & 15, cc = c & 31, ob = rr * 64 + cc * 2; return st * 1024 + (ob ^ (((ob >> 9) & 1) << 5)); }
__host__ __device__ __forceinline__ void stage_rc(int b, int& R, int& C) { const int st = b / 1024, sb = b % 1024, swz = sb ^ (((sb >> 9) & 1) << 5); R = (st >> 1) * 16 + swz / 64; C = (st & 1) * 32 + (swz % 64) / 2; }
__host__ __device__ __forceinline__ int perm32(int rho) { const int n = rho >> 4, i = rho & 15; return 8 * (i >> 2) + 4 * n + (i & 3); }
struct Unit { int pm, pn; const char* bA; const char* bB; int cl, slot0, n; const float* bsc; };
DI bool static_next(int i, int G, int c, int nM, int nN, Unit& u) {
    const int nwg = nM * nN; const long L = (long)i * G + c; if (L >= nwg) return false;
    int wgid = (int)L; { const int q = nwg / NXCD, r = nwg % NXCD, xcd = wgid % NXCD, off = wgid / NXCD; wgid = (xcd < r ? xcd * (q + 1) : r * (q + 1) + (xcd - r) * q) + off; }
    const int nig = WGM * nN, gid = wgid / nig, fm = gid * WGM, gsz = (nM - fm) < WGM ? (nM - fm) : WGM;
    u.pm = fm + ((wgid % nig) % gsz); u.pn = (wgid % nig) / gsz; return true;
}
template <class Epi, class Sched, int MODE = 0>
__device__ __forceinline__ void gemm_phase(LAS unsigned char* lds, const int tid_in, const char* Abase, const int Kbytes, const unsigned ldb, const Sched& S, const Epi& E, unsigned long long& pacc) {
    constexpr bool I8 = MODE == 1, F8 = MODE == 2;
    int tid_ = tid_in; asm volatile("" : "+v"(tid_));
    const int tid = tid_, wid = __builtin_amdgcn_readfirstlane(tid >> 6), lane = tid & 63, wr = wid >> 2, wc = wid & 3, fr = lane & 15, fq = lane >> 4;
    const int nt = Kbytes / 128;
    int Rr[2], Cc[2]; unsigned voffB[2];
#pragma unroll
    for (int i = 0; i < 2; ++i) { int R, C; stage_rc(tid * 16 + i * 8192, R, C); Rr[i] = R; Cc[i] = C; const int Rb = Epi::PERM ? ((R & ~31) + perm32(R & 31)) : R; voffB[i] = (unsigned)Rb * ldb + (unsigned)C * 2u; }
    const size_t kstep = (size_t)(BK * 2);
    const size_t hstepB = (size_t)HALF * ldb;
    const unsigned ldsw = (unsigned)wid * 1024u;
    const int aoff = lds_byte(wr * 64 + fr, fq * 8), boff = lds_byte(wc * 32 + fr, fq * 8);
#define PG8_SA(b, h) (((b) * 2 + (h)) * HTB)
#define PG8_SB(b, h) ((4 + (b) * 2 + (h)) * HTB)
#define PG8_STAGE_B(bufoff, gbase) do { _Pragma("unroll") for (int _i = 0; _i < 2; ++_i) \
        __builtin_amdgcn_global_load_lds((const unsigned*)((const char*)(gbase) + voffB[_i]), (LAS unsigned*)(lds + (bufoff) + ldsw + _i * 8192), 16, 0, 0); } while (0)
#define PG8_STAGE_A(bufoff, koff, offs) do { _Pragma("unroll") for (int _i = 0; _i < 2; ++_i) \
        __builtin_amdgcn_global_load_lds((const unsigned*)(Abase + (koff) + (offs)[_i]), (LAS unsigned*)(lds + (bufoff) + ldsw + _i * 8192), 16, 0, 0); } while (0)
#define PG8_CAT8(p_) __builtin_shufflevector(*(const LAS i32x4*)(p_), *(const LAS i32x4*)((p_) + 1024), 0, 1, 2, 3, 4, 5, 6, 7)
#define PG8_LDA(dst, b, h) do { if constexpr (F8) { _Pragma("unroll") for (int m = 0; m < 4; ++m) dst##8[m] = PG8_CAT8(lds + PG8_SA(b, h) + aoff + m * 2048); } \
        else { _Pragma("unroll") for (int m = 0; m < 4; ++m) _Pragma("unroll") for (int k = 0; k < 2; ++k) dst[m][k] = *(const LAS bf16x8*)(lds + PG8_SA(b, h) + aoff + m * 2048 + k * 1024); } } while (0)
#define PG8_LDB(dst, b, h) do { if constexpr (F8) { _Pragma("unroll") for (int n = 0; n < 2; ++n) dst##8[n] = PG8_CAT8(lds + PG8_SB(b, h) + boff + n * 2048); } \
        else { _Pragma("unroll") for (int n = 0; n < 2; ++n) _Pragma("unroll") for (int k = 0; k < 2; ++k) dst[n][k] = *(const LAS bf16x8*)(lds + PG8_SB(b, h) + boff + n * 2048 + k * 1024); } } while (0)
#define PG8_MMA(ai, bj, At, Bt) do { __builtin_amdgcn_s_setprio(1); _Pragma("unroll") for (int m = 0; m < 4; ++m) _Pragma("unroll") for (int n = 0; n < 2; ++n) _Pragma("unroll") for (int k = 0; k < 2; ++k) { \
        if constexpr (F8) { if (k == 0) asm volatile("v_mfma_scale_f32_16x16x128_f8f6f4 %0, %1, %2, %0, %3, %3 op_sel_hi:[0,0,0]" : "+v"(acc[ai][bj][m][n]) : "v"(Bt##8[n]), "v"(At##8[m]), "v"(f8one)); } \
        else if constexpr (I8) acc[ai][bj][m][n] = __builtin_bit_cast(f32x4, __builtin_amdgcn_mfma_i32_16x16x64_i8(__builtin_bit_cast(i32x4, Bt[n][k]), __builtin_bit_cast(i32x4, At[m][k]), __builtin_bit_cast(i32x4, acc[ai][bj][m][n]), 0, 0, 0)); \
        else acc[ai][bj][m][n] = __builtin_amdgcn_mfma_f32_16x16x32_bf16(Bt[n][k], At[m][k], acc[ai][bj][m][n], 0, 0, 0); } __builtin_amdgcn_s_setprio(0); } while (0)
#define PG8_WAIT_V(n) asm volatile("s_waitcnt vmcnt(" #n ")" ::: "memory")
#define PG8_WAIT_L(n) asm volatile("s_waitcnt lgkmcnt(" #n ")" ::: "memory")
#define PG8_BAR __builtin_amdgcn_s_barrier()
#define PG8_SCHED __builtin_amdgcn_sched_barrier(0)
#if PROBE_GEMM
    unsigned long long gtp_ = __builtin_amdgcn_s_memrealtime();
#define GEMT(k) do { const unsigned long long tn_ = __builtin_amdgcn_s_memrealtime(); if (PROBE_GEMM == (k)) pacc += tn_ - gtp_; gtp_ = tn_; } while (0)
#else
#define GEMT(k) do { } while (0)
#endif
    Unit cur, nxt; int ui = 0;
    if (!S.next(0, cur)) return;
#if GEMM_STAGGER_TICKS
    { const int nwg_ = S.total(), G_ = (int)gridDim.x, c_ = (int)blockIdx.x; const int nmax_ = (nwg_ + G_ - 1) / G_, mine_ = (nwg_ - 1 - c_) / G_ + 1;
      if (mine_ < nmax_) { const unsigned long long t0_ = __builtin_amdgcn_s_memrealtime(); while (__builtin_amdgcn_s_memrealtime() - t0_ < (unsigned long long)GEMM_STAGGER_TICKS) __builtin_amdgcn_s_sleep(16); } }
#endif
    f32x4 acc[2][2][4][2];
#pragma unroll
    for (int a = 0; a < 2; ++a)
#pragma unroll
        for (int b = 0; b < 2; ++b)
#pragma unroll
            for (int m = 0; m < 4; ++m)
#pragma unroll
                for (int n = 0; n < 2; ++n) acc[a][b][m][n] = (f32x4){0.f, 0.f, 0.f, 0.f};
    int f8one = 0x7F7F7F7F; asm volatile("" : "+v"(f8one));
    bf16x8 At[4][2], B0[2][2], B1[2][2]; i32x8 At8[4], B08[2], B18[2];
    unsigned oC[2][2], oN[2][2];
#pragma unroll
    for (int h = 0; h < 2; ++h)
#pragma unroll
        for (int i = 0; i < 2; ++i) { oC[h][i] = S.a_off(cur, h * HALF + Rr[i]) + (unsigned)Cc[i] * 2u; asm volatile("" : "+v"(oC[h][i])); }
#define PG8_BPTR(u, t) (((t) < Sched::KSPLIT ? (u).bA : (u).bB) + (size_t)((t) & (Sched::KSPLIT - 1)) * 128)
    const char* cB = PG8_BPTR(cur, 0);
    PG8_STAGE_B(PG8_SB(0, 0), cB); PG8_STAGE_B(PG8_SB(0, 1), cB + hstepB); PG8_STAGE_A(PG8_SA(0, 0), 0, oC[0]); PG8_STAGE_A(PG8_SA(0, 1), 0, oC[1]);
    if (wr == 1) PG8_BAR;
    PG8_WAIT_V(2); PG8_BAR;
    { const char* cB1 = PG8_BPTR(cur, 1); PG8_STAGE_B(PG8_SB(1, 0), cB1); PG8_STAGE_A(PG8_SA(1, 0), kstep, oC[0]); PG8_STAGE_B(PG8_SB(1, 1), cB1 + hstepB); }
    PG8_WAIT_V(6); PG8_BAR;
    for (;;) {
        const bool has_next = S.next(ui + 1, nxt);
        if (!has_next) nxt = cur;
        if constexpr (!Sched::GATHER) {
#pragma unroll
            for (int h = 0; h < 2; ++h)
#pragma unroll
                for (int i = 0; i < 2; ++i) { oN[h][i] = S.a_off(nxt, h * HALF + Rr[i]) + (unsigned)Cc[i] * 2u; asm volatile("" : "+v"(oN[h][i])); }
        }
        if constexpr (I8 || F8 || Sched::GATHER || Epi::HAS_GL) {
            int t8 = tid; asm volatile("" : "+v"(t8)); const int wid8 = __builtin_amdgcn_readfirstlane(t8 >> 6); const unsigned l8 = (unsigned)(t8 & 63) * 4u;
            LAS unsigned char* tbc = lds + TAB_OFF + (ui & 1) * TAB_STRIDE;
            if constexpr (F8) { if (wid8 >= 4) __builtin_amdgcn_global_load_lds((const unsigned*)((const char*)S.b_scale(cur) + (wid8 - 4) * 256 + l8), (LAS unsigned*)(tbc + wid8 * 256), 4, 0, 0); }
            if constexpr (I8) { const char* g8 = wid8 < 4 ? (const char*)S.sa_ptr(cur) + wid8 * 256 : (const char*)S.b_scale(cur) + (wid8 - 4) * 256;
                __builtin_amdgcn_global_load_lds((const unsigned*)(g8 + l8), (LAS unsigned*)(tbc + wid8 * 256), 4, 0, 0); }
            if constexpr (Epi::HAS_GL) __builtin_amdgcn_global_load_lds((const unsigned*)((const char*)E.gl_ptr(cur) + wid8 * 256 + l8), (LAS unsigned*)(tbc + 2048 + wid8 * 256), 4, 0, 0);
            if constexpr (Sched::GATHER) { if (wid8 < 4) __builtin_amdgcn_global_load_lds((const unsigned*)((const char*)S.list_ptr(nxt) + wid8 * 256 + l8), (LAS unsigned*)(lds + TAB_OFF + ((ui + 1) & 1) * TAB_STRIDE + 4096 + wid8 * 256), 4, 0, 0); }
        }
        GEMT(3);
        for (int t = 0; t < nt; t += 2) {
            const bool last = (t == nt - 2);
            const size_t a1k = (size_t)(t + 1) * kstep;
            const size_t a2k = last ? 0 : (size_t)(t + 2) * kstep, a3k = a2k + kstep;
            const char* b2 = last ? PG8_BPTR(nxt, 0) : PG8_BPTR(cur, t + 2);
            const char* b3 = last ? PG8_BPTR(nxt, 1) : PG8_BPTR(cur, t + 3);
            if constexpr (Sched::GATHER) {
                const LAS int* Ln = (const LAS int*)(lds + TAB_OFF + ((ui + 1) & 1) * TAB_STRIDE + 4096);
#pragma unroll
                for (int h = 0; h < 2; ++h)
#pragma unroll
                    for (int i = 0; i < 2; ++i) { const int row = h * HALF + Rr[i]; int tok = Ln[row]; tok = S.row_valid(nxt, row) ? tok : 0; oN[h][i] = (unsigned)tok * 1024u + (unsigned)Cc[i] * 2u; }
            }
            unsigned o2[2][2];
            { const unsigned c00 = oC[0][0], c01 = oC[0][1], c10 = oC[1][0], c11 = oC[1][1], n00 = oN[0][0], n01 = oN[0][1], n10 = oN[1][0], n11 = oN[1][1];
              o2[0][0] = last ? n00 : c00; o2[0][1] = last ? n01 : c01; o2[1][0] = last ? n10 : c10; o2[1][1] = last ? n11 : c11; }
            PG8_LDB(B0, 0, 0); PG8_LDB(B1, 0, 1); PG8_SCHED; PG8_LDA(At, 0, 0); PG8_STAGE_A(PG8_SA(1, 1), a1k, oC[1]);
            PG8_WAIT_V(8); PG8_WAIT_L(0); PG8_BAR; PG8_MMA(0, 0, At, B0); PG8_MMA(0, 1, At, B1); PG8_BAR; PG8_SCHED;
            PG8_LDA(At, 0, 1); PG8_STAGE_B(PG8_SB(0, 0), b2); PG8_STAGE_B(PG8_SB(0, 1), b2 + hstepB); PG8_STAGE_A(PG8_SA(0, 0), a2k, o2[0]);
            PG8_WAIT_V(8); PG8_WAIT_L(0); PG8_BAR; PG8_MMA(1, 0, At, B0); PG8_MMA(1, 1, At, B1); PG8_BAR; PG8_SCHED;
            PG8_LDB(B0, 1, 0); PG8_LDB(B1, 1, 1); PG8_SCHED; PG8_LDA(At, 1, 0); PG8_STAGE_A(PG8_SA(0, 1), a2k, o2[1]);
            PG8_WAIT_V(8); PG8_WAIT_L(0); PG8_BAR; PG8_MMA(0, 0, At, B0); PG8_MMA(0, 1, At, B1); PG8_BAR; PG8_SCHED;
            PG8_LDA(At, 1, 1); PG8_STAGE_B(PG8_SB(1, 0), b3); PG8_STAGE_B(PG8_SB(1, 1), b3 + hstepB); PG8_STAGE_A(PG8_SA(1, 0), a3k, o2[0]);
            PG8_WAIT_V(8); PG8_WAIT_L(0); PG8_BAR; PG8_MMA(1, 0, At, B0); PG8_MMA(1, 1, At, B1); PG8_BAR; PG8_SCHED;
        }
        GEMT(1);
        if constexpr (F8) asm volatile("s_nop 15\n\ts_nop 15" ::: "memory");
        if (wr == 0) PG8_BAR;
        if constexpr (I8) {
            int t7 = tid; asm volatile("" : "+v"(t7)); const int wid7 = __builtin_amdgcn_readfirstlane(t7 >> 6), l7 = t7 & 63, wr7 = wid7 >> 2, wc7 = wid7 & 3, fr7 = l7 & 15, fq7 = l7 >> 4;
            const LAS float* sap = (const LAS float*)(lds + TAB_OFF + (ui & 1) * TAB_STRIDE); const LAS float* sbp = sap + 256 + wc7 * 32 + (Epi::PERM ? 8 * fq7 : 4 * fq7);
#pragma unroll
            for (int a = 0; a < 2; ++a)
#pragma unroll
                for (int m = 0; m < 4; ++m) { const int row7 = a * HALF + wr7 * 64 + m * 16 + fr7; float sa_ = sap[row7]; sa_ = S.row_valid(cur, row7) ? sa_ : 0.f;
#pragma unroll
                    for (int b = 0; b < 2; ++b)
#pragma unroll
                        for (int n = 0; n < 2; ++n) { const f32x4 sb_ = *(const LAS f32x4*)(sbp + b * HALF + (Epi::PERM ? 4 * n : 16 * n)); const i32x4 v = __builtin_bit_cast(i32x4, acc[a][b][m][n]);
                            acc[a][b][m][n] = (f32x4){(float)v[0], (float)v[1], (float)v[2], (float)v[3]} * sa_ * sb_; } }
        }
        if constexpr (F8) {
            int t7 = tid; asm volatile("" : "+v"(t7)); const int wid7 = __builtin_amdgcn_readfirstlane(t7 >> 6), l7 = t7 & 63, wc7 = wid7 & 3, fq7 = l7 >> 4;
            const LAS float* sbp = (const LAS float*)(lds + TAB_OFF + (ui & 1) * TAB_STRIDE) + 256 + wc7 * 32 + (Epi::PERM ? 8 * fq7 : 4 * fq7); const float ac_ = S.a_const();
#pragma unroll
            for (int b = 0; b < 2; ++b)
#pragma unroll
                for (int n = 0; n < 2; ++n) { const f32x4 sb_ = *(const LAS f32x4*)(sbp + b * HALF + (Epi::PERM ? 4 * n : 16 * n)) * ac_;
#pragma unroll
                    for (int a = 0; a < 2; ++a)
#pragma unroll
                        for (int m = 0; m < 4; ++m) acc[a][b][m][n] = acc[a][b][m][n] * sb_; }
        }
        E(acc, cur, wr, wc, fr, fq, (const LAS unsigned char*)(lds + TAB_OFF + (ui & 1) * TAB_STRIDE));
        GEMT(2);
        if (!has_next) break;
#pragma unroll
        for (int a = 0; a < 2; ++a)
#pragma unroll
            for (int b = 0; b < 2; ++b)
#pragma unroll
                for (int m = 0; m < 4; ++m)
#pragma unroll
                    for (int n = 0; n < 2; ++n) acc[a][b][m][n] = (f32x4){0.f, 0.f, 0.f, 0.f};
        cur = nxt; ++ui;
#pragma unroll
        for (int h = 0; h < 2; ++h)
#pragma unroll
            for (int i = 0; i < 2; ++i) oC[h][i] = oN[h][i];
        if (wr == 1) PG8_BAR;
    }
    PG8_WAIT_V(0);
    PG8_BAR;
    GEMT(3);
#undef GEMT
#undef PG8_BPTR
#undef PG8_SA
#undef PG8_SB
#undef PG8_STAGE_A
#undef PG8_STAGE_B
#undef PG8_LDA
#undef PG8_LDB
#undef PG8_MMA
#undef PG8_WAIT_V
#undef PG8_WAIT_L
#undef PG8_BAR
#undef PG8_SCHED
}
}
using pg8::Unit;

struct DenseOrder {
    int nM, nN, G, c; unsigned lda; const char* Bt; unsigned ldb; const float* sa; const float* sb; float ac = 1.f;
    DI float a_const() const { return ac; }
    DI bool next(int i, Unit& u) const { if (!pg8::static_next(i, G, c, nM, nN, u)) return false; u.bA = Bt + (size_t)u.pn * 256 * ldb; u.bB = u.bA + 1024; u.cl = 0; u.slot0 = 0; u.n = 0; u.bsc = sb + u.pn * 256; return true; }
    static constexpr bool GATHER = false; static constexpr int KSPLIT = 8;
    DI const float* sa_ptr(const Unit& u) const { return sa + u.pm * 256; }
    DI const float* b_scale(const Unit& u) const { return u.bsc; }
    DI bool row_valid(const Unit&, int) const { return true; }
    DI const int* list_ptr(const Unit&) const { return nullptr; }
    DI unsigned a_off(const Unit& u, int row) const { return (unsigned)(u.pm * 256 + row) * lda; }
    DI int total() const { return nM * nN; }
};
DI int moe_class(const LAS int* bs, int pm) { int c = 0;
#pragma unroll
    for (int k = 1; k < NCLS; ++k) c += (bs[k] <= pm) ? 1 : 0;
    return c; }
DI void moe_experts(int c, int& elo, int& ehi) { const int g = c / 6, p = c - 6 * g; const int lo = p < 3 ? 0 : (p < 5 ? 1 : 2), hi = p < 3 ? p + 1 : (p < 5 ? p - 1 : 3); elo = 4 * g + lo; ehi = 4 * g + hi; }
struct MoeUpOrder {
    int nM, G, c; const LAS int* bs; const LAS int* cnt; const int* list; const char* Wgu; const float* slist; const float* sbgu;
    DI bool next(int i, Unit& u) const { if (!pg8::static_next(i, G, c, nM, 8, u)) return false;
        const int cl = __builtin_amdgcn_readfirstlane(moe_class(bs, u.pm)); int elo, ehi; moe_experts(cl, elo, ehi); const int e = u.pn < 4 ? elo : ehi;
        u.bA = Wgu + (size_t)e * (1024 * 1024) + (size_t)(u.pn & 3) * 256 * 1024; u.bB = u.bA + 1024; u.cl = cl; u.slot0 = (u.pm - __builtin_amdgcn_readfirstlane(bs[cl])) * 256; u.n = __builtin_amdgcn_readfirstlane(cnt[cl]); u.bsc = sbgu + e * 1024 + (u.pn & 3) * 256; return true; }
    DI unsigned a_off(const Unit& u, int row) const { const int slot = u.slot0 + row; int tok = 0; if (slot < u.n) tok = list[(size_t)u.cl * MT + slot]; return (unsigned)tok * 1024u; }
    static constexpr int KSPLIT = 8;
    static constexpr bool GATHER = true;
    DI const float* sa_ptr(const Unit& u) const { return slist + (size_t)u.cl * MT + u.slot0; }
    DI const int* list_ptr(const Unit& u) const { return list + (size_t)u.cl * MT + u.slot0; }
    DI bool row_valid(const Unit& u, int row) const { return u.slot0 + row < u.n; }
    DI const float* b_scale(const Unit& u) const { return u.bsc; }
};
struct MoeDownOrder {
    int nM, G, c; const LAS int* bs; const char* Wd; const float* sbd;
    static constexpr bool GATHER = false; static constexpr int KSPLIT = 4;
    DI bool next(int i, Unit& u) const { if (!pg8::static_next(i, G, c, nM, 4, u)) return false;
        const int cl = __builtin_amdgcn_readfirstlane(moe_class(bs, u.pm)); int elo, ehi; moe_experts(cl, elo, ehi);
        u.bA = Wd + (size_t)elo * (1024 * 512) + (size_t)u.pn * 256 * 512; u.bB = Wd + (size_t)ehi * (1024 * 512) + (size_t)u.pn * 256 * 512; u.cl = cl; u.slot0 = 0; u.n = 0; u.bsc = sbd + (cl / 6) * 1024 + u.pn * 256; return true; }
    DI unsigned a_off(const Unit& u, int row) const { return (unsigned)(u.pm * 256 + row) * 1024u; }
    DI const float* sa_ptr(const Unit&) const { return nullptr; }
    DI const float* b_scale(const Unit& u) const { return u.bsc; }
    DI float a_const() const { return 1.0f / HID_SCALE; }
    DI bool row_valid(const Unit&, int) const { return true; }
    DI const int* list_ptr(const Unit&) const { return nullptr; }
    DI int total() const { return nM * 4; }
};

struct EpiQKV {
    static constexpr bool PERM = false, HAS_GL = false;
    bf16_t* P; const LAS float* rope;
    DI void operator()(const f32x4 (&acc)[2][2][4][2], const Unit& u, int wr, int wc, int fr, int fq, const LAS unsigned char* tb) const {
        const int row0 = u.pm * 256 + wr * 64 + fr; const bool lat = u.pm < 256; const bool dorope = lat && u.pn < 5; const float sc = u.pn < 4 ? QSCALE : 1.0f;
#pragma unroll
        for (int ai = 0; ai < 2; ++ai)
#pragma unroll
            for (int m = 0; m < 4; ++m) { const int row = row0 + ai * 128 + m * 16; const int t = row & 2047; const int pos = (wc & 1) ? (t & 63) : (t >> 6);
                f32x4 cs = (f32x4){1.f, 1.f, 1.f, 1.f}, sn = (f32x4){0.f, 0.f, 0.f, 0.f};
                if (dorope) { cs = *(const LAS f32x4*)(rope + pos * 32 + 4 * fq); sn = *(const LAS f32x4*)(rope + pos * 32 + 16 + 4 * fq); }
                bf16_t* rowp = P + (size_t)row * NQKV + u.pn * 256 + wc * 32 + 4 * fq;
#pragma unroll
                for (int bj = 0; bj < 2; ++bj) { const f32x4 y1 = acc[ai][bj][m][0], y2 = acc[ai][bj][m][1];
                    const f32x4 o1 = (y1 * cs - y2 * sn) * sc, o2 = (y2 * cs + y1 * sn) * sc;
                    u32x2 w1, w2; w1.x = cvt_pk_bf16(o1[0], o1[1]); w1.y = cvt_pk_bf16(o1[2], o1[3]); w2.x = cvt_pk_bf16(o2[0], o2[1]); w2.y = cvt_pk_bf16(o2[2], o2[3]);
                    *(u32x2*)(rowp + bj * 128) = w1; *(u32x2*)(rowp + bj * 128 + 16) = w2; } }
    }
};
struct EpiGLA {
    static constexpr bool PERM = true, HAS_GL = false;
    bf16_t* R2b; float* R;
    DI void operator()(const f32x4 (&acc)[2][2][4][2], const Unit& u, int wr, int wc, int fr, int fq, const LAS unsigned char* tb) const {
        const int row0 = u.pm * 256 + wr * 64 + fr;
        if (u.pn == 12) { if (wc == 0) {
#pragma unroll
            for (int ai = 0; ai < 2; ++ai)
#pragma unroll
                for (int m = 0; m < 4; ++m) { float* rp = R + (size_t)(row0 + ai * 128 + m * 16) * 32 + 8 * fq; *(f32x4*)rp = acc[ai][0][m][0]; *(f32x4*)(rp + 4) = acc[ai][0][m][1]; } }
            return; }
        const int tsel = u.pn < 4 ? 0 : (u.pn < 8 ? 2 : 1);
        bf16_t* base = R2b + (size_t)tsel * ((size_t)MT * 1024); const int colt = (u.pn & 3) * 256; const float sc = u.pn < 2 ? 0.08838834764831845f : 1.0f;
#pragma unroll
        for (int ai = 0; ai < 2; ++ai)
#pragma unroll
            for (int m = 0; m < 4; ++m) { bf16_t* rowp = base + (size_t)(row0 + ai * 128 + m * 16) * 1024 + colt + wc * 32 + 8 * fq;
#pragma unroll
                for (int bj = 0; bj < 2; ++bj) { const f32x4 v0 = acc[ai][bj][m][0] * sc, v1 = acc[ai][bj][m][1] * sc;
                    u32x4 w; w.x = cvt_pk_bf16(v0[0], v0[1]); w.y = cvt_pk_bf16(v0[2], v0[3]); w.z = cvt_pk_bf16(v1[0], v1[1]); w.w = cvt_pk_bf16(v1[2], v1[3]);
                    *(u32x4*)(rowp + bj * 128) = w; } }
    }
};
struct EpiY {
    static constexpr bool PERM = true, HAS_GL = false;
    unsigned char* Y;
    DI void operator()(const f32x4 (&acc)[2][2][4][2], const Unit& u, int wr, int wc, int fr, int fq, const LAS unsigned char* tb) const {
        const int row0 = u.pm * 256 + wr * 64 + fr; const int col0 = u.pn * 256 + wc * 32 + 8 * fq;
#pragma unroll
        for (int ai = 0; ai < 2; ++ai)
#pragma unroll
            for (int m = 0; m < 4; ++m) { unsigned char* rowp = Y + (size_t)(row0 + ai * 128 + m * 16) * 1024 + col0;
#pragma unroll
                for (int bj = 0; bj < 2; ++bj) { const f32x4 v0 = acc[ai][bj][m][0] * Y_SCALE, v1 = acc[ai][bj][m][1] * Y_SCALE;
                    int w0 = 0, w1 = 0;
                    w0 = __builtin_amdgcn_cvt_pk_fp8_f32(__builtin_amdgcn_fmed3f(v0[0], -448.f, 448.f), __builtin_amdgcn_fmed3f(v0[1], -448.f, 448.f), w0, false); w0 = __builtin_amdgcn_cvt_pk_fp8_f32(__builtin_amdgcn_fmed3f(v0[2], -448.f, 448.f), __builtin_amdgcn_fmed3f(v0[3], -448.f, 448.f), w0, true);
                    w1 = __builtin_amdgcn_cvt_pk_fp8_f32(__builtin_amdgcn_fmed3f(v1[0], -448.f, 448.f), __builtin_amdgcn_fmed3f(v1[1], -448.f, 448.f), w1, false); w1 = __builtin_amdgcn_cvt_pk_fp8_f32(__builtin_amdgcn_fmed3f(v1[2], -448.f, 448.f), __builtin_amdgcn_fmed3f(v1[3], -448.f, 448.f), w1, true);
                    *(u32x2*)(rowp + bj * 128) = (u32x2){(unsigned)w0, (unsigned)w1}; } }
    }
};
DI float silu_fast(float a) { return a * __builtin_amdgcn_rcpf(1.0f + __builtin_amdgcn_exp2f(-a * LOG2E)); }
struct EpiSwiGLU {
    static constexpr bool PERM = true, HAS_GL = true;
    unsigned char* HID; const f32x2* glist;
    DI const f32x2* gl_ptr(const Unit& u) const { return glist + (size_t)u.cl * MT + u.slot0; }
    DI void operator()(const f32x4 (&acc)[2][2][4][2], const Unit& u, int wr, int wc, int fr, int fq, const LAS unsigned char* tb) const {
        const int sel = u.pn >> 2, hb = u.pn & 3; const int r0 = wr * 64 + fr; const LAS f32x2* gl = (const LAS f32x2*)(tb + 2048);
#pragma unroll
        for (int ai = 0; ai < 2; ++ai) {
            float gwv[4];
#pragma unroll
            for (int m = 0; m < 4; ++m) { const int rr_ = r0 + ai * 128 + m * 16; const f32x2 gg = gl[rr_]; const float g = (sel ? gg.y : gg.x) * HID_SCALE; gwv[m] = (u.slot0 + rr_ < u.n) ? g : 0.f; }
#pragma unroll
            for (int m = 0; m < 4; ++m) { const int r = r0 + ai * 128 + m * 16; const float gw = gwv[m];
                const f32x4 a0 = acc[ai][0][m][0], a1 = acc[ai][0][m][1], b0 = acc[ai][1][m][0], b1 = acc[ai][1][m][1];
                float h[8];
#pragma unroll
                for (int e = 0; e < 4; ++e) { h[e] = __builtin_amdgcn_fmed3f(silu_fast(a0[e]) * b0[e] * gw, -448.f, 448.f); h[4 + e] = __builtin_amdgcn_fmed3f(silu_fast(a1[e]) * b1[e] * gw, -448.f, 448.f); }
                int w0 = 0, w1 = 0; w0 = __builtin_amdgcn_cvt_pk_fp8_f32(h[0], h[1], w0, false); w0 = __builtin_amdgcn_cvt_pk_fp8_f32(h[2], h[3], w0, true); w1 = __builtin_amdgcn_cvt_pk_fp8_f32(h[4], h[5], w1, false); w1 = __builtin_amdgcn_cvt_pk_fp8_f32(h[6], h[7], w1, true);
                *(u32x2*)(HID + (size_t)(u.pm * 256 + r) * 1024 + sel * 512 + hb * 128 + wc * 32 + 8 * fq) = (u32x2){(unsigned)w0, (unsigned)w1}; } }
    }
};

struct TItem { const float* W; int ldw; bf16_t* WT; int Kd, k0, n0, drow0; };
DI void titem_load(const TItem& I, f32x4 (&t)[8], int lane) {
#pragma unroll
    for (int i = 0; i < 8; ++i) { const int idx = lane + 64 * i; t[i] = *(const f32x4*)(I.W + (size_t)(I.k0 + (idx >> 3)) * I.ldw + I.n0 + 4 * (idx & 7)); }
}
DI void titem_store(const TItem& I, const f32x4 (&t)[8], LAS float* scr, int lane) {
#pragma unroll
    for (int i = 0; i < 8; ++i) { const int idx = lane + 64 * i; LAS float* d = scr + (idx >> 3) * 33 + 4 * (idx & 7); d[0] = t[i][0]; d[1] = t[i][1]; d[2] = t[i][2]; d[3] = t[i][3]; }
    asm volatile("s_waitcnt lgkmcnt(0)" ::: "memory");
    const int c = lane & 7;
#pragma unroll
    for (int j = 0; j < 4; ++j) { const int n = (lane >> 3) + 8 * j; const LAS float* s = scr + (8 * c) * 33 + n;
        u32x4 o; o.x = cvt_pk_bf16(s[0 * 33], s[1 * 33]); o.y = cvt_pk_bf16(s[2 * 33], s[3 * 33]); o.z = cvt_pk_bf16(s[4 * 33], s[5 * 33]); o.w = cvt_pk_bf16(s[6 * 33], s[7 * 33]);
        *(u32x4*)(I.WT + (size_t)(I.drow0 + n) * I.Kd + I.k0 + 8 * c) = o; }
    asm volatile("s_waitcnt lgkmcnt(0)" ::: "memory");
}
template <bool F8>
DI void wstrip_q(const float* W, int ldw, int nkb, int kbsh, size_t estride, int rowlen, signed char* W8, int n0, int drow0, float* sb, LAS float* scr, int lane) {
    constexpr float QMAX = F8 ? 224.0f : 127.0f;
    const int kmask = (1 << kbsh) - 1;
    float m4[4] = {0.f, 0.f, 0.f, 0.f};
    for (int kb = 0; kb < nkb; ++kb) { f32x4 t[8];
#pragma unroll
        for (int i = 0; i < 8; ++i) { const int idx = lane + 64 * i; t[i] = *(const f32x4*)(W + (size_t)(64 * kb + (idx >> 3)) * ldw + n0 + 4 * (idx & 7)); }
#pragma unroll
        for (int i = 0; i < 8; ++i)
#pragma unroll
            for (int e = 0; e < 4; ++e) m4[e] = fmaxf(m4[e], fabsf(t[i][e])); }
#pragma unroll
    for (int o = 8; o < 64; o <<= 1)
#pragma unroll
        for (int e = 0; e < 4; ++e) m4[e] = fmaxf(m4[e], shx(m4[e], o, lane));
    LAS float* inv = scr + 64 * 33;
    if (lane < 8) {
#pragma unroll
        for (int e = 0; e < 4; ++e) { const float am = m4[e]; sb[drow0 + 4 * lane + e] = am > 0.f ? am * (1.0f / QMAX) : 1.0f; inv[4 * lane + e] = am > 0.f ? QMAX / am : 0.f; } }
    asm volatile("s_waitcnt lgkmcnt(0)" ::: "memory");
    for (int kb = 0; kb < nkb; ++kb) { f32x4 t[8];
#pragma unroll
        for (int i = 0; i < 8; ++i) { const int idx = lane + 64 * i; t[i] = *(const f32x4*)(W + (size_t)(64 * kb + (idx >> 3)) * ldw + n0 + 4 * (idx & 7)); }
#pragma unroll
        for (int i = 0; i < 8; ++i) { const int idx = lane + 64 * i; LAS float* d = scr + (idx >> 3) * 33 + 4 * (idx & 7); d[0] = t[i][0]; d[1] = t[i][1]; d[2] = t[i][2]; d[3] = t[i][3]; }
        asm volatile("s_waitcnt lgkmcnt(0)" ::: "memory");
#pragma unroll
        for (int j = 0; j < 2; ++j) { const int p = lane + 64 * j; const int n = p >> 2, c = p & 3; const float iv = inv[n]; const LAS float* sp = scr + (16 * c) * 33 + n; unsigned w[4];
#pragma unroll
            for (int q = 0; q < 4; ++q) {
                if constexpr (F8) { int pk = 0; pk = __builtin_amdgcn_cvt_pk_fp8_f32(sp[(4 * q) * 33] * iv, sp[(4 * q + 1) * 33] * iv, pk, false); pk = __builtin_amdgcn_cvt_pk_fp8_f32(sp[(4 * q + 2) * 33] * iv, sp[(4 * q + 3) * 33] * iv, pk, true); w[q] = (unsigned)pk; }
                else { unsigned pk = 0u;
#pragma unroll
                    for (int e = 0; e < 4; ++e) { const int qi = (int)__builtin_rintf(sp[(4 * q + e) * 33] * iv); pk |= ((unsigned)qi & 0xffu) << (8 * e); }
                    w[q] = pk; } }
            *(u32x4*)(W8 + (size_t)(kb >> kbsh) * estride + (size_t)(drow0 + n) * rowlen + 64 * (kb & kmask) + 16 * c) = (u32x4){w[0], w[1], w[2], w[3]}; }
        asm volatile("s_waitcnt lgkmcnt(0)" ::: "memory"); }
}
DI void wstrip_i8(const float* W, int ldw, signed char* W8, int n0, int drow0, float* sb, LAS float* scr, int lane) { wstrip_q<false>(W, ldw, 16, 4, 0, 1024, W8, n0, drow0, sb, scr, lane); }
template <bool F8, int NB>
DI void wstrip_blk(LAS unsigned char* lds, int wave, int lane_in, const float* W, int ldw, int kbsh, size_t estride, int rowlen, signed char* W8, int n0, int drow0, float* sb, int par) {
    constexpr float QMAX = F8 ? 224.0f : 127.0f;
    int lane = lane_in; asm volatile("" : "+v"(lane));
    const int kmask = (1 << kbsh) - 1;
    LAS float* scr = (LAS float*)(lds + wave * 16384);
    LAS float* amx = (LAS float*)(lds + 131072 + par * 1024);
    f32x4 t[NB][8];
    const GAS char* wb = (const GAS char*)(W + (size_t)(64 * NB * wave) * ldw + n0); const unsigned lo = (unsigned)(((lane >> 3) * ldw + 4 * (lane & 7)) * 4);
#pragma unroll
    for (int b = 0; b < NB; ++b)
#pragma unroll
        for (int i = 0; i < 8; ++i) t[b][i] = *(const GAS f32x4*)(wb + (size_t)(64 * b + 8 * i) * ldw * 4 + lo);
    float m4[4] = {0.f, 0.f, 0.f, 0.f};
#pragma unroll
    for (int b = 0; b < NB; ++b)
#pragma unroll
        for (int i = 0; i < 8; ++i)
#pragma unroll
            for (int e = 0; e < 4; ++e) m4[e] = fmaxf(m4[e], fabsf(t[b][i][e]));
#pragma unroll
    for (int o = 8; o < 64; o <<= 1)
#pragma unroll
        for (int e = 0; e < 4; ++e) m4[e] = fmaxf(m4[e], shx(m4[e], o, lane));
    if (lane < 8) *(LAS f32x4*)(amx + wave * 32 + 4 * lane) = (f32x4){m4[0], m4[1], m4[2], m4[3]};
    __syncthreads();
    LAS float* inv = scr + 64 * 33;
    if (lane < 32) { float am = 0.f;
#pragma unroll
        for (int w = 0; w < 8; ++w) am = fmaxf(am, amx[w * 32 + lane]);
        inv[lane] = am > 0.f ? QMAX / am : 0.f; if (wave == 0) sb[drow0 + lane] = am > 0.f ? am * (1.0f / QMAX) : 1.0f; }
    asm volatile("s_waitcnt lgkmcnt(0)" ::: "memory");
#pragma unroll
    for (int b = 0; b < NB; ++b) { const int kb = NB * wave + b;
#pragma unroll
        for (int i = 0; i < 8; ++i) { const int idx = lane + 64 * i; LAS float* d = scr + (idx >> 3) * 33 + 4 * (idx & 7); d[0] = t[b][i][0]; d[1] = t[b][i][1]; d[2] = t[b][i][2]; d[3] = t[b][i][3]; }
        asm volatile("s_waitcnt lgkmcnt(0)" ::: "memory");
#pragma unroll
        for (int j = 0; j < 2; ++j) { const int p = lane + 64 * j; const int n = p >> 2, c = p & 3; const float iv = inv[n]; const LAS float* sp = scr + (16 * c) * 33 + n; unsigned w[4];
#pragma unroll
            for (int q = 0; q < 4; ++q) {
                if constexpr (F8) { int pk = 0; pk = __builtin_amdgcn_cvt_pk_fp8_f32(sp[(4 * q) * 33] * iv, sp[(4 * q + 1) * 33] * iv, pk, false); pk = __builtin_amdgcn_cvt_pk_fp8_f32(sp[(4 * q + 2) * 33] * iv, sp[(4 * q + 3) * 33] * iv, pk, true); w[q] = (unsigned)pk; }
                else { unsigned pk = 0u;
#pragma unroll
                    for (int e = 0; e < 4; ++e) { const int qi = (int)__builtin_rintf(sp[(4 * q + e) * 33] * iv); pk |= ((unsigned)qi & 0xffu) << (8 * e); }
                    w[q] = pk; } }
            GAS char* db = (GAS char*)W8 + (size_t)(kb >> kbsh) * estride + (size_t)(drow0 + 16 * j) * rowlen + 64 * (kb & kmask);
            *(GAS u32x4*)(db + (unsigned)((lane >> 2) * rowlen + 16 * c)) = (u32x4){w[0], w[1], w[2], w[3]}; }
        asm volatile("s_waitcnt lgkmcnt(0)" ::: "memory"); }
}
DI void p0_strip_item(Frame& F, unsigned char* const ws, const int it, const int par) {
    constexpr int S_QKV = 2 * 48, S_IN = 2 * 96, S_GO = 2 * 32, S_AO = 2 * 32;
            if (it < 512) { const int lg = it >> 5, nb = it & 31;
                wstrip_blk<true, 4>(F.lds, F.wave, F.lane, KIN(I_MD) + (size_t)lg * 4 * 512 * 1024, 1024, 3, (size_t)1024 * 512, 512, (signed char*)(ws + WS_WD) + (size_t)lg * 4 * 1024 * 512, 32 * nb, 32 * nb, (float*)(ws + WS_SBD) + lg * 1024, par); return; }
            int r = it - 512;
            if (r < S_QKV) { const int j = r / 48, nb = r % 48; wstrip_blk<false, 2>(F.lds, F.wave, F.lane, KIN(I_WQKV) + (size_t)j * 1024 * NQKV, NQKV, 4, 0, 1024, (signed char*)(ws + WS_WQKV) + (size_t)j * NQKV * 1024, 32 * nb, 32 * nb, (float*)(ws + WS_SBQKV) + j * NQKV, par); return; } r -= S_QKV;
            if (r < S_IN) { const int j = r / 96, nb = r % 96; wstrip_blk<false, 2>(F.lds, F.wave, F.lane, KIN(I_GWIN) + (size_t)j * 1024 * 3072, 3072, 4, 0, 1024, (signed char*)(ws + WS_WIN) + (size_t)j * NGIN * 1024, 32 * nb, 32 * nb, (float*)(ws + WS_SBIN) + j * NGIN, par); return; } r -= S_IN;
            if (r < S_GO) { const int j = r / 32, nb = r % 32; wstrip_blk<false, 2>(F.lds, F.wave, F.lane, KIN(I_GWO) + (size_t)j * 1024 * 1024, 1024, 4, 0, 1024, (signed char*)(ws + WS_WGO) + (size_t)j * 1024 * 1024, 32 * nb, 32 * nb, (float*)(ws + WS_SBGO) + j * 1024, par); return; } r -= S_GO;
            if (r < S_AO) { const int j = r / 32, nb = r % 32; wstrip_blk<true, 2>(F.lds, F.wave, F.lane, KIN(I_WO) + (size_t)j * 1024 * 1024, 1024, 4, 0, 1024, (signed char*)(ws + WS_WO) + (size_t)j * 1024 * 1024, 32 * nb, 32 * nb, (float*)(ws + WS_SBO) + j * 1024, par); return; } r -= S_AO;
            { const int le = r >> 5, q = r & 31, up = q >> 4, nb = q & 15; const int n0 = 32 * nb;
              wstrip_blk<false, 2>(F.lds, F.wave, F.lane, (up ? KIN(I_MU) : KIN(I_MG)) + (size_t)le * 1024 * 512, 512, 4, 0, 1024, (signed char*)(ws + WS_WGU) + (size_t)le * 1024 * 1024, n0, (n0 >> 7) * 256 + up * 128 + (n0 & 127), (float*)(ws + WS_SBGU) + le * 1024, par); }
}
DI void p0_prologue(Frame& F) {
    unsigned char* const ws = KWS;
    const int gw = blockIdx.x * NWAVES + F.wave, NGW = F.G * NWAVES;
    const int gtid = blockIdx.x * 512 + F.tid, NT = F.G * 512;
    {
        LAS float* sl = (LAS float*)F.lds;
        LAS float* red = (LAS float*)(F.lds + 40960);
        float* modp = ((float*)(ws + WS_MOD));
        const int kq = F.wave & 3, chh = F.wave >> 2;
        for (int it = blockIdx.x; it < 4 * 48; it += F.G) {
            const int l = it / 48, n0 = (it % 48) * 128;
            const float* W = KIN(I_ADAW) + (size_t)l * 1024 * 6144 + n0 + 64 * chh + F.lane; const float* cin = KIN(I_C); const float* ccin = KIN(I_CCTX); const float* adab = KIN(I_ADAB);
            float acc[33];
#pragma unroll
            for (int i = 0; i < 33; ++i) acc[i] = 0.f;
            for (int kc = 0; kc < 4; ++kc) {
                __syncthreads();
                for (int idx = F.tid; idx < 33 * 256; idx += 512) { const int mb = idx >> 8, k = idx & 255; const float cv = mb < 32 ? cin[mb * 1024 + kc * 256 + k] : ccin[kc * 256 + k]; sl[k * 36 + mb] = siluf_(cv); }
                __syncthreads();
                for (int kk0 = 0; kk0 < 64; kk0 += 16) { float wv[16];
#pragma unroll
                    for (int i = 0; i < 16; ++i) wv[i] = W[(size_t)(kc * 256 + kq * 64 + kk0 + i) * 6144];
#pragma unroll
                    for (int i = 0; i < 16; ++i) { const int k = kq * 64 + kk0 + i; const LAS f32x4* sp = (const LAS f32x4*)(sl + k * 36);
#pragma unroll
                        for (int q = 0; q < 8; ++q) { const f32x4 s4 = sp[q]; acc[4 * q] += s4[0] * wv[i]; acc[4 * q + 1] += s4[1] * wv[i]; acc[4 * q + 2] += s4[2] * wv[i]; acc[4 * q + 3] += s4[3] * wv[i]; }
                        acc[32] += sl[k * 36 + 32] * wv[i]; } }
            }
#pragma unroll
            for (int i = 0; i < 33; ++i) red[(kq * 33 + i) * 128 + 64 * chh + F.lane] = acc[i];
            __syncthreads();
            for (int idx = F.tid; idx < 33 * 128; idx += 512) { const int mb = idx >> 7, nn = idx & 127; float sm = 0.f;
#pragma unroll
                for (int q = 0; q < 4; ++q) sm += red[(q * 33 + mb) * 128 + nn];
                modp[((size_t)l * 33 + mb) * 6144 + n0 + nn] = sm + adab[l * 6144 + n0 + nn]; }
            __syncthreads();
        }
    }
    __syncthreads();
    {
        LAS float* scr = (LAS float*)(F.lds + F.wave * 16384);
        constexpr int I_O = 16 * 32, I_D = 8 * 32;
        constexpr int S_QKV = 2 * 48, S_IN = 2 * 96, S_GO = 2 * 32, S_AO = 2 * 32, S_GU = 64 * 32, N_STRIPS = S_QKV + S_IN + S_GO + S_AO + S_GU;
        { unsigned* qctr = (unsigned*)ws + CW_STRIPQ; LAS int* qslot = (LAS int*)(F.lds + 131072 + 2048);
          if (F.tid == 0) qslot[0] = (int)__hip_atomic_fetch_add(qctr, 1u, __ATOMIC_RELAXED, __HIP_MEMORY_SCOPE_AGENT);
          __syncthreads();
          int cnt = 0;
          for (int it = qslot[0]; it < 512 + N_STRIPS; ) { const int par = cnt & 1; int nx_ = 0;
            if (F.tid == 0) nx_ = (int)__hip_atomic_fetch_add(qctr, 1u, __ATOMIC_RELAXED, __HIP_MEMORY_SCOPE_AGENT);
            p0_strip_item(F, ws, it, par);
            if (F.tid == 0) qslot[(cnt + 1) & 1] = nx_;
            __syncthreads();
            ++cnt; it = qslot[cnt & 1]; } }
        { const float* wa1 = KIN(I_GWA1); signed char* Win8 = (signed char*)(ws + WS_WIN); float* sbin = (float*)(ws + WS_SBIN);
          for (int rw = gw; rw < 2 * 256; rw += NGW) { const int j = rw >> 8, rr = rw & 255; float v[16]; float am = 0.f;
#pragma unroll
              for (int e = 0; e < 16; ++e) { v[e] = rr < 32 ? wa1[(((size_t)j * 2 + (rr >> 4)) * 1024 + 16 * F.lane + e) * 16 + (rr & 15)] : 0.f; am = fmaxf(am, fabsf(v[e])); }
#pragma unroll
              for (int o = 1; o < 64; o <<= 1) am = fmaxf(am, shx(am, o, F.lane));
              const float iv = am > 0.f ? 127.0f / am : 0.f; unsigned w[4];
#pragma unroll
              for (int q = 0; q < 4; ++q) { unsigned pk = 0u;
#pragma unroll
                  for (int e = 0; e < 4; ++e) { const int qi = (int)__builtin_rintf(v[4 * q + e] * iv); pk |= ((unsigned)qi & 0xffu) << (8 * e); }
                  w[q] = pk; }
              *(u32x4*)(Win8 + ((size_t)j * NGIN + 3072 + rr) * 1024 + 16 * F.lane) = (u32x4){w[0], w[1], w[2], w[3]};
              if (F.lane == 0) sbin[j * NGIN + 3072 + rr] = am > 0.f ? am * (1.0f / 127.0f) : 1.0f; } }
    }
    __syncthreads();
    if (blockIdx.x == 0) { float* ropep = ((float*)(ws + WS_ROPE)); for (int idx = F.tid; idx < 64 * 16; idx += 512) { const int pos = idx >> 4, j = idx & 15;
        const float inv = __builtin_amdgcn_exp2f(-(float)j * 0.8304820237218406f); const float ang = (float)pos * inv;
        const float kq = rintf(ang * 0.15915494309189535f); float r = fmaf(-kq, 6.28318548202514648f, ang); r = fmaf(-kq, -1.7484556000744883e-7f, r);
        ropep[pos * 32 + j] = cosf(r); ropep[pos * 32 + 16 + j] = sinf(r); } }
}

DI int moe_table(Frame& F, int layer, bool reuse = false) {
    LAS int* bs = (LAS int*)(F.lds + MOE_TAB_OFF); LAS int* cnt = bs + 32;
#if MK_N_LAUNCHES == 1 && !defined(PH_SEL_SINGLE)
    if (reuse) { __syncthreads(); return __builtin_amdgcn_readfirstlane(bs[NCLS]); }
#endif
    __syncthreads();
    if (F.tid < NCLS) cnt[F.tid] = (int)__hip_atomic_load((unsigned*)KWS + CW_MOE + 32 * layer + F.tid, __ATOMIC_RELAXED, __HIP_MEMORY_SCOPE_AGENT);
    __syncthreads();
    if (F.tid == 0) { int a = 0; for (int k = 0; k < NCLS; ++k) { bs[k] = a; a += (cnt[k] + 255) >> 8; } bs[NCLS] = a; }
    __syncthreads();
    return __builtin_amdgcn_readfirstlane(bs[NCLS]);
}
DI void unpack16(const u32x4& a, const u32x4& b, float (&v)[16]) {
    v[0] = bf_lo(a.x); v[1] = bf_hi(a.x); v[2] = bf_lo(a.y); v[3] = bf_hi(a.y); v[4] = bf_lo(a.z); v[5] = bf_hi(a.z); v[6] = bf_lo(a.w); v[7] = bf_hi(a.w);
    v[8] = bf_lo(b.x); v[9] = bf_hi(b.x); v[10] = bf_lo(b.y); v[11] = bf_hi(b.y); v[12] = bf_lo(b.z); v[13] = bf_hi(b.z); v[14] = bf_lo(b.w); v[15] = bf_hi(b.w);
}
DI void unpack16_f8(unsigned a0, unsigned a1, unsigned b0, unsigned b1, float (&v)[16]) {
    f32x2 t;
    t = __builtin_amdgcn_cvt_pk_f32_fp8((int)a0, false); v[0] = t.x; v[1] = t.y; t = __builtin_amdgcn_cvt_pk_f32_fp8((int)a0, true); v[2] = t.x; v[3] = t.y;
    t = __builtin_amdgcn_cvt_pk_f32_fp8((int)a1, false); v[4] = t.x; v[5] = t.y; t = __builtin_amdgcn_cvt_pk_f32_fp8((int)a1, true); v[6] = t.x; v[7] = t.y;
    t = __builtin_amdgcn_cvt_pk_f32_fp8((int)b0, false); v[8] = t.x; v[9] = t.y; t = __builtin_amdgcn_cvt_pk_f32_fp8((int)b0, true); v[10] = t.x; v[11] = t.y;
    t = __builtin_amdgcn_cvt_pk_f32_fp8((int)b1, false); v[12] = t.x; v[13] = t.y; t = __builtin_amdgcn_cvt_pk_f32_fp8((int)b1, true); v[14] = t.x; v[15] = t.y;
}
DI void pack16(const float (&v)[16], u32x4& a, u32x4& b) {
    a.x = cvt_pk_bf16(v[0], v[1]); a.y = cvt_pk_bf16(v[2], v[3]); a.z = cvt_pk_bf16(v[4], v[5]); a.w = cvt_pk_bf16(v[6], v[7]);
    b.x = cvt_pk_bf16(v[8], v[9]); b.y = cvt_pk_bf16(v[10], v[11]); b.z = cvt_pk_bf16(v[12], v[13]); b.w = cvt_pk_bf16(v[14], v[15]);
}
DI float quant_row_i8(const float (&v)[16], signed char* dst_row, int c0, int lane) {
    float am = 0.f;
#pragma unroll
    for (int e = 0; e < 16; ++e) am = fmaxf(am, fabsf(v[e]));
    am = wave_max(am, lane);
    const float inv = am > 0.f ? 127.0f / am : 0.f;
    unsigned w[4];
#pragma unroll
    for (int q = 0; q < 4; ++q) { unsigned p = 0u;
#pragma unroll
        for (int e = 0; e < 4; ++e) { const int qi = (int)__builtin_rintf(v[4 * q + e] * inv); p |= ((unsigned)qi & 0xffu) << (8 * e); }
        w[q] = p; }
    *(u32x2*)(dst_row + c0) = (u32x2){w[0], w[1]}; *(u32x2*)(dst_row + 512 + c0) = (u32x2){w[2], w[3]};
    return am * (1.0f / 127.0f);
}
template <bool ROUTER>
DI void norm_phase(Frame& F, int layer) {
    unsigned char* const ws = KWS;
    const float* gain = (ROUTER ? KIN(I_NFFN) : KIN(I_NMIX)) + layer * 1024;
    const float* modl = (const float*)(ws + WS_MOD) + (size_t)layer * 33 * 6144 + (ROUTER ? 3 * 1024 : 0);
    const float* gatel = ROUTER ? (const float*)(ws + WS_MOD) + (size_t)layer * 33 * 6144 + 2 * 1024 : (const float*)(ws + WS_MOD) + (size_t)(layer > 0 ? layer - 1 : 0) * 33 * 6144 + 5 * 1024;
    const int ymode = ROUTER ? 1 : (layer > 0 ? 2 : 0);
    const bool src32 = !ROUTER && layer == 0;
    bf16_t* XRp = (bf16_t*)(ws + WS_XR); bf16_t* Hp = (bf16_t*)(ws + WS_H);
    const unsigned char* Yp = ROUTER ? (const unsigned char*)(ws + WS_H) : (const unsigned char*)(ws + WS_R3);
    const int* tokpos = (const int*)(ws + WS_TOKPOS);
    const float* xin = nullptr; const float* cxin = nullptr;
    if (!ROUTER) { xin = KIN(I_X); cxin = KIN(I_CTX); if (ymode == 2) (void)moe_table(F, layer - 1, true); }
    const LAS int* bs = (const LAS int*)(F.lds + MOE_TAB_OFF);
    const int NROWS = (ROUTER && layer == DEPTH - 1) ? NL : MT;
    const int RPB = (NROWS + F.G - 1) / F.G, RPW = (RPB + 7) / 8;
    const int brow0 = blockIdx.x * RPB; int bend = brow0 + RPB; if (bend > NROWS) bend = NROWS;
    const int row0 = brow0 + F.wave * RPW; int rend = row0 + RPW; if (rend > bend) rend = bend;
    LAS float* RW = (LAS float*)F.lds;
    LAS float* WL = (LAS float*)(F.lds + 67584) + F.wave * 64;
    LAS int* lcnt = (LAS int*)(F.lds + 69632); LAS int* lbase = (LAS int*)(F.lds + 69760);
    LAS int* rec = (LAS int*)(F.lds + 69888); LAS f32x2* recg = (LAS f32x2*)(F.lds + 73984);
    float rb[16];
    if (ROUTER) {
        const float* rwp = KIN(I_RW); const float* rbp = KIN(I_RB);
        for (int idx = F.tid; idx < 1024 * 16; idx += 512) { const int col = idx >> 4, e = idx & 15; RW[(col >> 3) * 132 + (col & 7) * 16 + e] = rwp[idx]; }
        if (F.tid < 32) lcnt[F.tid] = 0;
#pragma unroll
        for (int e = 0; e < 16; ++e) rb[e] = rbp[e];
        __syncthreads();
    }
    float gs[16], sh[16], gy[16]; int mb = -1;
    const int c0 = 8 * F.lane;
    constexpr int NBR = ROUTER ? 2 : 4;
    u32x4 xa[NBR], xb[NBR], ya[NBR], yb[NBR]; f32x4 xs[NBR][4];
    u32x4 nxa[NBR], nxb[NBR], nya[NBR], nyb[NBR]; f32x4 nxs[NBR][4];
#define NORM_LOAD(XA, XB, YA, YB, XS, rowb_) do { _Pragma("unroll") for (int u = 0; u < NBR; ++u) { const int rr = (rowb_) + u < rend ? (rowb_) + u : rend - 1; \
            if (!ROUTER && src32) { const float* src = rr < NL ? xin + (size_t)rr * 1024 : cxin + (size_t)(rr - NL) * 1024; \
                XS[u][0] = *(const f32x4*)(src + c0); XS[u][1] = *(const f32x4*)(src + c0 + 4); XS[u][2] = *(const f32x4*)(src + 512 + c0); XS[u][3] = *(const f32x4*)(src + 512 + c0 + 4); } \
            else { const bf16_t* xr = XRp + (size_t)rr * 1024; XA[u] = *(const u32x4*)(xr + c0); XB[u] = *(const u32x4*)(xr + 512 + c0); } \
            if (ymode) { size_t yrow = (size_t)rr; if (!ROUTER) { const int tp = tpc[u]; yrow = (size_t)bs[tp & 0xff] * 256 + (size_t)(tp >> 8); } \
                const unsigned char* yr = Yp + yrow * 1024; const u32x2 ta_ = *(const u32x2*)(yr + c0), tb_ = *(const u32x2*)(yr + 512 + c0); YA[u].x = ta_.x; YA[u].y = ta_.y; YB[u].x = tb_.x; YB[u].y = tb_.y; } } } while (0)
    constexpr bool PF = ROUTER;
    int tpc[NBR];
#pragma unroll
    for (int u = 0; u < NBR; ++u) { tpc[u] = 0; if (!ROUTER && ymode == 2 && row0 < rend) { const int rr = row0 + u < rend ? row0 + u : rend - 1; tpc[u] = tokpos[rr]; } }
    if (PF) { if (row0 < rend) NORM_LOAD(xa, xb, ya, yb, xs, row0); }
    for (int rowb = row0; rowb < rend; rowb += NBR) {
        if (PF) { if (rowb + NBR < rend) NORM_LOAD(nxa, nxb, nya, nyb, nxs, rowb + NBR); } else NORM_LOAD(xa, xb, ya, yb, xs, rowb);
        if (!ROUTER && ymode == 2 && rowb + NBR < rend) {
#pragma unroll
            for (int u = 0; u < NBR; ++u) { const int rr = rowb + NBR + u < rend ? rowb + NBR + u : rend - 1; tpc[u] = tokpos[rr]; } }
#pragma unroll
        for (int up = 0; up < NBR; up += 2) {
        float vv[2][16];
#pragma unroll
        for (int u2 = 0; u2 < 2; ++u2) { const int u = up + u2; const int row = rowb + u; float (&v)[16] = vv[u2];
        if (row < rend) {
        const int mbn = row < NL ? (row >> 11) : 32;
        if (mbn != mb) { mb = mbn; const float* mp = modl + (size_t)mb * 6144; const float* gp = gatel + (size_t)mb * 6144;
#pragma unroll
            for (int hh = 0; hh < 2; ++hh)
#pragma unroll
                for (int q = 0; q < 2; ++q) { const int cc = hh * 512 + c0 + 4 * q; const f32x4 g4 = *(const f32x4*)(gain + cc), s4 = *(const f32x4*)(mp + 1024 + cc), h4 = *(const f32x4*)(mp + cc), y4 = *(const f32x4*)(gp + cc);
#pragma unroll
                    for (int e = 0; e < 4; ++e) { gs[hh * 8 + q * 4 + e] = g4[e] * (1.0f + s4[e]); sh[hh * 8 + q * 4 + e] = h4[e]; gy[hh * 8 + q * 4 + e] = y4[e] * (1.0f / Y_SCALE); } } }
        if (!ROUTER && src32) {
#pragma unroll
            for (int q = 0; q < 4; ++q)
#pragma unroll
                for (int e = 0; e < 4; ++e) v[4 * q + e] = xs[u][q][e]; }
        else unpack16(xa[u], xb[u], v);
        if (ymode) { float yv[16]; unpack16_f8(ya[u].x, ya[u].y, yb[u].x, yb[u].y, yv);
#pragma unroll
            for (int e = 0; e < 16; ++e) v[e] += gy[e] * yv[e]; }
        if (ymode || src32) { u32x4 wa, wb; pack16(v, wa, wb); bf16_t* xw = XRp + (size_t)row * 1024; *(u32x4*)(xw + c0) = wa; *(u32x4*)(xw + 512 + c0) = wb; }
        float ss = 0.f;
#pragma unroll
        for (int e = 0; e < 16; ++e) ss += v[e] * v[e];
        ss = wave_sum(ss, F.lane);
        const float rstd = 1.0f / sqrtf(ss * (1.0f / 1024.0f) + RMS_EPS);
#pragma unroll
        for (int e = 0; e < 16; ++e) v[e] = v[e] * rstd * gs[e] + sh[e];
        if (ROUTER) { u32x4 oa, ob; pack16(v, oa, ob); bf16_t* hr = Hp + (size_t)row * 1024; *(u32x4*)(hr + c0) = oa; *(u32x4*)(hr + 512 + c0) = ob; }
        else { const float sc_ = quant_row_i8(v, (signed char*)Hp + (size_t)row * 1024, c0, F.lane); if (F.lane == 0) ((float*)(ws + WS_SA))[row] = sc_; }
        } else {
#pragma unroll
            for (int e = 0; e < 16; ++e) v[e] = 0.f; }
        }
        if (ROUTER) {
            float pl[2][16];
#pragma unroll
            for (int u = 0; u < 2; ++u)
#pragma unroll
                for (int e = 0; e < 16; ++e) pl[u][e] = 0.f;
#pragma unroll
            for (int jj = 0; jj < 16; ++jj) { const LAS f32x4* wp = (const LAS f32x4*)(RW + ((jj >> 3) * 64 + F.lane) * 132 + (jj & 7) * 16);
#pragma unroll
                for (int q = 0; q < 4; ++q) { const f32x4 w4 = wp[q];
#pragma unroll
                    for (int u = 0; u < 2; ++u) { const float x = vv[u][jj]; pl[u][4 * q] += x * w4[0]; pl[u][4 * q + 1] += x * w4[1]; pl[u][4 * q + 2] += x * w4[2]; pl[u][4 * q + 3] += x * w4[3]; } } }
#pragma unroll
            for (int u = 0; u < 2; ++u) {
                float v8[8], v4[4], v2[2], v1;
                { const bool bt = (F.lane >> 5) & 1;
#pragma unroll
                  for (int i = 0; i < 8; ++i) { const float mine = bt ? pl[u][8 + i] : pl[u][i], theirs = bt ? pl[u][i] : pl[u][8 + i]; v8[i] = mine + shx(theirs, 32, F.lane); } }
                { const bool bt = (F.lane >> 4) & 1;
#pragma unroll
                  for (int i = 0; i < 4; ++i) { const float mine = bt ? v8[4 + i] : v8[i], theirs = bt ? v8[i] : v8[4 + i]; v4[i] = mine + shx(theirs, 16, F.lane); } }
                { const bool bt = (F.lane >> 3) & 1;
#pragma unroll
                  for (int i = 0; i < 2; ++i) { const float mine = bt ? v4[2 + i] : v4[i], theirs = bt ? v4[i] : v4[2 + i]; v2[i] = mine + shx(theirs, 8, F.lane); } }
                { const bool bt = (F.lane >> 2) & 1; const float mine = bt ? v2[1] : v2[0], theirs = bt ? v2[0] : v2[1]; v1 = mine + shx(theirs, 4, F.lane); }
                v1 += shx(v1, 2, F.lane); v1 += shx(v1, 1, F.lane);
                { const int ei = ((F.lane >> 5) & 1) * 8 + ((F.lane >> 4) & 1) * 4 + ((F.lane >> 3) & 1) * 2 + ((F.lane >> 2) & 1); WL[(F.lane & 3) == 0 ? u * 16 + ei : 32 + (F.lane >> 1)] = v1; }
            }
            asm volatile("s_waitcnt lgkmcnt(0)" ::: "memory");
            const int ur = F.lane & 1;
            float sc[16], sel[16];
#pragma unroll
            for (int q = 0; q < 4; ++q) { const f32x4 l4 = ((const LAS f32x4*)(WL + ur * 16))[q];
#pragma unroll
                for (int e = 0; e < 4; ++e) { sc[4 * q + e] = sigmoidf_(l4[e]); sel[4 * q + e] = sc[4 * q + e] + rb[4 * q + e]; } }
            asm volatile("s_waitcnt lgkmcnt(0)" ::: "memory");
            int grp = 0; float best = -1e30f;
#pragma unroll
            for (int g = 0; g < 4; ++g) { const float a = sel[4 * g], b = sel[4 * g + 1], c = sel[4 * g + 2], d = sel[4 * g + 3];
                const float m1 = fmaxf(fmaxf(a, b), fmaxf(c, d)); const float lo1 = fminf(a, b), hi1 = fmaxf(a, b), lo2 = fminf(c, d), hi2 = fmaxf(c, d);
                const float m2 = fmaxf(fminf(hi1, hi2), fmaxf(lo1, lo2)); const float gsum = m1 + m2;
                if (gsum > best) { best = gsum; grp = g; } }
            float s4[4], c4[4];
#pragma unroll
            for (int e = 0; e < 4; ++e) { s4[e] = grp == 0 ? sel[e] : (grp == 1 ? sel[4 + e] : (grp == 2 ? sel[8 + e] : sel[12 + e])); c4[e] = grp == 0 ? sc[e] : (grp == 1 ? sc[4 + e] : (grp == 2 ? sc[8 + e] : sc[12 + e])); }
            int i1 = 0; float b1 = s4[0];
#pragma unroll
            for (int e = 1; e < 4; ++e) if (s4[e] > b1) { b1 = s4[e]; i1 = e; }
            int i2 = -1; float b2 = -1e30f;
#pragma unroll
            for (int e = 0; e < 4; ++e) if (e != i1 && s4[e] > b2) { b2 = s4[e]; i2 = e; }
            const float g1 = i1 == 0 ? c4[0] : (i1 == 1 ? c4[1] : (i1 == 2 ? c4[2] : c4[3])), g2 = i2 == 0 ? c4[0] : (i2 == 1 ? c4[1] : (i2 == 2 ? c4[2] : c4[3]));
            const float inv = 1.0f / (g1 + g2);
            const int lo = i1 < i2 ? i1 : i2, hi = i1 < i2 ? i2 : i1;
            const int pidx = lo == 0 ? hi - 1 : (lo == 1 ? hi + 1 : 5);
            const int cls = grp * 6 + pidx;
            const float glo = (i1 < i2 ? g1 : g2) * inv, ghi = (i1 < i2 ? g2 : g1) * inv;
            if (F.lane < 2 && rowb + up + F.lane < rend) { const int sl_ = __hip_atomic_fetch_add(lcnt + cls, 1, __ATOMIC_RELAXED, __HIP_MEMORY_SCOPE_WORKGROUP); const int rbi = rowb + up + F.lane - brow0; rec[rbi] = cls | (sl_ << 8); recg[rbi] = (f32x2){glo, ghi}; }
        }
        }
        if (PF) {
#pragma unroll
            for (int u = 0; u < NBR; ++u) { xa[u] = nxa[u]; xb[u] = nxb[u]; ya[u] = nya[u]; yb[u] = nyb[u]; } }
    }
#undef NORM_LOAD
    if (ROUTER) {
        __syncthreads();
        if (F.tid < NCLS) { const int n = lcnt[F.tid]; int base = 0; if (n > 0) base = (int)__hip_atomic_fetch_add((unsigned*)ws + CW_MOE + 32 * layer + F.tid, (unsigned)n, __ATOMIC_RELAXED, __HIP_MEMORY_SCOPE_AGENT); lbase[F.tid] = base; }
        __syncthreads();
        int* listp = (int*)(ws + WS_LIST); f32x2* glistp = (f32x2*)(ws + WS_GLIST); int* tpw = (int*)(ws + WS_TOKPOS);
        for (int rbi = F.tid; rbi < bend - brow0; rbi += 512) { const int rc = rec[rbi]; const int cls = rc & 0xff; const int slot = lbase[cls] + (rc >> 8);
            listp[(size_t)cls * MT + slot] = brow0 + rbi; glistp[(size_t)cls * MT + slot] = recg[rbi]; tpw[brow0 + rbi] = cls | (slot << 8); }
        __syncthreads();
    }
}

DI void route_decide(const float (&lg)[16], const float (&rb)[16], int& cls, float& glo, float& ghi) {
    float sc[16], sel[16];
#pragma unroll
    for (int e = 0; e < 16; ++e) { sc[e] = sigmoidf_(lg[e]); sel[e] = sc[e] + rb[e]; }
    int grp = 0; float best = -1e30f;
#pragma unroll
    for (int g = 0; g < 4; ++g) { const float a = sel[4 * g], b = sel[4 * g + 1], c = sel[4 * g + 2], d = sel[4 * g + 3];
        const float m1 = fmaxf(fmaxf(a, b), fmaxf(c, d)); const float lo1 = fminf(a, b), hi1 = fmaxf(a, b), lo2 = fminf(c, d), hi2 = fmaxf(c, d);
        const float m2 = fmaxf(fminf(hi1, hi2), fmaxf(lo1, lo2)); const float gsum = m1 + m2;
        if (gsum > best) { best = gsum; grp = g; } }
    float s4[4], c4[4];
#pragma unroll
    for (int e = 0; e < 4; ++e) { s4[e] = grp == 0 ? sel[e] : (grp == 1 ? sel[4 + e] : (grp == 2 ? sel[8 + e] : sel[12 + e])); c4[e] = grp == 0 ? sc[e] : (grp == 1 ? sc[4 + e] : (grp == 2 ? sc[8 + e] : sc[12 + e])); }
    int i1 = 0; float b1 = s4[0];
#pragma unroll
    for (int e = 1; e < 4; ++e) if (s4[e] > b1) { b1 = s4[e]; i1 = e; }
    int i2 = -1; float b2 = -1e30f;
#pragma unroll
    for (int e = 0; e < 4; ++e) if (e != i1 && s4[e] > b2) { b2 = s4[e]; i2 = e; }
    const float g1 = i1 == 0 ? c4[0] : (i1 == 1 ? c4[1] : (i1 == 2 ? c4[2] : c4[3])), g2 = i2 == 0 ? c4[0] : (i2 == 1 ? c4[1] : (i2 == 2 ? c4[2] : c4[3]));
    const float inv = 1.0f / (g1 + g2);
    const int lo = i1 < i2 ? i1 : i2, hi = i1 < i2 ? i2 : i1;
    const int pidx = lo == 0 ? hi - 1 : (lo == 1 ? hi + 1 : 5);
    cls = grp * 6 + pidx;
    glo = (i1 < i2 ? g1 : g2) * inv; ghi = (i1 < i2 ? g2 : g1) * inv;
}

DI void n2_phase(Frame& F, int layer) {
    unsigned char* const ws = KWS;
    const float* gain = KIN(I_NFFN) + layer * 1024;
    const float* modl = (const float*)(ws + WS_MOD) + (size_t)layer * 33 * 6144 + 3 * 1024;
    const float* gatel = (const float*)(ws + WS_MOD) + (size_t)layer * 33 * 6144 + 2 * 1024;
    bf16_t* XRp = (bf16_t*)(ws + WS_XR); const unsigned char* Hp = ws + WS_H;
    const int NROWS = (layer == DEPTH - 1) ? NL : MT;
    const int RPB = (NROWS + F.G - 1) / F.G;
    const int brow0 = blockIdx.x * RPB; int bend = brow0 + RPB; if (bend > NROWS) bend = NROWS;
    const int nsteps = (bend - brow0 + 31) >> 5;
    constexpr int AST = 2064;
    LAS unsigned char* AH = F.lds; LAS unsigned char* AL = F.lds + 32 * AST;
    LAS float* PART = (LAS float*)(F.lds + 64 * AST);
    LAS float* RB = (LAS float*)(F.lds + 64 * AST + 16384);
    LAS int* lcnt = (LAS int*)(F.lds + 64 * AST + 16384 + 128); LAS int* lbase = lcnt + 32;
    LAS int* rec = lbase + 32; LAS f32x2* recg = (LAS f32x2*)(rec + 512); LAS float* rsa = (LAS float*)(recg + 512);
    static_assert(64 * AST + 16384 + 128 + 256 + 2048 + 4096 + 2048 <= PHASE_LDS, "N2 LDS map");
    const int c0 = 8 * F.lane;
    u32x4 xa[4], xb[4], nxa[4], nxb[4]; u32x2 ya[4], yb[4], nya[4], nyb[4];
#define N2_LOAD(XA, XB, YA, YB, st_) do { _Pragma("unroll") for (int u = 0; u < 4; ++u) { int rr = brow0 + 32 * (st_) + 4 * F.wave + u; rr = rr < bend ? rr : bend - 1; \
            const bf16_t* xr = XRp + (size_t)rr * 1024; XA[u] = *(const u32x4*)(xr + c0); XB[u] = *(const u32x4*)(xr + 512 + c0); \
            const unsigned char* yr = Hp + (size_t)rr * 1024; YA[u] = *(const u32x2*)(yr + c0); YB[u] = *(const u32x2*)(yr + 512 + c0); } } while (0)
    if (nsteps > 0) N2_LOAD(xa, xb, ya, yb, 0);
    const int i16 = F.lane & 15, qd = F.lane >> 4;
    bf16x8 wfh[4], wfl[4];
    { const float* rwp = KIN(I_RW); const float* rbp = KIN(I_RB);
#pragma unroll
      for (int kk = 0; kk < 4; ++kk) { u32x4 hq, lq;
#pragma unroll
          for (int q = 0; q < 4; ++q) { const int k = 32 * (4 * F.wave + kk) + 8 * qd + 2 * q; const float w0 = rwp[k * 16 + i16], w1 = rwp[(k + 1) * 16 + i16];
              const unsigned hh = cvt_pk_bf16(w0, w1); hq[q] = hh; lq[q] = cvt_pk_bf16(w0 - bf_lo(hh), w1 - bf_hi(hh)); }
          wfh[kk] = __builtin_bit_cast(bf16x8, hq); wfl[kk] = __builtin_bit_cast(bf16x8, lq); }
      if (F.tid < 16) RB[F.tid] = rbp[F.tid];
      if (F.tid < 32) lcnt[F.tid] = 0; }
    __syncthreads();
    float gs[16], sh[16], gy[16]; int mb = -1;
    for (int st = 0; st < nsteps; ++st) {
#pragma unroll
        for (int u = 0; u < 4; ++u) { const int t = 4 * F.wave + u; const int row = brow0 + 32 * st + t;
            u32x4 oa = (u32x4){0u, 0u, 0u, 0u}, ob = oa, la = oa, lb = oa;
            if (row < bend) {
                const int mbn = row < NL ? (row >> 11) : 32;
                if (mbn != mb) { mb = mbn; const float* mp = modl + (size_t)mb * 6144; const float* gp = gatel + (size_t)mb * 6144;
#pragma unroll
                    for (int hh = 0; hh < 2; ++hh)
#pragma unroll
                        for (int q = 0; q < 2; ++q) { const int cc = hh * 512 + c0 + 4 * q; const f32x4 g4 = *(const f32x4*)(gain + cc), s4 = *(const f32x4*)(mp + 1024 + cc), h4 = *(const f32x4*)(mp + cc), y4 = *(const f32x4*)(gp + cc);
#pragma unroll
                            for (int e = 0; e < 4; ++e) { gs[hh * 8 + q * 4 + e] = g4[e] * (1.0f + s4[e]); sh[hh * 8 + q * 4 + e] = h4[e]; gy[hh * 8 + q * 4 + e] = y4[e] * (1.0f / Y_SCALE); } } }
                float v[16], yv[16]; unpack16(xa[u], xb[u], v); unpack16_f8(ya[u].x, ya[u].y, yb[u].x, yb[u].y, yv);
#pragma unroll
                for (int e = 0; e < 16; ++e) v[e] += gy[e] * yv[e];
                { u32x4 wa, wb; pack16(v, wa, wb); bf16_t* xw = XRp + (size_t)row * 1024; *(u32x4*)(xw + c0) = wa; *(u32x4*)(xw + 512 + c0) = wb; }
                float ss = 0.f;
#pragma unroll
                for (int e = 0; e < 16; ++e) ss += v[e] * v[e];
                ss = wave_sum(ss, F.lane);
                const float rstd = 1.0f / sqrtf(ss * (1.0f / 1024.0f) + RMS_EPS);
#pragma unroll
                for (int e = 0; e < 16; ++e) v[e] = v[e] * rstd * gs[e] + sh[e];
                pack16(v, oa, ob);
                { const float sc_ = quant_row_i8(v, (signed char*)(ws + WS_R3) + (size_t)row * 1024, c0, F.lane); if (F.lane == 0) rsa[row - brow0] = sc_; }
                float lo[16]; { float hv[16]; unpack16(oa, ob, hv);
#pragma unroll
                    for (int e = 0; e < 16; ++e) lo[e] = v[e] - hv[e]; }
                pack16(lo, la, lb);
            }
            *(LAS u32x4*)(AH + t * AST + 2 * c0) = oa; *(LAS u32x4*)(AH + t * AST + 1024 + 2 * c0) = ob;
            *(LAS u32x4*)(AL + t * AST + 2 * c0) = la; *(LAS u32x4*)(AL + t * AST + 1024 + 2 * c0) = lb; }
        if (st + 1 < nsteps) N2_LOAD(nxa, nxb, nya, nyb, st + 1);
        __syncthreads();
#pragma unroll
        for (int rt = 0; rt < 2; ++rt) { f32x4 acc = (f32x4){0.f, 0.f, 0.f, 0.f};
#pragma unroll
          for (int kk = 0; kk < 4; ++kk) { const int ko = (32 * (4 * F.wave + kk) + 8 * qd) * 2;
              const bf16x8 fh = *(const LAS bf16x8*)(AH + (16 * rt + i16) * AST + ko), fl = *(const LAS bf16x8*)(AL + (16 * rt + i16) * AST + ko);
              acc = MFMA16(wfh[kk], fh, acc); acc = MFMA16(wfh[kk], fl, acc); acc = MFMA16(wfl[kk], fh, acc); }
          *(LAS f32x4*)(PART + ((F.wave * 32 + 16 * rt + i16) * 16) + 4 * qd) = acc; }
        __syncthreads();
        if (F.wave == (st & 7)) { const int l32 = F.lane & 31;
            float lg[16], rb[16];
#pragma unroll
            for (int e = 0; e < 16; ++e) lg[e] = 0.f;
#pragma unroll
            for (int w = 0; w < 8; ++w)
#pragma unroll
                for (int q = 0; q < 4; ++q) { const f32x4 p4 = *(const LAS f32x4*)(PART + ((w * 32 + l32) * 16) + 4 * q); lg[4 * q] += p4[0]; lg[4 * q + 1] += p4[1]; lg[4 * q + 2] += p4[2]; lg[4 * q + 3] += p4[3]; }
#pragma unroll
            for (int q = 0; q < 4; ++q) { const f32x4 r4 = ((const LAS f32x4*)RB)[q]; rb[4 * q] = r4[0]; rb[4 * q + 1] = r4[1]; rb[4 * q + 2] = r4[2]; rb[4 * q + 3] = r4[3]; }
            int cls; float glo, ghi; route_decide(lg, rb, cls, glo, ghi);
            const int rbi = 32 * st + F.lane;
            if (F.lane < 32 && brow0 + rbi < bend) { const int sl_ = __hip_atomic_fetch_add(lcnt + cls, 1, __ATOMIC_RELAXED, __HIP_MEMORY_SCOPE_WORKGROUP); rec[rbi] = cls | (sl_ << 8); recg[rbi] = (f32x2){glo, ghi}; }
        }
#pragma unroll
        for (int u = 0; u < 4; ++u) { xa[u] = nxa[u]; xb[u] = nxb[u]; ya[u] = nya[u]; yb[u] = nyb[u]; }
    }
#undef N2_LOAD
    __syncthreads();
    if (F.tid < NCLS) { const int n = lcnt[F.tid]; int base = 0; if (n > 0) base = (int)__hip_atomic_fetch_add((unsigned*)ws + CW_MOE + 32 * layer + F.tid, (unsigned)n, __ATOMIC_RELAXED, __HIP_MEMORY_SCOPE_AGENT); lbase[F.tid] = base; }
    __syncthreads();
    int* listp = (int*)(ws + WS_LIST); f32x2* glistp = (f32x2*)(ws + WS_GLIST); int* tpw = (int*)(ws + WS_TOKPOS); float* slistp = (float*)(ws + WS_SLIST);
    for (int rbi = F.tid; rbi < bend - brow0; rbi += 512) { const int rc = rec[rbi]; const int cls = rc & 0xff; const int slot = lbase[cls] + (rc >> 8);
        listp[(size_t)cls * MT + slot] = brow0 + rbi; glistp[(size_t)cls * MT + slot] = recg[rbi]; slistp[(size_t)cls * MT + slot] = rsa[rbi]; tpw[brow0 + rbi] = cls | (slot << 8); }
    __syncthreads();
}

DI void attn_phase(Frame& F, int j, unsigned long long& pacc) {
    unsigned char* const ws = KWS; const bf16_t* P = (const bf16_t*)(ws + WS_R2); unsigned char* O = ws + WS_R3; const float* sinks = KIN(I_SINKS);
    const int lane = F.lane, wave = F.wave, tid = F.tid, r32 = lane & 31, hi = lane >> 5;
    const int g = wave & 3, qh = wave >> 2;
    LAS unsigned char* KB = F.lds; LAS unsigned char* VB = F.lds + 2 * 18432;
    const int i16 = lane & 15, tq = i16 >> 2, tp = i16 & 3, blk = (lane >> 4) & 1;
    const int nunits = 2048 + 256;
#if PROBE_ATT
    unsigned long long atp_ = __builtin_amdgcn_s_memrealtime();
#define ATTT(k) do { const unsigned long long tn_ = __builtin_amdgcn_s_memrealtime(); if (PROBE_ATT == (k)) pacc += tn_ - atp_; atp_ = tn_; } while (0)
#else
#define ATTT(k) do { } while (0)
#endif
    struct AU { int b, kvh, s, qrow0, klo, nwin; };
#define ATT_DECODE(U, u_) do { const int uu_ = (u_); if (uu_ < 2048) { U.b = uu_ >> 6; U.kvh = (uu_ >> 4) & 3; U.s = (uu_ & 15) * 128; U.qrow0 = U.b * SEQ + U.s; U.klo = U.s - 128 < 0 ? 0 : U.s - 128; \
            const int khi_ = U.s + 256 > SEQ ? SEQ : U.s + 256; U.nwin = (khi_ - U.klo) >> 7; } \
        else { const int v_ = uu_ - 2048; U.b = v_ >> 3; U.kvh = (v_ >> 1) & 3; U.s = (v_ & 1) * 128; U.qrow0 = NL + U.b * CTX + U.s; U.klo = 0; U.nwin = 0; } } while (0)
#define ATT_CHROW(U, ch) ((ch) < U.nwin ? (U.b * SEQ + U.klo + 128 * (ch)) : (NL + U.b * CTX + 128 * ((ch) - U.nwin)))
#define ATT_LOAD(U, ch) do { const int cr_ = ATT_CHROW(U, ch); _Pragma("unroll") for (int i_ = 0; i_ < 2; ++i_) { const int p_ = tid + 512 * i_; const bf16_t* src_ = P + (size_t)(cr_ + (p_ >> 3)) * NQKV + 1024 + U.kvh * 64 + (p_ & 7) * 8; \
            kst[i_] = *(const u32x4*)src_; vst[i_] = *(const u32x4*)(src_ + 256); } } while (0)
#define ATT_STORE(bufi) do { _Pragma("unroll") for (int i_ = 0; i_ < 2; ++i_) { const int p_ = tid + 512 * i_; const int off_ = (bufi) * 18432 + (p_ >> 3) * 144 + (p_ & 7) * 16; \
            *(LAS u32x4*)(KB + off_) = kst[i_]; *(LAS u32x4*)(VB + off_) = vst[i_]; } } while (0)
#define ATT_LOADQ(U) do { _Pragma("unroll") for (int gr = 0; gr < 2; ++gr) { const bf16_t* qp = P + (size_t)(U.qrow0 + 64 * gr + 32 * qh + r32) * NQKV + (U.kvh * 4 + g) * 64 + 8 * hi; \
            _Pragma("unroll") for (int ks = 0; ks < 4; ++ks) qf[gr][ks] = *(const bf16x8*)(qp + 16 * ks); } } while (0)
    float sk4[4];
#pragma unroll
    for (int kk = 0; kk < 4; ++kk) sk4[kk] = sinks[j * 16 + kk * 4 + g] * LOG2E;
    u32x4 kst[2], vst[2]; bf16x8 qf[2][4];
    AU UC, UN;
    if ((int)blockIdx.x < nunits) { ATT_DECODE(UC, (int)blockIdx.x); ATT_LOAD(UC, 0); ATT_LOADQ(UC); }
    for (int u = blockIdx.x; u < nunits; u += F.G) {
        const bool has_next = u + F.G < nunits;
        if (has_next) ATT_DECODE(UN, u + F.G); else UN = UC;
        const int s = UC.s, qrow0 = UC.qrow0, klo = UC.klo, nwin = UC.nwin, nch = UC.nwin + 2, hq = UC.kvh * 4 + g;
        const float sink2 = UC.kvh == 0 ? sk4[0] : (UC.kvh == 1 ? sk4[1] : (UC.kvh == 2 ? sk4[2] : sk4[3]));
        float mrun[2], lrun[2]; f32x16 o[2][2];
#pragma unroll
        for (int gr = 0; gr < 2; ++gr) { mrun[gr] = sink2; lrun[gr] = hi == 0 ? 1.0f : 0.0f;
#pragma unroll
            for (int d0 = 0; d0 < 2; ++d0)
#pragma unroll
                for (int i = 0; i < 16; ++i) o[gr][d0][i] = 0.f; }
        __syncthreads();
        ATT_STORE(0);
        __syncthreads();
        ATTT(3);
        for (int ch = 0; ch < nch; ++ch) {
            const int buf = ch & 1;
            if (ch + 1 < nch) ATT_LOAD(UC, ch + 1); else if (has_next) ATT_LOAD(UN, 0);
            ATTT(2);
            const bool masked = ch < nwin; const int kpos0 = klo + 128 * ch;
            const LAS unsigned char* kb = KB + buf * 18432; const LAS unsigned char* vb = VB + buf * 18432;
#pragma unroll 1
            for (int kt = 0; kt < 4; ++kt) {
                int tmode[2] = {0, 0};
                if (masked) {
#pragma unroll
                    for (int gr = 0; gr < 2; ++gr) { const int q0 = s + 64 * gr + 32 * qh; const int dmin = q0 - (kpos0 + 32 * kt + 31), dmax = (q0 + 31) - (kpos0 + 32 * kt);
                        tmode[gr] = (dmax < -128 || dmin > 128) ? 2 : ((dmin >= -128 && dmax <= 128) ? 0 : 1); } }
                if (tmode[0] == 2 && tmode[1] == 2) continue;
                bf16x8 kf[4];
#pragma unroll
                for (int ks = 0; ks < 4; ++ks) kf[ks] = *(const LAS bf16x8*)(kb + (32 * kt + r32) * 144 + (16 * ks + 8 * hi) * 2);
                bf16x8 vf[2][2];
#pragma unroll
                for (int d0 = 0; d0 < 2; ++d0)
#pragma unroll
                    for (int s2 = 0; s2 < 2; ++s2) { const LAS unsigned char* vp = vb + (32 * kt + 16 * s2 + 4 * hi + tq) * 144 + (32 * d0 + 16 * blk + 4 * tp) * 2;
                        vf[d0][s2] = cat4(tr_read(vp), tr_read(vp + 8 * 144)); }
#pragma unroll
                for (int gr = 0; gr < 2; ++gr) { if (tmode[gr] == 2) continue;
                    const float nm = -mrun[gr]; const f32x2 nm2 = (f32x2){nm, nm};
                    f32x16 st = __builtin_shufflevector(nm2, nm2, 0, 1, 0, 1, 0, 1, 0, 1, 0, 1, 0, 1, 0, 1, 0, 1);
#pragma unroll
                    for (int ks = 0; ks < 4; ++ks) st = MFMA32(kf[ks], qf[gr][ks], st);
                    if (tmode[gr] == 1) { const int qpos = s + 64 * gr + 32 * qh + r32; const int kb0 = kpos0 + 32 * kt + 4 * hi;
#pragma unroll
                        for (int i = 0; i < 16; ++i) { const int dlt = qpos - (kb0 + (i & 3) + 8 * (i >> 2)); if (dlt > 128 || dlt < -128) st[i] = -1e30f; } }
                    float tmax = fmaxf(st[0], st[1]);
#pragma unroll
                    for (int i = 2; i < 16; i += 2) tmax = fmaxf(fmaxf(tmax, st[i]), st[i + 1]);
                    { auto rr = __builtin_amdgcn_permlane32_swap(__float_as_uint(tmax), __float_as_uint(tmax), false, false); tmax = fmaxf(__uint_as_float(rr[0]), __uint_as_float(rr[1])); }
                    if (__any(tmax > 8.0f)) { const float dl = fmaxf(tmax, 0.f); mrun[gr] += dl; const float alpha = __builtin_amdgcn_exp2f(-dl); lrun[gr] *= alpha;
#pragma unroll
                        for (int i = 0; i < 16; ++i) st[i] -= dl;
#pragma unroll
                        for (int d0 = 0; d0 < 2; ++d0)
#pragma unroll
                            for (int i = 0; i < 16; ++i) o[gr][d0][i] *= alpha; }
#pragma unroll
                    for (int i = 0; i < 16; ++i) st[i] = __builtin_amdgcn_exp2f(st[i]);
                    f32x2 ps2 = (f32x2){st[0], st[1]};
#pragma unroll
                    for (int i = 2; i < 16; i += 2) ps2 += (f32x2){st[i], st[i + 1]};
                    lrun[gr] += ps2.x + ps2.y;
                    const bf16x8 p0 = pack8(st, 0), p1 = pack8(st, 1);
#pragma unroll
                    for (int d0 = 0; d0 < 2; ++d0) { o[gr][d0] = MFMA32(vf[d0][0], p0, o[gr][d0]); o[gr][d0] = MFMA32(vf[d0][1], p1, o[gr][d0]); }
                }
            }
            ATTT(1);
            if (ch + 1 < nch) ATT_STORE(buf ^ 1);
            __syncthreads();
            ATTT(2);
        }
        if (has_next) ATT_LOADQ(UN);
        { LAS unsigned char* OW = F.lds + wave * 9216;
#pragma unroll
        for (int gr = 0; gr < 2; ++gr) { float lt; { auto rr = __builtin_amdgcn_permlane32_swap(__float_as_uint(lrun[gr]), __float_as_uint(lrun[gr]), false, false); lt = __uint_as_float(rr[0]) + __uint_as_float(rr[1]); } const float inv = ATT_O_SCALE / lt;
#pragma unroll
            for (int d0 = 0; d0 < 2; ++d0)
#pragma unroll
                for (int i4 = 0; i4 < 4; ++i4) { int w = 0; w = __builtin_amdgcn_cvt_pk_fp8_f32(__builtin_amdgcn_fmed3f(o[gr][d0][4 * i4] * inv, -448.f, 448.f), __builtin_amdgcn_fmed3f(o[gr][d0][4 * i4 + 1] * inv, -448.f, 448.f), w, false);
                    w = __builtin_amdgcn_cvt_pk_fp8_f32(__builtin_amdgcn_fmed3f(o[gr][d0][4 * i4 + 2] * inv, -448.f, 448.f), __builtin_amdgcn_fmed3f(o[gr][d0][4 * i4 + 3] * inv, -448.f, 448.f), w, true);
                    *(LAS int*)(OW + (32 * gr + r32) * 80 + (32 * d0 + 8 * i4 + 4 * hi)) = w; } }
        asm volatile("s_waitcnt lgkmcnt(0)" ::: "memory");
#pragma unroll
        for (int it = 0; it < 4; ++it) { const int idx = lane + 64 * it; const int qr = idx >> 2, pc = idx & 3; const u32x4 w = *(const LAS u32x4*)(OW + qr * 80 + pc * 16);
            *(u32x4*)(O + (size_t)(qrow0 + 64 * (qr >> 5) + 32 * qh + (qr & 31)) * 1024 + hq * 64 + pc * 16) = w; } }
        UC = UN;
    }
    ATTT(3);
#undef ATTT
#undef ATT_DECODE
#undef ATT_LOADQ
#undef ATT_CHROW
#undef ATT_LOAD
#undef ATT_STORE
}

DI void gla_phase(Frame& F, int j, unsigned long long& pacc) {
    unsigned char* const ws = KWS; const bf16_t* QK = (const bf16_t*)(ws + WS_R2); const bf16_t* GV = (const bf16_t*)(ws + WS_R3); bf16_t* const OBp = (bf16_t*)KOUT;
    const float* wa2g = KIN(I_GWA2); const float* bag = KIN(I_GBA); const float* rbuf = (const float*)(ws + WS_R);
    const int lane = F.lane, wave = F.wave, tid = F.tid, r32 = lane & 31, hi = lane >> 5;
    const int i16 = lane & 15, tq = i16 >> 2, tp = i16 & 3, blk = (lane >> 4) & 1;
    LAS unsigned char* QD = F.lds; LAS unsigned char* KD = F.lds + 17408; LAS unsigned char* KZ = F.lds + 34816; LAS unsigned char* VT = F.lds + 52224; LAS unsigned char* PT = F.lds + 86016;
    LAS float* RR = (LAS float*)(F.lds + 95232); LAS float* SEG = (LAS float*)(F.lds + 99328); LAS float* DEC = (LAS float*)(F.lds + 103424);
    LAS float* WA2 = (LAS float*)(F.lds + 103936); LAS float* BA = (LAS float*)(F.lds + 112128);
    LAS unsigned char* OTW = F.lds + 114688 + wave * 4096;
    LAS float* XT = (LAS float*)(F.lds + 114688);
    static_assert(114688 + 8 * 4096 <= PHASE_LDS, "scan LDS map");
    const int kp = tid & 63, seg = tid >> 6;
    for (int u = blockIdx.x; u < 256; u += F.G) {
        const int b = u >> 3, hd = (u >> 1) & 3, dir = u & 1;
        bf16_t* OUT = dir ? OBp : (bf16_t*)(ws + WS_H);
        __syncthreads();
        { int t2 = tid; asm volatile("" : "+v"(t2));
          for (int idx = t2; idx < 16 * 128; idx += 512) WA2[idx] = wa2g[(((size_t)j * 2 + dir) * 16 + (idx >> 7)) * 512 + hd * 128 + (idx & 127)];
          if (t2 < 128) BA[t2] = bag[((size_t)j * 2 + dir) * 512 + hd * 128 + t2] * (-LOG2E); }
        f32x16 S[4];
#pragma unroll
        for (int kb = 0; kb < 4; ++kb)
#pragma unroll
            for (int i = 0; i < 16; ++i) S[kb][i] = 0.f;
        __syncthreads();
        bf16x8 wfh;
        { u32x4 bh;
#pragma unroll
          for (int q = 0; q < 4; ++q) bh[q] = cvt_pk_bf16(WA2[(8 * hi + 2 * q) * 128 + 32 * (wave & 3) + r32] * (-LOG2E), WA2[(8 * hi + 2 * q + 1) * 128 + 32 * (wave & 3) + r32] * (-LOG2E));
          wfh = __builtin_bit_cast(bf16x8, bh); }
        u32x4 vreg[4]; f32x4 rreg = (f32x4){0.f, 0.f, 0.f, 0.f}; unsigned q2[8], k2[8];
        const int sgn = dir ? -1 : 1;
        const unsigned vlo = (unsigned)((dir ? 63 - (tid >> 5) : (tid >> 5)) * 2048 + (tid & 31) * 16);
        const unsigned rlo = (unsigned)((dir ? 63 - (tid >> 2) : (tid >> 2)) * 128 + (tid & 3) * 16);
        const unsigned qlo = (unsigned)(4 * kp);
        const unsigned olo = (unsigned)((dir ? 63 - (lane >> 2) : (lane >> 2)) * 2048 + (lane & 3) * 16);
#define GLA_TLOW(cj_) ((cj_) < 4 ? (NL + b * CTX + (dir ? 192 - 64 * (cj_) : 64 * (cj_))) : (b * SEQ + (dir ? 1984 - 64 * ((cj_) - 4) : 64 * ((cj_) - 4))))
#define GLA_FETCH_V(cj_) do { const int tl_ = GLA_TLOW(cj_); \
            _Pragma("unroll") for (int i_ = 0; i_ < 4; ++i_) { const char* ub_ = (const char*)GV + ((size_t)(tl_ + sgn * 16 * i_)) * 2048 + hd * 512; vreg[i_] = *(const u32x4*)(ub_ + vlo); } \
            if (tid < 256) { const char* ub_ = (const char*)rbuf + (size_t)tl_ * 128 + dir * 64; rreg = *(const f32x4*)(ub_ + rlo); } } while (0)
#define GLA_FETCH_QK(cj_) do { const int tl_ = GLA_TLOW(cj_); \
            _Pragma("unroll") for (int e_ = 0; e_ < 8; ++e_) { const int ro_ = dir ? 63 - (8 * seg + e_) : 8 * seg + e_; const char* ub_ = (const char*)QK + ((size_t)(tl_ + ro_)) * 2048 + hd * 256; \
                q2[e_] = *(const unsigned*)(ub_ + qlo); k2[e_] = *(const unsigned*)(ub_ + 1024 + qlo); } } while (0)
        GLA_FETCH_V(0); GLA_FETCH_QK(0);
#if PROBE_SCAN
        unsigned long long tprev_ = __builtin_amdgcn_s_memrealtime();
#define SCANT(k) do { const unsigned long long tn_ = __builtin_amdgcn_s_memrealtime(); if (PROBE_SCAN == (k)) pacc += tn_ - tprev_; tprev_ = tn_; } while (0)
#else
#define SCANT(k) do { } while (0)
#endif
        for (int cj = 0; cj < 36; ++cj) {
            const int tlow = GLA_TLOW(cj);
            LDS_BAR();
#pragma unroll
            for (int i = 0; i < 4; ++i) { const int p = tid + 512 * i; *(LAS u32x4*)(VT + (p >> 5) * 528 + (p & 31) * 16) = vreg[i]; }
            if (tid < 256) *(LAS f32x4*)(RR + (tid >> 2) * 16 + (tid & 3) * 4) = rreg;
            LDS_BAR();
            SCANT(1);
            { const LAS float* rp = RR + (32 * (wave >> 2) + r32) * 16 + 8 * hi; const f32x4 ra = *(const LAS f32x4*)rp, rb4 = *(const LAS f32x4*)(rp + 4);
              const float rv[8] = {ra[0], ra[1], ra[2], ra[3], rb4[0], rb4[1], rb4[2], rb4[3]};
              u32x4 ah, al;
#pragma unroll
              for (int q = 0; q < 4; ++q) { const unsigned hh2 = cvt_pk_bf16(rv[2 * q], rv[2 * q + 1]); ah[q] = hh2; al[q] = cvt_pk_bf16(rv[2 * q] - bf_lo(hh2), rv[2 * q + 1] - bf_hi(hh2)); }
              f32x16 xt;
#pragma unroll
              for (int i = 0; i < 16; ++i) xt[i] = 0.f;
              xt = MFMA32(__builtin_bit_cast(bf16x8, ah), wfh, xt); xt = MFMA32(__builtin_bit_cast(bf16x8, al), wfh, xt);
              LAS float* xo = XT + (32 * (wave >> 2) + 4 * hi) * 128 + 32 * (wave & 3) + r32;
#pragma unroll
              for (int i = 0; i < 16; ++i) xo[((i & 3) + 8 * (i >> 2)) * 128] = xt[i]; }
            LDS_BAR();
            float bl[8][2];
            { const f32x2 ba2 = *(const LAS f32x2*)(BA + 2 * kp);
              float run0 = 0.f, run1 = 0.f;
#pragma unroll
              for (int e = 0; e < 8; ++e) { const f32x2 x2 = *(const LAS f32x2*)(XT + (8 * seg + e) * 128 + 2 * kp); const float t0 = fminf(x2[0] + ba2[0], 100.f), t1 = fminf(x2[1] + ba2[1], 100.f);
                  run0 = __builtin_fmaf(__builtin_amdgcn_logf(1.0f + __builtin_amdgcn_exp2f(t0)), -0.0625f, run0); run1 = __builtin_fmaf(__builtin_amdgcn_logf(1.0f + __builtin_amdgcn_exp2f(t1)), -0.0625f, run1); bl[e][0] = run0; bl[e][1] = run1; }
              *(LAS f32x2*)(SEG + seg * 128 + 2 * kp) = (f32x2){run0, run1}; }
            LDS_BAR();
            SCANT(2);
            { float off0 = 0.f, off1 = 0.f, tot0 = 0.f, tot1 = 0.f;
#pragma unroll
              for (int s2 = 0; s2 < 8; ++s2) { const f32x2 t2 = *(const LAS f32x2*)(SEG + s2 * 128 + 2 * kp); tot0 += t2[0]; tot1 += t2[1]; }
#pragma unroll 1
              for (int s2 = 0; s2 < seg; ++s2) { const f32x2 t2 = *(const LAS f32x2*)(SEG + s2 * 128 + 2 * kp); off0 += t2[0]; off1 += t2[1]; }
              const float et0 = __builtin_amdgcn_exp2f(tot0), et1 = __builtin_amdgcn_exp2f(tot1);
              if (seg == 0) *(LAS f32x2*)(DEC + 2 * kp) = (f32x2){et0, et1};
#pragma unroll
              for (int e = 0; e < 8; ++e) { const float b0 = bl[e][0] + off0, b1 = bl[e][1] + off1; const float q0 = bf_lo(q2[e]), q1 = bf_hi(q2[e]), k0 = bf_lo(k2[e]), k1 = bf_hi(k2[e]);
                  const float e0 = __builtin_amdgcn_exp2f(b0), e1 = __builtin_amdgcn_exp2f(b1), n0 = __builtin_amdgcn_exp2f(fminf(-b0, 86.f)), n1 = __builtin_amdgcn_exp2f(fminf(-b1, 86.f)), z0 = et0 * n0, z1 = et1 * n1;
                  const int ro = (8 * seg + e) * 272 + 4 * kp;
                  *(LAS unsigned*)(QD + ro) = cvt_pk_bf16(q0 * e0, q1 * e1); *(LAS unsigned*)(KD + ro) = cvt_pk_bf16(k0 * n0, k1 * n1); *(LAS unsigned*)(KZ + ro) = cvt_pk_bf16(k0 * z0, k1 * z1); } }
            LDS_BAR();
            SCANT(3);
            if (cj + 1 < 36) GLA_FETCH_V(cj + 1);
            { const int ti = wave >> 1;
#pragma unroll
              for (int uu = 0; uu < 2; ++uu) { const int sj = 2 * (wave & 1) + uu; f32x4 a4 = (f32x4){0.f, 0.f, 0.f, 0.f};
#pragma unroll
                  for (int kk = 0; kk < 4; ++kk) { const bf16x8 af = *(const LAS bf16x8*)(KD + (16 * sj + i16) * 272 + (32 * kk + 8 * (lane >> 4)) * 2), bfr = *(const LAS bf16x8*)(QD + (16 * ti + i16) * 272 + (32 * kk + 8 * (lane >> 4)) * 2);
                      a4 = MFMA16(af, bfr, a4); }
                  const int t = 16 * ti + i16, s0 = 16 * sj + 4 * (lane >> 4);
                  float pv[4];
#pragma unroll
                  for (int i = 0; i < 4; ++i) pv[i] = (s0 + i <= t) ? a4[i] : 0.f;
                  u32x2 w; w.x = cvt_pk_bf16(pv[0], pv[1]); w.y = cvt_pk_bf16(pv[2], pv[3]);
                  *(LAS u32x2*)(PT + t * 144 + s0 * 2) = w; } }
            LDS_BAR();
            SCANT(4);
#define SB_ asm volatile("" ::: "memory")
#define LD_INTER(Fx, kb_, s2_) do { _Pragma("unroll") for (int tb_ = 0; tb_ < 2; ++tb_) { const LAS unsigned char* qp_ = QD + (32 * tb_ + r32) * 272 + (32 * (kb_) + 16 * (s2_) + 4 * hi) * 2; \
                Fx[tb_] = cat4(*(const LAS s16x4*)qp_, *(const LAS s16x4*)(qp_ + 16)); } } while (0)
#define MM_INTER(Fx, kb_, s2_) do { const bf16x8 ap_ = pack8(S[kb_], s2_); oT[0] = MFMA32(ap_, Fx[0], oT[0]); oT[1] = MFMA32(ap_, Fx[1], oT[1]); } while (0)
#define LD_P(Fx, i_, tb_, ss_) Fx[i_] = *(const LAS bf16x8*)(PT + (32 * (tb_) + r32) * 144 + (16 * (ss_) + 8 * hi) * 2)
#define LD_STATE(Fx, kb_) do { _Pragma("unroll") for (int ss_ = 0; ss_ < 4; ++ss_) { const LAS unsigned char* zp_ = KZ + (16 * ss_ + 8 * hi + tq) * 272 + (32 * (kb_) + 16 * blk + 4 * tp) * 2; Fx[ss_] = cat4(tr_read(zp_), tr_read(zp_ + 4 * 272)); } } while (0)
#define LD_DEC(kb_) do { } while (0)
#define DECAY(kb_) do { _Pragma("unroll") for (int i4_ = 0; i4_ < 4; ++i4_) { const f32x4 dv_ = *(const LAS f32x4*)(DEC + 32 * (kb_) + 8 * i4_ + 4 * hi); _Pragma("unroll") for (int e_ = 0; e_ < 4; ++e_) S[kb_][4 * i4_ + e_] *= dv_[e_]; } } while (0)
#define MM_STATE(Fx, kb_) do { _Pragma("unroll") for (int ss_ = 0; ss_ < 4; ++ss_) S[kb_] = MFMA32(Fx[ss_], vfr[ss_], S[kb_]); } while (0)
            bf16x8 vfr[4], fa[4], fb[4];
#pragma unroll
            for (int ss = 0; ss < 4; ++ss) { const LAS unsigned char* vp = VT + (16 * ss + 8 * hi + tq) * 528 + (32 * wave + 16 * blk + 4 * tp) * 2; vfr[ss] = cat4(tr_read(vp), tr_read(vp + 4 * 528)); }
            f32x16 oT[2];
#pragma unroll
            for (int tb = 0; tb < 2; ++tb)
#pragma unroll
                for (int i = 0; i < 16; ++i) oT[tb][i] = 0.f;
            LD_INTER(fa, 0, 0); LD_INTER(fb, 0, 1); SB_;
            MM_INTER(fa, 0, 0); LD_INTER(fa, 1, 0); SB_; MM_INTER(fb, 0, 1); LD_INTER(fb, 1, 1); SB_;
            MM_INTER(fa, 1, 0); LD_INTER(fa, 2, 0); SB_; MM_INTER(fb, 1, 1); LD_INTER(fb, 2, 1); SB_;
            MM_INTER(fa, 2, 0); LD_INTER(fa, 3, 0); SB_; MM_INTER(fb, 2, 1); LD_INTER(fb, 3, 1); SB_;
            MM_INTER(fa, 3, 0); SB_;
            LD_P(fa, 0, 0, 0); LD_P(fa, 1, 0, 1); LD_P(fa, 2, 1, 0); LD_P(fa, 3, 1, 1); SB_; MM_INTER(fb, 3, 1); SB_;
            LD_P(fb, 0, 1, 2); LD_P(fb, 1, 1, 3); LD_DEC(0); SB_;
            oT[0] = MFMA32(vfr[0], fa[0], oT[0]); oT[1] = MFMA32(vfr[0], fa[2], oT[1]); oT[0] = MFMA32(vfr[1], fa[1], oT[0]); oT[1] = MFMA32(vfr[1], fa[3], oT[1]); SB_;
            LD_STATE(fa, 0); SB_;
            oT[1] = MFMA32(vfr[2], fb[0], oT[1]); oT[1] = MFMA32(vfr[3], fb[1], oT[1]); SB_;
#pragma unroll
            for (int tb = 0; tb < 2; ++tb)
#pragma unroll
                for (int i4 = 0; i4 < 4; ++i4) { u32x2 w; w.x = cvt_pk_bf16(oT[tb][4 * i4], oT[tb][4 * i4 + 1]); w.y = cvt_pk_bf16(oT[tb][4 * i4 + 2], oT[tb][4 * i4 + 3]);
                    *(LAS u32x2*)(OTW + (32 * tb + r32) * 64 + (8 * i4 + 4 * hi) * 2) = w; }
            SB_;
            if (cj + 1 < 36) GLA_FETCH_QK(cj + 1);
            DECAY(0); LD_DEC(1); LD_STATE(fb, 1); SB_; MM_STATE(fa, 0); SB_;
#pragma unroll
            for (int it = 0; it < 4; ++it) { const int idx = lane + 64 * it; const int trow = idx >> 2, pc = idx & 3; const u32x4 w = *(const LAS u32x4*)(OTW + trow * 64 + pc * 16);
                char* ub = (char*)OUT + ((size_t)(tlow + sgn * 16 * it)) * 2048 + hd * 512 + 64 * wave; *(u32x4*)(ub + olo) = w; }
            SB_;
            DECAY(1); LD_DEC(2); LD_STATE(fa, 2); SB_; MM_STATE(fb, 1); SB_;
            DECAY(2); LD_DEC(3); LD_STATE(fb, 3); SB_; MM_STATE(fa, 2); SB_;
            DECAY(3); SB_; MM_STATE(fb, 3);
#undef SB_
#undef LD_INTER
#undef MM_INTER
#undef LD_P
#undef LD_STATE
#undef LD_DEC
#undef DECAY
#undef MM_STATE
            SCANT(5);
        }
    }
}
#undef SCANT

#undef GLA_TLOW
#undef GLA_FETCH_V
#undef GLA_FETCH_QK
DI void gla_norm_phase(Frame& F, int j, int nrows) {
    unsigned char* const ws = KWS; const bf16_t* OFW = (const bf16_t*)(ws + WS_H); const bf16_t* OBW = (const bf16_t*)KOUT; const bf16_t* GB = (const bf16_t*)(ws + WS_R2) + (size_t)MT * 1024; signed char* A2 = (signed char*)(ws + WS_R2); float* sap = (float*)(ws + WS_SA);
    const int gw = blockIdx.x * NWAVES + F.wave, NGW = F.G * NWAVES;
    const float* ngp = KIN(I_GNORM) + j * 256 + 8 * (F.lane & 31);
    const f32x4 ng0 = *(const f32x4*)ngp, ng1 = *(const f32x4*)(ngp + 4);
    const float ng[8] = {ng0[0], ng0[1], ng0[2], ng0[3], ng1[0], ng1[1], ng1[2], ng1[3]};
    for (int rowb = 4 * gw; rowb < nrows; rowb += 4 * NGW) {
        u32x4 a[4][2], bq[4][2], gg[4][2];
#pragma unroll
        for (int u = 0; u < 4; ++u)
#pragma unroll
            for (int it = 0; it < 2; ++it) { const size_t off = (size_t)(rowb + u) * 1024 + (size_t)(F.lane + 64 * it) * 8; a[u][it] = *(const u32x4*)(OFW + off); bq[u][it] = *(const u32x4*)(OBW + off); gg[u][it] = *(const u32x4*)(GB + off); }
#pragma unroll
        for (int u = 0; u < 4; ++u) { float v16[16];
#pragma unroll
            for (int it = 0; it < 2; ++it) {
                const unsigned aw[4] = {a[u][it].x, a[u][it].y, a[u][it].z, a[u][it].w}, bw[4] = {bq[u][it].x, bq[u][it].y, bq[u][it].z, bq[u][it].w}, gw4[4] = {gg[u][it].x, gg[u][it].y, gg[u][it].z, gg[u][it].w};
                float ov[8], gv[8]; float ss = 0.f;
#pragma unroll
                for (int q = 0; q < 4; ++q) { ov[2 * q] = bf_lo(aw[q]) + bf_lo(bw[q]); ov[2 * q + 1] = bf_hi(aw[q]) + bf_hi(bw[q]); gv[2 * q] = bf_lo(gw4[q]); gv[2 * q + 1] = bf_hi(gw4[q]); }
#pragma unroll
                for (int e = 0; e < 8; ++e) ss += ov[e] * ov[e];
                ss = half_sum32(ss, F.lane);
                const float rstd = 1.0f / sqrtf(ss * (1.0f / 256.0f) + RMS_EPS);
#pragma unroll
                for (int e = 0; e < 8; ++e) v16[8 * it + e] = ov[e] * rstd * ng[e] * silu_fast(gv[e]); }
            const float sc_ = quant_row_i8(v16, A2 + (size_t)(rowb + u) * 1024, 8 * F.lane, F.lane); if (F.lane == 0) sap[rowb + u] = sc_; }
    }
}

DI void final_phase(Frame& F) {
    unsigned char* const ws = KWS; const bf16_t* XRp = (const bf16_t*)(ws + WS_XR); const unsigned char* Yp = ws + WS_R3; float* outp = KOUT; const float* fg = KIN(I_FINALG);
    const float* gatel = (const float*)(ws + WS_MOD) + (size_t)(DEPTH - 1) * 33 * 6144 + 5 * 1024; const int* tokpos = (const int*)(ws + WS_TOKPOS);
    (void)moe_table(F, DEPTH - 1, true); const LAS int* bs = (const LAS int*)(F.lds + MOE_TAB_OFF);
    const int c0 = 8 * F.lane;
    const int RPB = (NL + F.G - 1) / F.G, RPW = (RPB + 7) / 8;
    const int brow0 = blockIdx.x * RPB; int bend = brow0 + RPB; if (bend > NL) bend = NL;
    const int row0 = brow0 + F.wave * RPW; int rend = row0 + RPW; if (rend > bend) rend = bend;
    float gn[16], gy[16]; int mb = -1;
#pragma unroll
    for (int hh = 0; hh < 2; ++hh)
#pragma unroll
        for (int q = 0; q < 2; ++q) { const f32x4 g4 = *(const f32x4*)(fg + hh * 512 + c0 + 4 * q);
#pragma unroll
            for (int e = 0; e < 4; ++e) gn[hh * 8 + q * 4 + e] = g4[e]; }
    int tpc[4];
#pragma unroll
    for (int u = 0; u < 4; ++u) { tpc[u] = 0; if (row0 < rend) { const int rr = row0 + u < rend ? row0 + u : rend - 1; tpc[u] = tokpos[rr]; } }
    for (int rowb = row0; rowb < rend; rowb += 4) {
        u32x4 xa[4], xb[4], ya[4], yb[4];
#pragma unroll
        for (int u = 0; u < 4; ++u) { const int rr = rowb + u < rend ? rowb + u : rend - 1; const bf16_t* xr = XRp + (size_t)rr * 1024; xa[u] = *(const u32x4*)(xr + c0); xb[u] = *(const u32x4*)(xr + 512 + c0);
            const int tp = tpc[u]; const unsigned char* yr = Yp + ((size_t)bs[tp & 0xff] * 256 + (size_t)(tp >> 8)) * 1024; const u32x2 ta_ = *(const u32x2*)(yr + c0), tb_ = *(const u32x2*)(yr + 512 + c0); ya[u].x = ta_.x; ya[u].y = ta_.y; yb[u].x = tb_.x; yb[u].y = tb_.y; }
        if (rowb + 4 < rend) {
#pragma unroll
            for (int u = 0; u < 4; ++u) { const int rr = rowb + 4 + u < rend ? rowb + 4 + u : rend - 1; tpc[u] = tokpos[rr]; } }
#pragma unroll
        for (int u = 0; u < 4; ++u) { const int row = rowb + u; if (row < rend) {
            const int mbn = row >> 11;
            if (mbn != mb) { mb = mbn; const float* gp = gatel + (size_t)mb * 6144;
#pragma unroll
                for (int hh = 0; hh < 2; ++hh)
#pragma unroll
                    for (int q = 0; q < 2; ++q) { const f32x4 y4 = *(const f32x4*)(gp + hh * 512 + c0 + 4 * q);
#pragma unroll
                        for (int e = 0; e < 4; ++e) gy[hh * 8 + q * 4 + e] = y4[e] * (1.0f / Y_SCALE); } }
            float v[16], yv[16]; unpack16(xa[u], xb[u], v); unpack16_f8(ya[u].x, ya[u].y, yb[u].x, yb[u].y, yv);
            float ss = 0.f;
#pragma unroll
            for (int e = 0; e < 16; ++e) { v[e] += gy[e] * yv[e]; ss += v[e] * v[e]; }
            ss = wave_sum(ss, F.lane);
            const float rstd = 1.0f / sqrtf(ss * (1.0f / 1024.0f) + RMS_EPS);
            float* op = outp + (size_t)row * 1024;
#pragma unroll
            for (int hh = 0; hh < 2; ++hh)
#pragma unroll
                for (int q = 0; q < 2; ++q) { f32x4 o4;
#pragma unroll
                    for (int e = 0; e < 4; ++e) o4[e] = v[hh * 8 + q * 4 + e] * rstd * gn[hh * 8 + q * 4 + e];
                    *(f32x4*)(op + hh * 512 + c0 + 4 * q) = o4; }
        } }
    }
}

struct Args { const float* in[23]; float* out; unsigned char* ws; int ph_lo, ph_hi; };
constexpr int PH_PER_LAYER = 8, N_PHASES = 1 + DEPTH * PH_PER_LAYER + 1;

__global__ void __launch_bounds__(NWAVES * 64, 2) fwd_kernel(Args args) {
    extern __shared__ __attribute__((aligned(16))) unsigned char lds[];
    LAS unsigned char* const ldsb = (LAS unsigned char*)lds;
    const int wv0 = __builtin_amdgcn_readfirstlane((int)threadIdx.x >> 6);
    for (int u = wv0 * 64 + (int)lane_id_(); u < (LDS_BYTES - MISC_OFF) / 4; u += NWAVES * 64) ((LAS unsigned*)(ldsb + MISC_OFF))[u] = 0u;
    __syncthreads();
    const int lo = args.ph_lo, hi = args.ph_hi;
    XcdBarrier bar; bar.bar = nullptr; bar.x = 0; bar.st = (volatile LAS unsigned*)(ldsb + MISC_OFF) + 8; bar.w = (unsigned)wv0;
    if (hi - lo > 1) bar = xcd_barrier_post((unsigned*)KWS + CW_BAR, (volatile LAS unsigned*)(ldsb + MISC_OFF) + 8, (unsigned)wv0);
#define IN(k) (lo <= (k) && (k) < hi)
#if PROBE_MASK
    unsigned long long pr_prev = __builtin_amdgcn_s_memrealtime(), pr_acc = 0;
#define PSTAMP(slot) do { const unsigned long long tn_ = __builtin_amdgcn_s_memrealtime(); if ((PROBE_MASK >> (slot)) & 1) pr_acc += tn_ - pr_prev; pr_prev = tn_; } while (0)
#else
    unsigned long long pr_acc = 0;
#define PSTAMP(slot) do { } while (0)
#endif
#define SEAM(k, slot) do { if (IN(k) && IN((k) + 1)) { bar.bar = (unsigned*)KWS + CW_BAR; xcd_barrier(bar); } PSTAMP(slot); } while (0)

    if (PHE(0) && IN(0)) { Frame F = mkframe(ldsb, wv0); p0_prologue(F); }
    SEAM(0, 0);
#pragma unroll 1
    for (int layer = 0; layer < DEPTH; ++layer) {
        const int pb = 1 + layer * PH_PER_LAYER; const int j = layer >> 1; const bool gla = layer & 1;
        if (PHE(1) && IN(pb + 0)) { Frame F = mkframe(ldsb, wv0); norm_phase<false>(F, layer); }
        SEAM(pb + 0, 1);
        if (IN(pb + 1)) { Frame F = mkframe(ldsb, wv0);
            if (PHE(2) && !gla) { unsigned char* const ws = KWS;
                LAS float* ropeL = (LAS float*)(F.lds + RING_BYTES);
                { const float* rg = (const float*)(ws + WS_ROPE); for (int idx = F.tid; idx < 64 * 32; idx += 512) ropeL[idx] = rg[idx]; }
                __syncthreads();
                DenseOrder S{MT / 256, NQKV / 256, F.G, (int)blockIdx.x, 1024u, (const char*)(ws + WS_WQKV) + (size_t)j * NQKV * 1024, 1024u, (const float*)(ws + WS_SA), (const float*)(ws + WS_SBQKV) + j * NQKV}; EpiQKV E{(bf16_t*)(ws + WS_R2), ropeL};
                pg8::gemm_phase<EpiQKV, DenseOrder, 1>(F.lds, F.tid, (const char*)(ws + WS_H), 1024, 1024u, S, E, pr_acc); }
            else if (PHE(3) && gla) { unsigned char* const ws = KWS;
                DenseOrder S{MT / 256, NGIN / 256, F.G, (int)blockIdx.x, 1024u, (const char*)(ws + WS_WIN) + (size_t)j * NGIN * 1024, 1024u, (const float*)(ws + WS_SA), (const float*)(ws + WS_SBIN) + j * NGIN};
                EpiGLA E{(bf16_t*)(ws + WS_R2), (float*)(ws + WS_R)};
                pg8::gemm_phase<EpiGLA, DenseOrder, 1>(F.lds, F.tid, (const char*)(ws + WS_H), 1024, 1024u, S, E, pr_acc); }
        }
        SEAM(pb + 1, gla ? 3 : 2);
        if (IN(pb + 2)) { if (PHE(4) && !gla) { Frame F = mkframe(ldsb, wv0); attn_phase(F, j, pr_acc); } else if (PHE(5) && gla) { Frame F = mkframe(ldsb, wv0); gla_phase(F, j, pr_acc); } }
        SEAM(pb + 2, gla ? 5 : 4);
        if (PHE(6) && IN(pb + 3)) { Frame F = mkframe(ldsb, wv0); if (gla) gla_norm_phase(F, j, layer == DEPTH - 1 ? NL : MT); }
        if (gla) SEAM(pb + 3, 6);
        if (PHE(7) && IN(pb + 4)) { Frame F = mkframe(ldsb, wv0); unsigned char* const ws = KWS;
            const int nMp = layer == DEPTH - 1 ? NL / 256 : MT / 256;
            EpiY E{ws + WS_H};
            if (gla) { DenseOrder S{nMp, 4, F.G, (int)blockIdx.x, 1024u, (const char*)(ws + WS_WGO) + (size_t)j * 1024 * 1024, 1024u, (const float*)(ws + WS_SA), (const float*)(ws + WS_SBGO) + j * 1024};
                pg8::gemm_phase<EpiY, DenseOrder, 1>(F.lds, F.tid, (const char*)(ws + WS_R2), 1024, 1024u, S, E, pr_acc); }
            else { DenseOrder S{nMp, 4, F.G, (int)blockIdx.x, 1024u, (const char*)(ws + WS_WO) + (size_t)j * 1024 * 1024, 1024u, nullptr, (const float*)(ws + WS_SBO) + j * 1024, 1.0f / ATT_O_SCALE};
                pg8::gemm_phase<EpiY, DenseOrder, 2>(F.lds, F.tid, (const char*)(ws + WS_R3), 1024, 1024u, S, E, pr_acc); }
        }
        SEAM(pb + 4, 7);
        if (PHE(8) && IN(pb + 5)) { Frame F = mkframe(ldsb, wv0); n2_phase(F, layer); }
        SEAM(pb + 5, 8);
        if (PHE(9) && IN(pb + 6)) { Frame F = mkframe(ldsb, wv0);
            const int nblk = moe_table(F, layer); const LAS int* bs = (const LAS int*)(F.lds + MOE_TAB_OFF); unsigned char* const ws = KWS;
            MoeUpOrder S{nblk, F.G, (int)blockIdx.x, bs, bs + 32, (const int*)(ws + WS_LIST), (const char*)(ws + WS_WGU) + (size_t)layer * 16 * 1024 * 1024, (const float*)(ws + WS_SLIST), (const float*)(ws + WS_SBGU) + layer * 16 * 1024};
            EpiSwiGLU E{(unsigned char*)(ws + WS_R2), (const f32x2*)(ws + WS_GLIST)};
            pg8::gemm_phase<EpiSwiGLU, MoeUpOrder, 1>(F.lds, F.tid, (const char*)(ws + WS_R3), 1024, 1024u, S, E, pr_acc);
        }
        SEAM(pb + 6, 9);
        if (PHE(10) && IN(pb + 7)) { Frame F = mkframe(ldsb, wv0);
            const int nblk = moe_table(F, layer, true); const LAS int* bs = (const LAS int*)(F.lds + MOE_TAB_OFF); unsigned char* const ws = KWS;
            MoeDownOrder S{nblk, F.G, (int)blockIdx.x, bs, (const char*)(ws + WS_WD) + (size_t)layer * 16 * 1024 * 512, (const float*)(ws + WS_SBD) + layer * 4 * 1024}; EpiY E{ws + WS_R3};
            pg8::gemm_phase<EpiY, MoeDownOrder, 2>(F.lds, F.tid, (const char*)(ws + WS_R2), 1024, 512u, S, E, pr_acc);
        }
        SEAM(pb + 7, 10);
    }
    if (PHE(11) && IN(N_PHASES - 1)) { Frame F = mkframe(ldsb, wv0); final_phase(F); }
#if PROBE_MASK
    PSTAMP(11);
    if (blockIdx.x == 0 && wv0 == 0 && lane_id_() == 0u) { const unsigned long long t0_ = __builtin_amdgcn_s_memrealtime(); while (__builtin_amdgcn_s_memrealtime() - t0_ < (unsigned long long)PROBE_AMP * pr_acc) __builtin_amdgcn_s_sleep(8); }
#endif
#undef IN
#undef SEAM
}

extern "C" void kernel_launch(void* const* d_in, const int* in_sizes, int n_in, void* d_out, int out_size, void* d_ws, size_t ws_size, hipStream_t stream) {
    static int grid = 0;
    if (grid == 0) {
        if (n_in != 23 || out_size != NL * D || ws_size < WS_END) { fprintf(stderr, "kernel_launch: unexpected shapes (n_in %d, out %d, ws %zu; need ws >= %zu)\n", n_in, out_size, ws_size, (size_t)WS_END); grid = -1; return; }
        int dev = 0, cus = 0, per_cu = 0;
        if (hipGetDevice(&dev) != hipSuccess || hipDeviceGetAttribute(&cus, hipDeviceAttributeMultiprocessorCount, dev) != hipSuccess) { grid = -1; return; }
        if (hipFuncSetAttribute((const void*)fwd_kernel, hipFuncAttributeMaxDynamicSharedMemorySize, LDS_BYTES) != hipSuccess) { fprintf(stderr, "kernel_launch: hipFuncSetAttribute failed\n"); grid = -1; return; }
        if (hipOccupancyMaxActiveBlocksPerMultiprocessor(&per_cu, (const void*)fwd_kernel, NWAVES * 64, LDS_BYTES) != hipSuccess || per_cu < 1) { fprintf(stderr, "kernel_launch: occupancy query reports %d blocks per CU\n", per_cu); }
        (void)hipGetLastError();
        grid = cus;
        if (grid < 128) { fprintf(stderr, "kernel_launch: too few CUs (%d)\n", grid); grid = -1; return; }
    }
    if (grid < 0) return;
    (void)in_sizes;
    if (hipMemsetAsync((char*)d_ws + WS_CTL, 0, CTL_ZERO_BYTES, stream) != hipSuccess) return;
    Args a{};
    for (int i = 0; i < 23; ++i) a.in[i] = (const float*)d_in[i];
    a.out = (float*)d_out; a.ws = (unsigned char*)d_ws;
#if MK_N_LAUNCHES == 1
    a.ph_lo = 0; a.ph_hi = N_PHASES;
    hipLaunchKernelGGL(fwd_kernel, dim3(grid), dim3(NWAVES * 64), LDS_BYTES, stream, a);
#else
    for (int p = 0; p < N_PHASES; ++p) {
        if (p >= 1 && p < N_PHASES - 1) { const int s = (p - 1) % PH_PER_LAYER, layer = (p - 1) / PH_PER_LAYER; if (s == 3 && !(layer & 1)) continue; }
        a.ph_lo = p; a.ph_hi = p + 1;
        hipLaunchKernelGGL(fwd_kernel, dim3(grid), dim3(NWAVES * 64), LDS_BYTES, stream, a);
    }
#endif
}
```
